# Optimizing an MI355X kernel written in HIP

```python
import math
import jax, jax.numpy as jnp
from jax import lax
import numpy as np

D_MODEL = 1024
BATCH = 8
SEQ = 2048
DEPTH = 4

GRID_W = 64
CTX_LEN = 256
N_MIXERS = 2
N_CONV_LAYERS = (DEPTH + N_MIXERS - 1) // N_MIXERS
N_ATTN_LAYERS = DEPTH // N_MIXERS
CONV_WIDTH = 31
QK_HEAD_DIM = 64
V_HEAD_DIM = 2 * QK_HEAD_DIM
ATTN_HEADS = D_MODEL // V_HEAD_DIM
ROT_AXIS_DIM = QK_HEAD_DIM // 2
ROPE_BASE = 10000.0
Q_BLOCK = 128
FFN_HIDDEN = ((-(-8 * D_MODEL // 3) + 255) // 256) * 256
N_MOD = 6
EPS = 1e-6

kernel_name = 'hybrid_conv_diffattn_prefix_dit'


def _rmsnorm(x, g):
    xf = x.astype(jnp.float32)
    y = xf * lax.rsqrt(jnp.mean(xf * xf, axis=-1, keepdims=True) + EPS)
    return (y * g.astype(jnp.float32)).astype(x.dtype)


def _layernorm(x, g, b):
    xf = x.astype(jnp.float32)
    mu = jnp.mean(xf, axis=-1, keepdims=True)
    var = jnp.mean(jnp.square(xf - mu), axis=-1, keepdims=True)
    y = (xf - mu) * lax.rsqrt(var + EPS)
    return (y * g.astype(jnp.float32) + b.astype(jnp.float32)).astype(x.dtype)


def _modulate(h, shift, scale):
    return h * (1 + scale) + shift


def _axial_rope_tables(rows, dtype):
    row = jnp.repeat(jnp.arange(rows, dtype=jnp.float32), GRID_W)
    col = jnp.tile(jnp.arange(GRID_W, dtype=jnp.float32), rows)
    inv = ROPE_BASE ** (-2.0 * jnp.arange(ROT_AXIS_DIM // 2, dtype=jnp.float32) / ROT_AXIS_DIM)
    ang_r = row[:, None] * inv[None, :]
    ang_c = col[:, None] * inv[None, :]
    ang = jnp.concatenate([ang_r, ang_r, ang_c, ang_c], axis=-1)
    return jnp.cos(ang).astype(dtype), jnp.sin(ang).astype(dtype)


def _apply_rope(x, cos, sin):
    xs = x.reshape(x.shape[:-1] + (2, 2, ROT_AXIS_DIM // 2))
    rot = jnp.stack([-xs[..., 1, :], xs[..., 0, :]], axis=-2).reshape(x.shape)
    c = cos[None, :, None, None, :]
    s = sin[None, :, None, None, :]
    return x * c + rot * s


def _conv_module(h, pw1_w, pw1_b, dw_w, dw_b, ln_g, ln_b, pw2_w, pw2_b):
    u = h @ pw1_w + pw1_b
    a, g = jnp.split(u, 2, axis=-1)
    u = a * jax.nn.sigmoid(g)
    u = lax.conv_general_dilated(
        u, dw_w[:, None, :].astype(u.dtype), window_strides=(1,),
        padding=[(CONV_WIDTH // 2, CONV_WIDTH // 2)],
        dimension_numbers=('NWC', 'WIO', 'NWC'),
        feature_group_count=D_MODEL) + dw_b
    u = jax.nn.silu(_layernorm(u, ln_g, ln_b))
    return u @ pw2_w + pw2_b


def _qkv(h, w_qkv):
    B, L, _ = h.shape
    q, k, v = jnp.split(h @ w_qkv, 3, axis=-1)
    q = q.reshape(B, L, ATTN_HEADS, 2, QK_HEAD_DIM)
    k = k.reshape(B, L, ATTN_HEADS, 2, QK_HEAD_DIM)
    v = v.reshape(B, L, ATTN_HEADS, V_HEAD_DIM)
    return q, k, v


def _diff_core(q, k, v, lam):
    s = jnp.einsum('bqhrd,bkhrd->bhrqk', q, k, preferred_element_type=jnp.float32)
    p = jax.nn.softmax(s * (1.0 / math.sqrt(QK_HEAD_DIM)), axis=-1)
    a = p[:, :, 0] - lam * p[:, :, 1]
    return jnp.einsum('bhqk,bkhe->bqhe', a.astype(v.dtype), v)


def _diff_attention(n_lat, n_ctx, w_qkv, lam_vec, subln_g, w_o, lam_init, cos, sin, with_ctx):
    B, L, _ = n_lat.shape
    q_l, k_l, v_l = _qkv(n_lat, w_qkv)
    q_c, k_c, v_c = _qkv(n_ctx, w_qkv)
    q_l = _apply_rope(q_l, cos, sin)
    k_l = _apply_rope(k_l, cos, sin)
    lv = lam_vec.astype(jnp.float32)
    lam = jnp.exp(jnp.dot(lv[0], lv[1])) - jnp.exp(jnp.dot(lv[2], lv[3])) + lam_init
    k_all = jnp.concatenate([k_c, k_l], axis=1)
    v_all = jnp.concatenate([v_c, v_l], axis=1)
    nb = L // Q_BLOCK
    qb = jnp.swapaxes(q_l.reshape(B, nb, Q_BLOCK, ATTN_HEADS, 2, QK_HEAD_DIM), 0, 1)
    ob = lax.map(lambda qblk: _diff_core(qblk, k_all, v_all, lam), qb)
    o_l = jnp.swapaxes(ob, 0, 1).reshape(B, L, ATTN_HEADS, V_HEAD_DIM)
    o_l = (_rmsnorm(o_l, subln_g) * (1.0 - lam_init)).reshape(B, L, D_MODEL) @ w_o
    if not with_ctx:
        return o_l, None
    o_c = _diff_core(q_c, k_c, v_c, lam)
    o_c = (_rmsnorm(o_c, subln_g) * (1.0 - lam_init)).reshape(B, n_ctx.shape[1], D_MODEL) @ w_o
    return o_l, o_c


def _swiglu(h, w_in, w_out):
    g, u = jnp.split(h @ w_in, 2, axis=-1)
    return (jax.nn.silu(g) * u) @ w_out


def setup_inputs(seed: int = 0) -> dict:
    key = jax.random.key(seed)
    ks = jax.random.split(key, 22)
    D = D_MODEL

    def nrm(k, shape, scale):
        return jax.random.normal(k, shape, jnp.float32) * scale

    return {
        'x': nrm(ks[0], (BATCH, SEQ, D), 1.0),
        'c': nrm(ks[1], (BATCH, D), 1.0),
        'ctx': nrm(ks[2], (BATCH, CTX_LEN, D), 1.0),
        'c_ctx': nrm(ks[3], (D,), 1.0),
        'mod_w': nrm(ks[4], (DEPTH, D, N_MOD * D), 0.5 * D ** -0.5),
        'mod_b': nrm(ks[5], (DEPTH, N_MOD * D), 0.02),
        'norm_g': 1.0 + nrm(ks[6], (DEPTH, 2, D), 0.02),
        'conv_pw1_w': nrm(ks[7], (N_CONV_LAYERS, D, 2 * D), D ** -0.5),
        'conv_pw1_b': nrm(ks[8], (N_CONV_LAYERS, 2 * D), 0.02),
        'conv_dw_w': nrm(ks[9], (N_CONV_LAYERS, CONV_WIDTH, D), CONV_WIDTH ** -0.5),
        'conv_dw_b': nrm(ks[10], (N_CONV_LAYERS, D), 0.02),
        'conv_ln_g': 1.0 + nrm(ks[11], (N_CONV_LAYERS, D), 0.02),
        'conv_ln_b': nrm(ks[12], (N_CONV_LAYERS, D), 0.02),
        'conv_pw2_w': nrm(ks[13], (N_CONV_LAYERS, D, D), D ** -0.5),
        'conv_pw2_b': nrm(ks[14], (N_CONV_LAYERS, D), 0.02),
        'attn_w_qkv': nrm(ks[15], (N_ATTN_LAYERS, D, 3 * D), D ** -0.5),
        'attn_lambda': nrm(ks[16], (N_ATTN_LAYERS, 4, QK_HEAD_DIM), 0.1),
        'attn_subln_g': 1.0 + nrm(ks[17], (N_ATTN_LAYERS, V_HEAD_DIM), 0.02),
        'attn_w_o': nrm(ks[18], (N_ATTN_LAYERS, D, D), D ** -0.5),
        'ffn_w_in': nrm(ks[19], (DEPTH, D, 2 * FFN_HIDDEN), D ** -0.5),
        'ffn_w_out': nrm(ks[20], (DEPTH, FFN_HIDDEN, D), FFN_HIDDEN ** -0.5),
        'final_g': 1.0 + nrm(ks[21], (D,), 0.02),
    }


def reference(x, c, ctx, c_ctx, mod_w, mod_b, norm_g,
              conv_pw1_w, conv_pw1_b, conv_dw_w, conv_dw_b, conv_ln_g, conv_ln_b, conv_pw2_w, conv_pw2_b,
              attn_w_qkv, attn_lambda, attn_subln_g, attn_w_o,
              ffn_w_in, ffn_w_out, final_g):
    L = x.shape[1]
    ROWS = L // GRID_W
    cos, sin = _axial_rope_tables(ROWS, x.dtype)
    s_lat = jax.nn.silu(c)
    s_ctx = jax.nn.silu(c_ctx)
    h_lat, h_ctx = x, ctx
    for i in range(DEPTH):
        with_ctx = i < DEPTH - 1
        m_l = jnp.split((s_lat @ mod_w[i] + mod_b[i])[:, None, :], N_MOD, axis=-1)
        m_c = jnp.split((s_ctx @ mod_w[i] + mod_b[i])[None, None, :], N_MOD, axis=-1)
        n_l = _modulate(_rmsnorm(h_lat, norm_g[i, 0]), m_l[0], m_l[1])
        n_c = _modulate(_rmsnorm(h_ctx, norm_g[i, 0]), m_c[0], m_c[1])
        j = i // N_MIXERS
        if i % N_MIXERS == 0:
            cp = (conv_pw1_w[j], conv_pw1_b[j], conv_dw_w[j], conv_dw_b[j],
                  conv_ln_g[j], conv_ln_b[j], conv_pw2_w[j], conv_pw2_b[j])
            y_l = _conv_module(n_l, *cp)
            y_c = _conv_module(n_c, *cp) if with_ctx else None
        else:
            lam_init = 0.8 - 0.6 * math.exp(-0.3 * i)
            y_l, y_c = _diff_attention(n_l, n_c, attn_w_qkv[j], attn_lambda[j], attn_subln_g[j],
                                       attn_w_o[j], lam_init, cos, sin, with_ctx)
        h_lat = h_lat + m_l[2] * y_l
        f_l = _modulate(_rmsnorm(h_lat, norm_g[i, 1]), m_l[3], m_l[4])
        h_lat = h_lat + m_l[5] * _swiglu(f_l, ffn_w_in[i], ffn_w_out[i])
        if with_ctx:
            h_ctx = h_ctx + m_c[2] * y_c
            f_c = _modulate(_rmsnorm(h_ctx, norm_g[i, 1]), m_c[3], m_c[4])
            h_ctx = h_ctx + m_c[5] * _swiglu(f_c, ffn_w_in[i], ffn_w_out[i])
    return _rmsnorm(h_lat, final_g)
```

```cpp
#include <hip/hip_runtime.h>
#include <hip/hip_cooperative_groups.h>
#include <cstdio>
namespace cg = cooperative_groups;

#ifndef MULTI_LAUNCH
#define MULTI_LAUNCH 0
#endif

typedef unsigned short u16;
using bf16x8 = __attribute__((ext_vector_type(8))) short;
using f32x4 = __attribute__((ext_vector_type(4))) float;
using u32x4 = __attribute__((ext_vector_type(4))) unsigned;

constexpr int D = 1024, NB = 8, SEQ = 2048, CTX = 256, DEPTH = 4;
constexpr int TL = NB * SEQ;
constexpr int TCX = NB * CTX;
constexpr int T = TL + TCX;
constexpr int FH = 2816;
constexpr int KEYS = CTX + SEQ;
constexpr int NPH = 2 + 7 * DEPTH;
constexpr float EPS = 1e-6f;

constexpr size_t al256(size_t x) { return (x + 255) & ~(size_t)255; }
constexpr size_t OFF_WPW1 = 0;
constexpr size_t OFF_WPW2 = OFF_WPW1 + al256((size_t)2 * 2048 * 1024 * 2);
constexpr size_t OFF_WQKV = OFF_WPW2 + al256((size_t)2 * 1024 * 1024 * 2);
constexpr size_t OFF_WO = OFF_WQKV + al256((size_t)2 * 3072 * 1024 * 2);
constexpr size_t OFF_WFIN = OFF_WO + al256((size_t)2 * 1024 * 1024 * 2);
constexpr size_t OFF_WFOUT = OFF_WFIN + al256((size_t)4 * 5632 * 1024 * 2);
constexpr size_t OFF_H = OFF_WFOUT + al256((size_t)4 * 1024 * FH * 2);
constexpr size_t OFF_NBUF = OFF_H + al256((size_t)T * 1024 * 4);
constexpr size_t OFF_BIG = OFF_NBUF + al256((size_t)T * 1024 * 2);
constexpr size_t OFF_VBUF = OFF_BIG + al256((size_t)T * 3072 * 2);
constexpr size_t OFF_MODV = OFF_VBUF + al256((size_t)T * 1024 * 2);
constexpr size_t OFF_ROPE = OFF_MODV + al256((size_t)4 * 9 * 6144 * 4);
constexpr size_t WS_NEED = OFF_ROPE + al256((size_t)1024 * 8);

struct Params {
  const float* in[22];
  float* outp;
  char* ws;
  __device__ __forceinline__ const float* x() const { return in[0]; }
  __device__ __forceinline__ const float* c() const { return in[1]; }
  __device__ __forceinline__ const float* ctx() const { return in[2]; }
  __device__ __forceinline__ const float* c_ctx() const { return in[3]; }
  __device__ __forceinline__ const float* mod_w() const { return in[4]; }
  __device__ __forceinline__ const float* mod_b() const { return in[5]; }
  __device__ __forceinline__ const float* norm_g() const { return in[6]; }
  __device__ __forceinline__ const float* pw1_w() const { return in[7]; }
  __device__ __forceinline__ const float* pw1_b() const { return in[8]; }
  __device__ __forceinline__ const float* dw_w() const { return in[9]; }
  __device__ __forceinline__ const float* dw_b() const { return in[10]; }
  __device__ __forceinline__ const float* ln_g() const { return in[11]; }
  __device__ __forceinline__ const float* ln_b() const { return in[12]; }
  __device__ __forceinline__ const float* pw2_w() const { return in[13]; }
  __device__ __forceinline__ const float* pw2_b() const { return in[14]; }
  __device__ __forceinline__ const float* wqkv() const { return in[15]; }
  __device__ __forceinline__ const float* lam() const { return in[16]; }
  __device__ __forceinline__ const float* subln() const { return in[17]; }
  __device__ __forceinline__ const float* wo() const { return in[18]; }
  __device__ __forceinline__ const float* ffn_in() const { return in[19]; }
  __device__ __forceinline__ const float* ffn_out() const { return in[20]; }
  __device__ __forceinline__ const float* final_g() const { return in[21]; }
  __device__ __forceinline__ float* out() const { return outp; }
  __device__ __forceinline__ u16* w_pw1() const { return (u16*)(ws + OFF_WPW1); }
  __device__ __forceinline__ u16* w_pw2() const { return (u16*)(ws + OFF_WPW2); }
  __device__ __forceinline__ u16* w_qkv() const { return (u16*)(ws + OFF_WQKV); }
  __device__ __forceinline__ u16* w_o() const { return (u16*)(ws + OFF_WO); }
  __device__ __forceinline__ u16* w_fin() const { return (u16*)(ws + OFF_WFIN); }
  __device__ __forceinline__ u16* w_fout() const { return (u16*)(ws + OFF_WFOUT); }
  __device__ __forceinline__ float* h() const { return (float*)(ws + OFF_H); }
  __device__ __forceinline__ u16* nbuf() const { return (u16*)(ws + OFF_NBUF); }
  __device__ __forceinline__ u16* big() const { return (u16*)(ws + OFF_BIG); }
  __device__ __forceinline__ u16* vbuf() const { return (u16*)(ws + OFF_VBUF); }
  __device__ __forceinline__ float* modv() const { return (float*)(ws + OFF_MODV); }
  __device__ __forceinline__ float2* rope() const { return (float2*)(ws + OFF_ROPE); }
};

__device__ __forceinline__ u16 f2bf(float f) {
  unsigned u = __float_as_uint(f);
  u += 0x7fffu + ((u >> 16) & 1u);
  return (u16)(u >> 16);
}
__device__ __forceinline__ unsigned pack2(float a, float b) { return (unsigned)f2bf(a) | ((unsigned)f2bf(b) << 16); }
__device__ __forceinline__ float bf2f(unsigned v) { return __uint_as_float(v << 16); }
__device__ __forceinline__ int tile_off(int row, int chunk) { return row * 128 + (((chunk ^ row) & 7) << 4); }
__device__ __forceinline__ float fexp2(float x) { return __builtin_amdgcn_exp2f(x); }
__device__ __forceinline__ float sigmoidf_(float x) { return 1.f / (1.f + __expf(-x)); }

__device__ __forceinline__ int otid() { int t = threadIdx.x; asm volatile("" : "+v"(t)); return t; }

__device__ void wconv_item(const Params& p, int item, char* smem) {
  float* tl = (float*)smem;
  const int tid = otid();
  int K, N, half = 0, tpl, ntN, base;
  const float* src; u16* dst;
  if (item < 1024)      { base = 0;    K = 1024; N = 2048; half = 1024; tpl = 512;  ntN = 32; src = p.pw1_w();  dst = p.w_pw1(); }
  else if (item < 1536) { base = 1024; K = 1024; N = 1024;              tpl = 256;  ntN = 16; src = p.pw2_w();  dst = p.w_pw2(); }
  else if (item < 3072) { base = 1536; K = 1024; N = 3072;              tpl = 768;  ntN = 48; src = p.wqkv();   dst = p.w_qkv(); }
  else if (item < 3584) { base = 3072; K = 1024; N = 1024;              tpl = 256;  ntN = 16; src = p.wo();     dst = p.w_o(); }
  else if (item < 9216) { base = 3584; K = 1024; N = 5632; half = 2816; tpl = 1408; ntN = 88; src = p.ffn_in(); dst = p.w_fin(); }
  else                  { base = 9216; K = 2816; N = 1024;              tpl = 704;  ntN = 16; src = p.ffn_out(); dst = p.w_fout(); }
  int it = item - base;
  int l = it / tpl, rem = it % tpl, kt = rem / ntN, nt = rem % ntN;
  src += (size_t)l * K * N; dst += (size_t)l * K * N;
  {
    int nl = tid & 63, kk0 = tid >> 6;
    int np = nt * 64 + nl;
    int sc = np;
    if (half) { int blk = np >> 5, w = np & 31; sc = blk * 16 + (w & 15) + ((w >> 4) ? half : 0); }
    const float* sp = src + (size_t)(kt * 64) * N + sc;
#pragma unroll
    for (int i = 0; i < 16; ++i) { int kk = kk0 + 4 * i; tl[kk * 65 + nl] = sp[(size_t)kk * N]; }
  }
  __syncthreads();
  {
    int nl2 = tid >> 2, kq = tid & 3;
    unsigned pk[8];
#pragma unroll
    for (int e = 0; e < 8; ++e) {
      float a = tl[(kq * 16 + 2 * e) * 65 + nl2], b = tl[(kq * 16 + 2 * e + 1) * 65 + nl2];
      pk[e] = pack2(a, b);
    }
    uint4* dp = (uint4*)(dst + (size_t)(nt * 64 + nl2) * K + kt * 64 + kq * 16);
    dp[0] = make_uint4(pk[0], pk[1], pk[2], pk[3]);
    dp[1] = make_uint4(pk[4], pk[5], pk[6], pk[7]);
  }
  __syncthreads();
}

__device__ void prologue_phase(const Params& p, char* smem) {
  const int tid = otid(), wid = tid >> 6, lane = tid & 63;
  if (blockIdx.x < 384) {
    float* s = (float*)smem;
    float* red = (float*)(smem + 36864);
    for (int idx = tid; idx < 9 * 1024; idx += 256) {
      int r = idx >> 10, k = idx & 1023;
      float cv = r < 8 ? p.c()[r * 1024 + k] : p.c_ctx()[k];
      s[idx] = cv * sigmoidf_(cv);
    }
    __syncthreads();
    for (int item = blockIdx.x; item < 384; item += gridDim.x) {
      int i = item / 96, cgp = item % 96;
      float a[9];
#pragma unroll
      for (int r = 0; r < 9; ++r) a[r] = 0.f;
      const float* wp = p.mod_w() + ((size_t)i * 1024 + wid * 256) * 6144 + cgp * 64 + lane;
#pragma unroll 2
      for (int k4 = 0; k4 < 256; k4 += 4) {
        float w0 = wp[(size_t)(k4 + 0) * 6144], w1 = wp[(size_t)(k4 + 1) * 6144];
        float w2 = wp[(size_t)(k4 + 2) * 6144], w3 = wp[(size_t)(k4 + 3) * 6144];
#pragma unroll
        for (int r = 0; r < 9; ++r) {
          float4 sv = *(const float4*)&s[r * 1024 + wid * 256 + k4];
          a[r] += sv.x * w0 + sv.y * w1 + sv.z * w2 + sv.w * w3;
        }
      }
#pragma unroll
      for (int r = 0; r < 9; ++r) red[(wid * 9 + r) * 64 + lane] = a[r];
      __syncthreads();
      for (int idx = tid; idx < 9 * 64; idx += 256) {
        int r = idx >> 6, l = idx & 63;
        float v = red[(0 * 9 + r) * 64 + l] + red[(1 * 9 + r) * 64 + l] + red[(2 * 9 + r) * 64 + l] + red[(3 * 9 + r) * 64 + l];
        v += p.mod_b()[i * 6144 + cgp * 64 + l];
        p.modv()[((size_t)i * 9 + r) * 6144 + cgp * 64 + l] = v;
      }
      __syncthreads();
    }
  }
  if (blockIdx.x == gridDim.x - 1) {
    for (int idx = tid; idx < 1024; idx += 256) {
      int pos = idx >> 4, f = idx & 15;
      float inv = powf(10000.f, -(float)f / 16.f);
      float ang = (float)pos * inv;
      p.rope()[idx] = make_float2(cosf(ang), sinf(ang));
    }
  }
  for (int item = blockIdx.x; item < 12032; item += gridDim.x) wconv_item(p, item, smem);
  {
    const float4* x4 = (const float4*)p.x(); const float4* c4 = (const float4*)p.ctx(); float4* h4 = (float4*)p.h();
    for (int idx = blockIdx.x * 256 + tid; idx < T * 256; idx += gridDim.x * 256)
      h4[idx] = idx < TL * 256 ? x4[idx] : c4[idx - TL * 256];
  }
}

__device__ void norm_phase(const Params& p, int layer, int which, int M) {
  const int tid = otid(), wid = tid >> 6, lane = tid & 63;
  const float* g = p.norm_g() + (layer * 2 + which) * 1024;
  for (int row = blockIdx.x * 4 + wid; row < M; row += gridDim.x * 4) {
    int r = row < TL ? row / SEQ : 8;
    const float* mv = p.modv() + ((size_t)layer * 9 + r) * 6144;
    const float* sh = mv + (which ? 3 : 0) * 1024;
    const float* sc = mv + (which ? 4 : 1) * 1024;
    const float4* hp = (const float4*)(p.h() + (size_t)row * 1024);
    float4 v[4];
    float ss = 0.f;
#pragma unroll
    for (int i = 0; i < 4; ++i) { v[i] = hp[lane + 64 * i]; ss += v[i].x * v[i].x + v[i].y * v[i].y + v[i].z * v[i].z + v[i].w * v[i].w; }
#pragma unroll
    for (int o = 32; o >= 1; o >>= 1) ss += __shfl_xor(ss, o);
    float rstd = rsqrtf(ss * (1.f / 1024.f) + EPS);
    uint2* op = (uint2*)(p.nbuf() + (size_t)row * 1024);
#pragma unroll
    for (int i = 0; i < 4; ++i) {
      int c4 = lane + 64 * i;
      float4 gg = ((const float4*)g)[c4], s4 = ((const float4*)sc)[c4], h4 = ((const float4*)sh)[c4];
      float y0 = v[i].x * rstd * gg.x * (1.f + s4.x) + h4.x;
      float y1 = v[i].y * rstd * gg.y * (1.f + s4.y) + h4.y;
      float y2 = v[i].z * rstd * gg.z * (1.f + s4.z) + h4.z;
      float y3 = v[i].w * rstd * gg.w * (1.f + s4.w) + h4.w;
      op[c4] = make_uint2(pack2(y0, y1), pack2(y2, y3));
    }
  }
}

__device__ void final_phase(const Params& p) {
  const int tid = otid(), wid = tid >> 6, lane = tid & 63;
  for (int row = blockIdx.x * 4 + wid; row < TL; row += gridDim.x * 4) {
    const float4* hp = (const float4*)(p.h() + (size_t)row * 1024);
    float4 v[4];
    float ss = 0.f;
#pragma unroll
    for (int i = 0; i < 4; ++i) { v[i] = hp[lane + 64 * i]; ss += v[i].x * v[i].x + v[i].y * v[i].y + v[i].z * v[i].z + v[i].w * v[i].w; }
#pragma unroll
    for (int o = 32; o >= 1; o >>= 1) ss += __shfl_xor(ss, o);
    float rstd = rsqrtf(ss * (1.f / 1024.f) + EPS);
    float4* op = (float4*)(p.out() + (size_t)row * 1024);
#pragma unroll
    for (int i = 0; i < 4; ++i) {
      int c4 = lane + 64 * i;
      float4 gg = ((const float4*)p.final_g())[c4];
      float4 ov = make_float4(v[i].x * rstd * gg.x, v[i].y * rstd * gg.y, v[i].z * rstd * gg.z, v[i].w * rstd * gg.w);
      op[c4] = ov;
    }
  }
}

template <int K>
__device__ __forceinline__ void gemm_tile(const Params& p, const u16* __restrict__ A, const u16* __restrict__ Bt,
                          int mt, int nt, int EPI, int layer, int gidx, const float* __restrict__ bias, char* smem) {
  const int tid = otid(), wid = tid >> 6, lane = tid & 63, wr = wid >> 1, wc = wid & 1, fr = lane & 15, fq = lane >> 4;
  const int brow = mt * 128, bcol = nt * 128;
  f32x4 acc[4][4];
#pragma unroll
  for (int i = 0; i < 4; ++i)
#pragma unroll
    for (int j = 0; j < 4; ++j) acc[i][j] = f32x4{0.f, 0.f, 0.f, 0.f};
  constexpr int nk = K / 64;
  const int lrow = tid >> 3, lc = tid & 7;
  const u16* Ab = A + (size_t)brow * K;
  const u16* Bb = Bt + (size_t)bcol * K;
  const int toff = lrow * K + lc * 8;
  const int loff = tile_off(lrow, lc);
  u32x4 ra0, ra1, ra2, ra3, rb0, rb1, rb2, rb3;
#define G_LOAD(ko)                                                   \
  ra0 = *(const u32x4*)(Ab + toff + 0 * 32 * K + (ko));              \
  ra1 = *(const u32x4*)(Ab + toff + 1 * 32 * K + (ko));              \
  ra2 = *(const u32x4*)(Ab + toff + 2 * 32 * K + (ko));              \
  ra3 = *(const u32x4*)(Ab + toff + 3 * 32 * K + (ko));              \
  rb0 = *(const u32x4*)(Bb + toff + 0 * 32 * K + (ko));              \
  rb1 = *(const u32x4*)(Bb + toff + 1 * 32 * K + (ko));              \
  rb2 = *(const u32x4*)(Bb + toff + 2 * 32 * K + (ko));              \
  rb3 = *(const u32x4*)(Bb + toff + 3 * 32 * K + (ko));
#define L_STORE(base)                                                \
  *(u32x4*)((base) + loff + 0 * 4096) = ra0;                          \
  *(u32x4*)((base) + loff + 1 * 4096) = ra1;                          \
  *(u32x4*)((base) + loff + 2 * 4096) = ra2;                          \
  *(u32x4*)((base) + loff + 3 * 4096) = ra3;                          \
  *(u32x4*)((base) + 16384 + loff + 0 * 4096) = rb0;                  \
  *(u32x4*)((base) + 16384 + loff + 1 * 4096) = rb1;                  \
  *(u32x4*)((base) + 16384 + loff + 2 * 4096) = rb2;                  \
  *(u32x4*)((base) + 16384 + loff + 3 * 4096) = rb3;
  G_LOAD(0)
  L_STORE(smem)
  __syncthreads();
  const int aoff = tile_off(wr * 64 + fr, fq);
  const int boff = tile_off(wc * 64 + fr, fq);
#pragma unroll 1
  for (int kt = 0; kt < nk; ++kt) {
    const int cur = kt & 1;
    if (kt + 1 < nk) { G_LOAD((kt + 1) * 64) }
    __builtin_amdgcn_sched_barrier(0);
    const char* As = smem + cur * 32768;
    const char* Bs = As + 16384;
#pragma unroll
    for (int ks = 0; ks < 2; ++ks) {
      bf16x8 af[4], bfr[4];
#pragma unroll
      for (int mi = 0; mi < 4; ++mi) af[mi] = *(const bf16x8*)(As + (aoff ^ (ks << 6)) + mi * 2048);
#pragma unroll
      for (int ni = 0; ni < 4; ++ni) bfr[ni] = *(const bf16x8*)(Bs + (boff ^ (ks << 6)) + ni * 2048);
#pragma unroll
      for (int mi = 0; mi < 4; ++mi)
#pragma unroll
        for (int ni = 0; ni < 4; ++ni) acc[mi][ni] = __builtin_amdgcn_mfma_f32_16x16x32_bf16(af[mi], bfr[ni], acc[mi][ni], 0, 0, 0);
    }
    __builtin_amdgcn_sched_barrier(0);
    if (kt + 1 < nk) {
      char* Aw = smem + (cur ^ 1) * 32768;
      L_STORE(Aw)
    }
    __syncthreads();
  }
#undef G_LOAD
#undef L_STORE
  const int r0 = brow + wr * 64;
  if (EPI == 0 || EPI == 3) {
    const int OW = (EPI == 0) ? 1024 : FH;
    u16* outp = p.big();
#pragma unroll
    for (int pp = 0; pp < 2; ++pp) {
      int jch = ((bcol + wc * 64) >> 1) + pp * 16 + fr;
      float b0 = 0.f, b1 = 0.f;
      if (bias) { b0 = bias[jch]; b1 = bias[1024 + jch]; }
#pragma unroll
      for (int mi = 0; mi < 4; ++mi)
#pragma unroll
        for (int j = 0; j < 4; ++j) {
          int row = r0 + mi * 16 + fq * 4 + j;
          float a = acc[mi][2 * pp][j] + b0, g = acc[mi][2 * pp + 1][j] + b1;
          float sg = sigmoidf_(EPI == 0 ? g : a);
          float v = (EPI == 0) ? a * sg : a * sg * g;
          outp[(size_t)row * OW + jch] = f2bf(v);
        }
    }
  } else if (EPI == 2) {
    const int r = brow < TL ? brow / SEQ : 8;
    const float* gate = p.modv() + ((size_t)layer * 9 + r) * 6144 + gidx * 1024;
#pragma unroll
    for (int ni = 0; ni < 4; ++ni) {
      int col = bcol + wc * 64 + ni * 16 + fr;
      float gt = gate[col];
      float bs = bias ? bias[col] : 0.f;
#pragma unroll
      for (int mi = 0; mi < 4; ++mi) {
#pragma unroll
        for (int j = 0; j < 4; ++j) {
          int row = r0 + mi * 16 + fq * 4 + j;
          float* hp = p.h() + (size_t)row * 1024 + col;          *hp = *hp + gt * (acc[mi][ni][j] + bs);
        }
        asm volatile("" ::: "memory");
      }
    }
  } else {
    const int region = nt >> 3, hd = nt & 7;
    const bool lat = brow < TL;
    const int b = lat ? brow / SEQ : (brow - TL) / CTX;
    const int kb = lat ? 256 + (r0 - b * SEQ) : (r0 - TL - b * CTX);
    const size_t bh = (size_t)(b * 8 + hd);
    u16* qb = p.big(); u16* kbuf = p.big() + (size_t)T * 1024; u16* vt = p.big() + (size_t)T * 2048;
    if (region < 2) {
      u16* dst = (region == 0 ? qb : kbuf) + ((bh * 2 + wc) * KEYS + kb) * 64;
      const float qs = region == 0 ? 0.125f * 1.44269504088896f : 1.f;
#pragma unroll
      for (int mi = 0; mi < 4; ++mi)
#pragma unroll
        for (int j = 0; j < 4; ++j) {
          int rl = mi * 16 + fq * 4 + j;
          float x0 = acc[mi][0][j], x1 = acc[mi][1][j], x2 = acc[mi][2][j], x3 = acc[mi][3][j];
          if (lat) {
            int t = kb - 256 + rl;
            float2 cr = p.rope()[(t >> 6) * 16 + fr], cc = p.rope()[(t & 63) * 16 + fr];
            float y0 = x0 * cr.x - x1 * cr.y, y1 = x1 * cr.x + x0 * cr.y;
            float y2 = x2 * cc.x - x3 * cc.y, y3 = x3 * cc.x + x2 * cc.y;
            x0 = y0; x1 = y1; x2 = y2; x3 = y3;
          }
          u16* dp = dst + (size_t)rl * 64 + fr;
          dp[0] = f2bf(x0 * qs); dp[16] = f2bf(x1 * qs); dp[32] = f2bf(x2 * qs); dp[48] = f2bf(x3 * qs);
        }
    } else {
#pragma unroll
      for (int ni = 0; ni < 4; ++ni) {
        int e = wc * 64 + ni * 16 + fr;
        u16* dp = vt + (bh * 128 + e) * KEYS + kb;
#pragma unroll
        for (int mi = 0; mi < 4; ++mi) {
          int slot = (mi >> 1) * 32 + fq * 8 + (mi & 1) * 4;
          *(uint2*)(dp + slot) = make_uint2(pack2(acc[mi][ni][0], acc[mi][ni][1]), pack2(acc[mi][ni][2], acc[mi][ni][3]));
        }
      }
    }
  }
}

__device__ void gemm_phase(const Params& p, const u16* A, const u16* Bt, int K, int Mt, int Nt, int epi, int layer, int gidx,
                           const float* bias, char* smem) {
  const int total = Mt * Nt;
  if (K == 1024) {
    for (int tile = blockIdx.x; tile < total; tile += gridDim.x) {
      int mt = tile / Nt, nt = tile % Nt;
      gemm_tile<1024>(p, A, Bt, mt, nt, epi, layer, gidx, bias, smem);
    }
  } else {
    for (int tile = blockIdx.x; tile < total; tile += gridDim.x) {
      int mt = tile / Nt, nt = tile % Nt;
      gemm_tile<FH>(p, A, Bt, mt, nt, 2, layer, gidx, bias, smem);
    }
  }
}

__device__ void conv_phase(const Params& p, int j, int M, char* smem) {
  const int tid = otid(), wid = tid >> 6, lane = tid & 63;
  float* cbuf = (float*)smem;
  const u16* U = p.big();
  for (int item = blockIdx.x; item < M / 8; item += gridDim.x) {
    const int t0 = item * 8;
    int s0, s1;
    if (t0 < TL) { s0 = (t0 / SEQ) * SEQ; s1 = s0 + SEQ; } else { s0 = TL + ((t0 - TL) / CTX) * CTX; s1 = s0 + CTX; }
#pragma unroll 1
    for (int g = 0; g < 2; ++g) {
      const int c = g * 512 + tid * 2;
      float acc[8][2];
      float w[31][2];
#pragma unroll
      for (int k = 0; k < 31; ++k) { float2 wv = *(const float2*)(p.dw_w() + ((size_t)j * 31 + k) * 1024 + c); w[k][0] = wv.x; w[k][1] = wv.y; }
      float2 bv = *(const float2*)(p.dw_b() + j * 1024 + c);
#pragma unroll
      for (int o = 0; o < 8; ++o) { acc[o][0] = bv.x; acc[o][1] = bv.y; }
#pragma unroll
      for (int ti = 0; ti < 38; ++ti) {
        int tin = t0 - 15 + ti;
        bool valid = tin >= s0 && tin < s1;
        int tc = min(max(tin, s0), s1 - 1);
        unsigned raw = *(const unsigned*)(U + (size_t)tc * 1024 + c);
        if (!valid) raw = 0u;
        float x0 = bf2f(raw & 0xffffu), x1 = bf2f(raw >> 16);
#pragma unroll
        for (int o = 0; o < 8; ++o) {
          const int k = ti - o;
          if (k >= 0 && k < 31) { acc[o][0] += x0 * w[k][0]; acc[o][1] += x1 * w[k][1]; }
        }
      }
#pragma unroll
      for (int o = 0; o < 8; ++o) *(float2*)(cbuf + o * 1024 + c) = make_float2(acc[o][0], acc[o][1]);
    }
    __syncthreads();
#pragma unroll
    for (int tt = 0; tt < 2; ++tt) {
      const int o = wid * 2 + tt;
      float4 v[4];
      float sm = 0.f;
#pragma unroll
      for (int i = 0; i < 4; ++i) { v[i] = *(const float4*)(cbuf + o * 1024 + (lane + 64 * i) * 4); sm += v[i].x + v[i].y + v[i].z + v[i].w; }
#pragma unroll
      for (int sh = 32; sh >= 1; sh >>= 1) sm += __shfl_xor(sm, sh);
      const float mean = sm * (1.f / 1024.f);
      float sq = 0.f;
#pragma unroll
      for (int i = 0; i < 4; ++i) {
        v[i].x -= mean; v[i].y -= mean; v[i].z -= mean; v[i].w -= mean;
        sq += v[i].x * v[i].x + v[i].y * v[i].y + v[i].z * v[i].z + v[i].w * v[i].w;
      }
#pragma unroll
      for (int sh = 32; sh >= 1; sh >>= 1) sq += __shfl_xor(sq, sh);
      const float rstd = rsqrtf(sq * (1.f / 1024.f) + EPS);
      uint2* op = (uint2*)(p.vbuf() + (size_t)(t0 + o) * 1024);
#pragma unroll
      for (int i = 0; i < 4; ++i) {
        int c4 = lane + 64 * i;
        float4 lg = ((const float4*)(p.ln_g() + j * 1024))[c4], lb = ((const float4*)(p.ln_b() + j * 1024))[c4];
        float y0 = v[i].x * rstd * lg.x + lb.x, y1 = v[i].y * rstd * lg.y + lb.y;
        float y2 = v[i].z * rstd * lg.z + lb.z, y3 = v[i].w * rstd * lg.w + lb.w;
        y0 *= sigmoidf_(y0); y1 *= sigmoidf_(y1); y2 *= sigmoidf_(y2); y3 *= sigmoidf_(y3);
        op[c4] = make_uint2(pack2(y0, y1), pack2(y2, y3));
      }
    }
    __syncthreads();
  }
}

__device__ void attn_item(const Params& p, int b, int hd, int q0, int nkeys, int out_row0, float lam, float oscale,
                          const float* __restrict__ subg, char* smem) {
  const int tid = otid(), wid = tid >> 6, lane = tid & 63, fr = lane & 15, fq = lane >> 4;
  const int comp = wid & 1, qg = wid >> 1;
  const size_t bh = (size_t)(b * 8 + hd);
  const u16* qb = p.big(); const u16* kbuf = p.big() + (size_t)T * 1024; const u16* vtb = p.big() + (size_t)T * 2048;
  const u16* Qp = qb + ((bh * 2 + comp) * KEYS + q0 + qg * 32) * 64;
  bf16x8 qf[2][2];
#pragma unroll
  for (int qs = 0; qs < 2; ++qs)
#pragma unroll
    for (int ks = 0; ks < 2; ++ks) qf[qs][ks] = *(const bf16x8*)(Qp + (qs * 16 + fr) * 64 + ks * 32 + fq * 8);
  const u16* K1p = kbuf + (bh * 2 + 0) * KEYS * 64;
  const u16* K2p = kbuf + (bh * 2 + 1) * KEYS * 64;
  const u16* Vp = vtb + bh * 128 * KEYS;
  const int lrow = tid >> 3, lc = tid & 7;
  uint4 rg[8];
#define ATT_GLOAD(kt_)                                                                         \
  {                                                                                            \
    const int key0 = (kt_) * 64;                                                               \
    _Pragma("unroll") for (int i = 0; i < 2; ++i) {                                            \
      rg[i] = *(const uint4*)(K1p + (size_t)(key0 + lrow + i * 32) * 64 + lc * 8);             \
      rg[2 + i] = *(const uint4*)(K2p + (size_t)(key0 + lrow + i * 32) * 64 + lc * 8);         \
    }                                                                                          \
    _Pragma("unroll") for (int i = 0; i < 4; ++i)                                              \
      rg[4 + i] = *(const uint4*)(Vp + (size_t)(lrow + i * 32) * KEYS + key0 + lc * 8);        \
  }
#define ATT_LSTORE(buf_)                                                                       \
  {                                                                                            \
    char* bs_ = smem + (buf_) * 32768;                                                         \
    _Pragma("unroll") for (int i = 0; i < 2; ++i) {                                            \
      *(uint4*)(bs_ + tile_off(lrow + i * 32, lc)) = rg[i];                                    \
      *(uint4*)(bs_ + 8192 + tile_off(lrow + i * 32, lc)) = rg[2 + i];                         \
    }                                                                                          \
    _Pragma("unroll") for (int i = 0; i < 4; ++i)                                              \
      *(uint4*)(bs_ + 16384 + tile_off(lrow + i * 32, lc)) = rg[4 + i];                        \
  }
  f32x4 O[8][2];
#pragma unroll
  for (int e = 0; e < 8; ++e) { O[e][0] = f32x4{0.f, 0.f, 0.f, 0.f}; O[e][1] = f32x4{0.f, 0.f, 0.f, 0.f}; }
  float m[2] = {-1e30f, -1e30f}, l[2] = {0.f, 0.f};
  const int ntile = nkeys >> 6;
  ATT_GLOAD(0);
  ATT_LSTORE(0);
  __syncthreads();
  for (int kt = 0; kt < ntile; ++kt) {
    const int cur = kt & 1;
    if (kt + 1 < ntile) ATT_GLOAD(kt + 1);
    const char* base = smem + cur * 32768;
    const char* Kc = base + comp * 8192;
    const char* Vt = base + 16384;
    f32x4 S[4][2];
#pragma unroll
    for (int i = 0; i < 4; ++i) { S[i][0] = f32x4{0.f, 0.f, 0.f, 0.f}; S[i][1] = f32x4{0.f, 0.f, 0.f, 0.f}; }
#pragma unroll
    for (int ks = 0; ks < 2; ++ks)
#pragma unroll
      for (int ksub = 0; ksub < 4; ++ksub) {
        bf16x8 kf = *(const bf16x8*)(Kc + tile_off(ksub * 16 + fr, ks * 4 + fq));
#pragma unroll
        for (int qs = 0; qs < 2; ++qs) S[ksub][qs] = __builtin_amdgcn_mfma_f32_16x16x32_bf16(kf, qf[qs][ks], S[ksub][qs], 0, 0, 0);
      }
#pragma unroll
    for (int qs = 0; qs < 2; ++qs) {
      float mx = -1e30f;
#pragma unroll
      for (int ksub = 0; ksub < 4; ++ksub)
#pragma unroll
        for (int j = 0; j < 4; ++j) mx = fmaxf(mx, S[ksub][qs][j]);
      mx = fmaxf(mx, __shfl_xor(mx, 16));
      mx = fmaxf(mx, __shfl_xor(mx, 32));
      float mn = fmaxf(m[qs], mx);
      float alpha = fexp2(m[qs] - mn);
      m[qs] = mn;
      float rs = 0.f;
#pragma unroll
      for (int ksub = 0; ksub < 4; ++ksub)
#pragma unroll
        for (int j = 0; j < 4; ++j) { float pv = fexp2(S[ksub][qs][j] - mn); S[ksub][qs][j] = pv; rs += pv; }
      l[qs] = l[qs] * alpha + rs;
#pragma unroll
      for (int e = 0; e < 8; ++e) O[e][qs] *= alpha;
    }
    bf16x8 pf[2][2];
#pragma unroll
    for (int qs = 0; qs < 2; ++qs)
#pragma unroll
      for (int s = 0; s < 2; ++s) {
        unsigned u0 = pack2(S[2 * s][qs][0], S[2 * s][qs][1]), u1 = pack2(S[2 * s][qs][2], S[2 * s][qs][3]);
        unsigned u2 = pack2(S[2 * s + 1][qs][0], S[2 * s + 1][qs][1]), u3 = pack2(S[2 * s + 1][qs][2], S[2 * s + 1][qs][3]);
        uint4 uu = make_uint4(u0, u1, u2, u3);
        pf[qs][s] = *(bf16x8*)&uu;
      }
#pragma unroll
    for (int s = 0; s < 2; ++s)
#pragma unroll
      for (int e = 0; e < 8; ++e) {
        bf16x8 vf = *(const bf16x8*)(Vt + tile_off(e * 16 + fr, s * 4 + fq));
#pragma unroll
        for (int qs = 0; qs < 2; ++qs) O[e][qs] = __builtin_amdgcn_mfma_f32_16x16x32_bf16(vf, pf[qs][s], O[e][qs], 0, 0, 0);
      }
    if (kt + 1 < ntile) ATT_LSTORE(cur ^ 1);
    __syncthreads();
  }
#undef ATT_GLOAD
#undef ATT_LSTORE
#pragma unroll
  for (int qs = 0; qs < 2; ++qs) {
    float ls = l[qs];
    ls += __shfl_xor(ls, 16);
    ls += __shfl_xor(ls, 32);
    float inv = (comp ? lam : 1.f) / ls;
#pragma unroll
    for (int e = 0; e < 8; ++e) O[e][qs] *= inv;
  }
  float* ex = (float*)smem;
  if (comp == 1) {
#pragma unroll
    for (int e = 0; e < 8; ++e)
#pragma unroll
      for (int qs = 0; qs < 2; ++qs) *(f32x4*)(ex + ((((qg * 8 + e) * 2 + qs) * 64 + lane) << 2)) = O[e][qs];
  }
  __syncthreads();
  if (comp == 0) {
#pragma unroll
    for (int qs = 0; qs < 2; ++qs) {
      float ssq = 0.f;
#pragma unroll
      for (int e = 0; e < 8; ++e) {
        f32x4 o2 = *(const f32x4*)(ex + ((((qg * 8 + e) * 2 + qs) * 64 + lane) << 2));
        O[e][qs] -= o2;
#pragma unroll
        for (int j = 0; j < 4; ++j) ssq += O[e][qs][j] * O[e][qs][j];
      }
      ssq += __shfl_xor(ssq, 16);
      ssq += __shfl_xor(ssq, 32);
      float rstd = rsqrtf(ssq * (1.f / 128.f) + EPS) * oscale;
      u16* op = p.vbuf() + (size_t)(out_row0 + qg * 32 + qs * 16 + fr) * 1024 + hd * 128 + fq * 4;
#pragma unroll
      for (int e = 0; e < 8; ++e) {
        float4 sg = *(const float4*)(subg + e * 16 + fq * 4);
        *(uint2*)(op + e * 16) = make_uint2(pack2(O[e][qs][0] * rstd * sg.x, O[e][qs][1] * rstd * sg.y),
                                            pack2(O[e][qs][2] * rstd * sg.z, O[e][qs][3] * rstd * sg.w));
      }
    }
  }
  __syncthreads();
}

__device__ void attn_phase(const Params& p, int layer, bool with_ctx, char* smem) {
  const int ja = layer >> 1;
  const float* lv = p.lam() + ja * 256;
  float d01 = 0.f, d23 = 0.f;
  for (int i = 0; i < 64; ++i) { d01 += lv[i] * lv[64 + i]; d23 += lv[128 + i] * lv[192 + i]; }
  const float lam_init = 0.8f - 0.6f * expf(-0.3f * (float)layer);
  const float lam = expf(d01) - expf(d23) + lam_init;
  const float* subg = p.subln() + ja * 128;
  const int nitems = 2048 + (with_ctx ? 256 : 0);
  for (int item = blockIdx.x; item < nitems; item += gridDim.x) {
    int b, hd, q0, nk, orow;
    if (item < 2048) {
      int qt = item & 31; hd = (item >> 5) & 7; b = item >> 8;
      q0 = 256 + qt * 64; nk = KEYS; orow = b * SEQ + qt * 64;
    } else {
      int it = item - 2048;
      int qt = it & 3; hd = (it >> 2) & 7; b = it >> 5;
      q0 = qt * 64; nk = CTX; orow = TL + b * CTX + qt * 64;
    }
    attn_item(p, b, hd, q0, nk, orow, lam, 1.f - lam_init, subg, smem);
  }
}

__device__ void run_phase(const Params& p, int ph, char* smem) {
  if (ph == 0) { prologue_phase(p, smem); return; }
  if (ph == NPH - 1) { final_phase(p); return; }
  const int layer = (ph - 1) / 7, sub = (ph - 1) % 7;
  const bool last = layer == DEPTH - 1;
  const int M = last ? TL : T;
  const bool is_conv = (layer & 1) == 0;
  const int j = layer >> 1;
  if (sub == 0 || sub == 4) { norm_phase(p, layer, sub == 4 ? 1 : 0, sub == 0 ? T : M); return; }
  if (sub == 2) {
    if (is_conv) conv_phase(p, j, T, smem);
    else attn_phase(p, layer, !last, smem);
    return;
  }
  const u16 *A, *Bt; int K = 1024, Nt, epi, gidx = 0, mtiles = M / 128; const float* bias = nullptr;
  if (sub == 1) {
    A = p.nbuf(); mtiles = T / 128;
    if (is_conv) { Bt = p.w_pw1() + (size_t)j * 2048 * 1024; Nt = 16; epi = 0; bias = p.pw1_b() + j * 2048; }
    else { Bt = p.w_qkv() + (size_t)j * 3072 * 1024; Nt = 24; epi = 1; }
  } else if (sub == 3) {
    A = p.vbuf(); Nt = 8; epi = 2; gidx = 2;
    if (is_conv) { Bt = p.w_pw2() + (size_t)j * 1024 * 1024; bias = p.pw2_b() + j * 1024; }
    else Bt = p.w_o() + (size_t)j * 1024 * 1024;
  } else if (sub == 5) {
    A = p.nbuf(); Bt = p.w_fin() + (size_t)layer * 5632 * 1024; Nt = 44; epi = 3;
  } else {
    A = p.big(); Bt = p.w_fout() + (size_t)layer * 1024 * FH; K = FH; Nt = 8; epi = 2; gidx = 5;
  }
  gemm_phase(p, A, Bt, K, mtiles, Nt, epi, layer, gidx, bias, smem);
}

__global__ void __launch_bounds__(256, 2) mega(Params p, int ph_begin, int ph_end, int use_sync) {
  __shared__ __attribute__((aligned(16))) char smem[65536];
  cg::grid_group grid = cg::this_grid();
  for (int ph = ph_begin; ph < ph_end; ++ph) {
    run_phase(p, ph, smem);
    if (use_sync && ph + 1 < ph_end) grid.sync();
  }
}

extern "C" void kernel_launch(void* const* d_in, const int* in_sizes, int n_in, void* d_out, int out_size, void* d_ws,
                              size_t ws_size, hipStream_t stream) {
  Params p{};
  for (int i = 0; i < 22; ++i) p.in[i] = (const float*)d_in[i];
  p.outp = (float*)d_out;
  p.ws = (char*)d_ws;
  if (WS_NEED > ws_size || n_in < 22) return;
  static int grid_blocks = 0;
  if (!grid_blocks) {
    int dev = 0, cus = 0, per_cu = 0;
    hipGetDevice(&dev);
    hipDeviceGetAttribute(&cus, hipDeviceAttributeMultiprocessorCount, dev);
    hipOccupancyMaxActiveBlocksPerMultiprocessor(&per_cu, mega, 256, 0);
    if (per_cu > 2) per_cu = 2;
    if (per_cu < 1) per_cu = 1;
    grid_blocks = cus * per_cu;
  }
#if MULTI_LAUNCH
  for (int ph = 0; ph < NPH; ++ph) mega<<<grid_blocks, 256, 0, stream>>>(p, ph, ph + 1, 0);
#else
  int b = 0, e = NPH, s = 1;
  void* args[] = {&p, &b, &e, &s};
  hipError_t err = hipLaunchCooperativeKernel((void*)mega, dim3(grid_blocks), dim3(256), args, 0, stream);
  if (err != hipSuccess) fprintf(stderr, "cooperative launch failed: %s (grid %d)\n", hipGetErrorString(err), grid_blocks);
#endif
}
```

```cpp
#include <hip/hip_runtime.h>
#include <hip/hip_cooperative_groups.h>
#include <cstdio>
namespace cg = cooperative_groups;

#ifndef DUP_FLAG
#define DUP_FLAG 0
#endif
#ifndef MULTI_LAUNCH
#define MULTI_LAUNCH 0
#endif

typedef unsigned short u16;
using bf16x8 = __attribute__((ext_vector_type(8))) short;
using f32x4 = __attribute__((ext_vector_type(4))) float;
using u32x4 = __attribute__((ext_vector_type(4))) unsigned;

constexpr int D = 1024, NB = 8, SEQ = 2048, CTX = 256, DEPTH = 4;
constexpr int TL = NB * SEQ;
constexpr int TCX = NB * CTX;
constexpr int T = TL + TCX;
constexpr int FH = 2816;
constexpr int KEYS = CTX + SEQ;
constexpr int NPH = 2 + 7 * DEPTH;
constexpr float EPS = 1e-6f;

constexpr size_t al256(size_t x) { return (x + 255) & ~(size_t)255; }
constexpr size_t OFF_WPW1 = 0;
constexpr size_t OFF_WPW2 = OFF_WPW1 + al256((size_t)2 * 2048 * 1024 * 2);
constexpr size_t OFF_WQKV = OFF_WPW2 + al256((size_t)2 * 1024 * 1024 * 2);
constexpr size_t OFF_WO = OFF_WQKV + al256((size_t)2 * 3072 * 1024 * 2);
constexpr size_t OFF_WFIN = OFF_WO + al256((size_t)2 * 1024 * 1024 * 2);
constexpr size_t OFF_WFOUT = OFF_WFIN + al256((size_t)4 * 5632 * 1024 * 2);
constexpr size_t OFF_H = OFF_WFOUT + al256((size_t)4 * 1024 * FH * 2);
constexpr size_t OFF_NBUF = OFF_H + al256((size_t)T * 1024 * 4);
constexpr size_t OFF_BIG = OFF_NBUF + al256((size_t)T * 1024 * 2);
constexpr size_t OFF_VBUF = OFF_BIG + al256((size_t)T * 3072 * 2);
constexpr size_t OFF_MODV = OFF_VBUF + al256((size_t)T * 1024 * 2);
constexpr size_t OFF_ROPE = OFF_MODV + al256((size_t)4 * 9 * 6144 * 4);
constexpr size_t WS_NEED = OFF_ROPE + al256((size_t)1024 * 8);

struct Params {
  const float* in[22];
  float* outp;
  char* ws;
  __device__ __forceinline__ const float* x() const { return in[0]; }
  __device__ __forceinline__ const float* c() const { return in[1]; }
  __device__ __forceinline__ const float* ctx() const { return in[2]; }
  __device__ __forceinline__ const float* c_ctx() const { return in[3]; }
  __device__ __forceinline__ const float* mod_w() const { return in[4]; }
  __device__ __forceinline__ const float* mod_b() const { return in[5]; }
  __device__ __forceinline__ const float* norm_g() const { return in[6]; }
  __device__ __forceinline__ const float* pw1_w() const { return in[7]; }
  __device__ __forceinline__ const float* pw1_b() const { return in[8]; }
  __device__ __forceinline__ const float* dw_w() const { return in[9]; }
  __device__ __forceinline__ const float* dw_b() const { return in[10]; }
  __device__ __forceinline__ const float* ln_g() const { return in[11]; }
  __device__ __forceinline__ const float* ln_b() const { return in[12]; }
  __device__ __forceinline__ const float* pw2_w() const { return in[13]; }
  __device__ __forceinline__ const float* pw2_b() const { return in[14]; }
  __device__ __forceinline__ const float* wqkv() const { return in[15]; }
  __device__ __forceinline__ const float* lam() const { return in[16]; }
  __device__ __forceinline__ const float* subln() const { return in[17]; }
  __device__ __forceinline__ const float* wo() const { return in[18]; }
  __device__ __forceinline__ const float* ffn_in() const { return in[19]; }
  __device__ __forceinline__ const float* ffn_out() const { return in[20]; }
  __device__ __forceinline__ const float* final_g() const { return in[21]; }
  __device__ __forceinline__ float* out() const { return outp; }
  __device__ __forceinline__ u16* w_pw1() const { return (u16*)(ws + OFF_WPW1); }
  __device__ __forceinline__ u16* w_pw2() const { return (u16*)(ws + OFF_WPW2); }
  __device__ __forceinline__ u16* w_qkv() const { return (u16*)(ws + OFF_WQKV); }
  __device__ __forceinline__ u16* w_o() const { return (u16*)(ws + OFF_WO); }
  __device__ __forceinline__ u16* w_fin() const { return (u16*)(ws + OFF_WFIN); }
  __device__ __forceinline__ u16* w_fout() const { return (u16*)(ws + OFF_WFOUT); }
  __device__ __forceinline__ float* h() const { return (float*)(ws + OFF_H); }
  __device__ __forceinline__ u16* nbuf() const { return (u16*)(ws + OFF_NBUF); }
  __device__ __forceinline__ u16* big() const { return (u16*)(ws + OFF_BIG); }
  __device__ __forceinline__ u16* vbuf() const { return (u16*)(ws + OFF_VBUF); }
  __device__ __forceinline__ float* modv() const { return (float*)(ws + OFF_MODV); }
  __device__ __forceinline__ float2* rope() const { return (float2*)(ws + OFF_ROPE); }
};

typedef __bf16 bf2v __attribute__((ext_vector_type(2)));
typedef float f2v __attribute__((ext_vector_type(2)));
__device__ __forceinline__ unsigned pack2(float a, float b) {
  f2v v = {a, b};
  bf2v r = __builtin_convertvector(v, bf2v);
  return *(unsigned*)&r;
}
__device__ __forceinline__ u16 f2bf(float f) { return (u16)(pack2(f, 0.f) & 0xffffu); }
__device__ __forceinline__ float bf2f(unsigned v) { return __uint_as_float(v << 16); }
__device__ __forceinline__ int tile_off(int row, int chunk) { return row * 128 + (((chunk ^ row) & 7) << 4); }
__device__ __forceinline__ float fexp2(float x) { return __builtin_amdgcn_exp2f(x); }
__device__ __forceinline__ float sigmoidf_(float x) { return __builtin_amdgcn_rcpf(1.f + __expf(-x)); }

__device__ __forceinline__ int otid() { int t = threadIdx.x; asm volatile("" : "+v"(t)); return t; }

__device__ void wconv_item(const Params& p, int item, char* smem) {
  float* tl = (float*)smem;
  const int tid = otid();
  int K, N, half = 0, tpl, ntN, base;
  const float* src; u16* dst;
  if (item < 1024)      { base = 0;    K = 1024; N = 2048; half = 1024; tpl = 512;  ntN = 32; src = p.pw1_w();  dst = p.w_pw1(); }
  else if (item < 1536) { base = 1024; K = 1024; N = 1024;              tpl = 256;  ntN = 16; src = p.pw2_w();  dst = p.w_pw2(); }
  else if (item < 3072) { base = 1536; K = 1024; N = 3072;              tpl = 768;  ntN = 48; src = p.wqkv();   dst = p.w_qkv(); }
  else if (item < 3584) { base = 3072; K = 1024; N = 1024;              tpl = 256;  ntN = 16; src = p.wo();     dst = p.w_o(); }
  else if (item < 9216) { base = 3584; K = 1024; N = 5632; half = 2816; tpl = 1408; ntN = 88; src = p.ffn_in(); dst = p.w_fin(); }
  else                  { base = 9216; K = 2816; N = 1024;              tpl = 704;  ntN = 16; src = p.ffn_out(); dst = p.w_fout(); }
  int it = item - base;
  int l = it / tpl, rem = it % tpl, kt = rem / ntN, nt = rem % ntN;
  src += (size_t)l * K * N; dst += (size_t)l * K * N;
  {
    int nl = tid & 63, kk0 = tid >> 6;
    int np = nt * 64 + nl;
    int sc = np;
    if (half) { int blk = np >> 5, w = np & 31; sc = blk * 16 + (w & 15) + ((w >> 4) ? half : 0); }
    const float* sp = src + (size_t)(kt * 64) * N + sc;
#pragma unroll
    for (int i = 0; i < 16; ++i) { int kk = kk0 + 4 * i; tl[kk * 65 + nl] = sp[(size_t)kk * N]; }
  }
  __syncthreads();
  {
    int nl2 = tid >> 2, kq = tid & 3;
    unsigned pk[8];
#pragma unroll
    for (int e = 0; e < 8; ++e) {
      float a = tl[(kq * 16 + 2 * e) * 65 + nl2], b = tl[(kq * 16 + 2 * e + 1) * 65 + nl2];
      pk[e] = pack2(a, b);
    }
    uint4* dp = (uint4*)(dst + (size_t)(nt * 64 + nl2) * K + kt * 64 + kq * 16);
    dp[0] = make_uint4(pk[0], pk[1], pk[2], pk[3]);
    dp[1] = make_uint4(pk[4], pk[5], pk[6], pk[7]);
  }
  __syncthreads();
}

__device__ void prologue_phase(const Params& p, char* smem) {
  const int tid = otid(), wid = tid >> 6, lane = tid & 63;
  if (blockIdx.x < 384) {
    float* s = (float*)smem;
    float* red = (float*)(smem + 36864);
    for (int idx = tid; idx < 9 * 1024; idx += 256) {
      int r = idx >> 10, k = idx & 1023;
      float cv = r < 8 ? p.c()[r * 1024 + k] : p.c_ctx()[k];
      s[idx] = cv * sigmoidf_(cv);
    }
    __syncthreads();
    for (int item = blockIdx.x; item < 384; item += gridDim.x) {
      int i = item / 96, cgp = item % 96;
      float a[9];
#pragma unroll
      for (int r = 0; r < 9; ++r) a[r] = 0.f;
      const float* wp = p.mod_w() + ((size_t)i * 1024 + wid * 256) * 6144 + cgp * 64 + lane;
#pragma unroll 2
      for (int k4 = 0; k4 < 256; k4 += 4) {
        float w0 = wp[(size_t)(k4 + 0) * 6144], w1 = wp[(size_t)(k4 + 1) * 6144];
        float w2 = wp[(size_t)(k4 + 2) * 6144], w3 = wp[(size_t)(k4 + 3) * 6144];
#pragma unroll
        for (int r = 0; r < 9; ++r) {
          float4 sv = *(const float4*)&s[r * 1024 + wid * 256 + k4];
          a[r] += sv.x * w0 + sv.y * w1 + sv.z * w2 + sv.w * w3;
        }
      }
#pragma unroll
      for (int r = 0; r < 9; ++r) red[(wid * 9 + r) * 64 + lane] = a[r];
      __syncthreads();
      for (int idx = tid; idx < 9 * 64; idx += 256) {
        int r = idx >> 6, l = idx & 63;
        float v = red[(0 * 9 + r) * 64 + l] + red[(1 * 9 + r) * 64 + l] + red[(2 * 9 + r) * 64 + l] + red[(3 * 9 + r) * 64 + l];
        v += p.mod_b()[i * 6144 + cgp * 64 + l];
        p.modv()[((size_t)i * 9 + r) * 6144 + cgp * 64 + l] = v;
      }
      __syncthreads();
    }
  }
  if (blockIdx.x == gridDim.x - 1) {
    for (int idx = tid; idx < 1024; idx += 256) {
      int pos = idx >> 4, f = idx & 15;
      float inv = powf(10000.f, -(float)f / 16.f);
      float ang = (float)pos * inv;
      p.rope()[idx] = make_float2(cosf(ang), sinf(ang));
    }
  }
  for (int item = blockIdx.x; item < 12032; item += gridDim.x) wconv_item(p, item, smem);
  {
    const float4* x4 = (const float4*)p.x(); const float4* c4 = (const float4*)p.ctx(); float4* h4 = (float4*)p.h();
    for (int idx = blockIdx.x * 256 + tid; idx < T * 256; idx += gridDim.x * 256)
      h4[idx] = idx < TL * 256 ? x4[idx] : c4[idx - TL * 256];
  }
}

__device__ void norm_phase(const Params& p, int layer, int which, int M) {
  const int tid = otid(), wid = tid >> 6, lane = tid & 63;
  const float* g = p.norm_g() + (layer * 2 + which) * 1024;
  for (int row = blockIdx.x * 4 + wid; row < M; row += gridDim.x * 4) {
    int r = row < TL ? row / SEQ : 8;
    const float* mv = p.modv() + ((size_t)layer * 9 + r) * 6144;
    const float* sh = mv + (which ? 3 : 0) * 1024;
    const float* sc = mv + (which ? 4 : 1) * 1024;
    const float4* hp = (const float4*)(p.h() + (size_t)row * 1024);
    float4 v[4];
    float ss = 0.f;
#pragma unroll
    for (int i = 0; i < 4; ++i) { v[i] = hp[lane + 64 * i]; ss += v[i].x * v[i].x + v[i].y * v[i].y + v[i].z * v[i].z + v[i].w * v[i].w; }
#pragma unroll
    for (int o = 32; o >= 1; o >>= 1) ss += __shfl_xor(ss, o);
    float rstd = rsqrtf(ss * (1.f / 1024.f) + EPS);
    uint2* op = (uint2*)(p.nbuf() + (size_t)row * 1024);
#pragma unroll
    for (int i = 0; i < 4; ++i) {
      int c4 = lane + 64 * i;
      float4 gg = ((const float4*)g)[c4], s4 = ((const float4*)sc)[c4], h4 = ((const float4*)sh)[c4];
      float y0 = v[i].x * rstd * gg.x * (1.f + s4.x) + h4.x;
      float y1 = v[i].y * rstd * gg.y * (1.f + s4.y) + h4.y;
      float y2 = v[i].z * rstd * gg.z * (1.f + s4.z) + h4.z;
      float y3 = v[i].w * rstd * gg.w * (1.f + s4.w) + h4.w;
      op[c4] = make_uint2(pack2(y0, y1), pack2(y2, y3));
    }
  }
}

__device__ void final_phase(const Params& p) {
  const int tid = otid(), wid = tid >> 6, lane = tid & 63;
  for (int row = blockIdx.x * 4 + wid; row < TL; row += gridDim.x * 4) {
    const float4* hp = (const float4*)(p.h() + (size_t)row * 1024);
    float4 v[4];
    float ss = 0.f;
#pragma unroll
    for (int i = 0; i < 4; ++i) { v[i] = hp[lane + 64 * i]; ss += v[i].x * v[i].x + v[i].y * v[i].y + v[i].z * v[i].z + v[i].w * v[i].w; }
#pragma unroll
    for (int o = 32; o >= 1; o >>= 1) ss += __shfl_xor(ss, o);
    float rstd = rsqrtf(ss * (1.f / 1024.f) + EPS);
    float4* op = (float4*)(p.out() + (size_t)row * 1024);
#pragma unroll
    for (int i = 0; i < 4; ++i) {
      int c4 = lane + 64 * i;
      float4 gg = ((const float4*)p.final_g())[c4];
      float4 ov = make_float4(v[i].x * rstd * gg.x, v[i].y * rstd * gg.y, v[i].z * rstd * gg.z, v[i].w * rstd * gg.w);
      op[c4] = ov;
    }
  }
}

template <int K>
__device__ __forceinline__ void gemm_tile(const Params& p, const u16* __restrict__ A, const u16* __restrict__ Bt,
                          int mt, int nt, int EPI, int layer, int gidx, const float* __restrict__ bias, char* smem) {
  const int tid = otid(), wid = tid >> 6, lane = tid & 63, wr = wid >> 1, wc = wid & 1, fr = lane & 15, fq = lane >> 4;
  const int brow = mt * 128, bcol = nt * 128;
  f32x4 acc[4][4];
#pragma unroll
  for (int i = 0; i < 4; ++i)
#pragma unroll
    for (int j = 0; j < 4; ++j) acc[i][j] = f32x4{0.f, 0.f, 0.f, 0.f};
  constexpr int nk = K / 64;
  const int lrow = tid >> 3, lc = tid & 7;
  const u16* Ab = A + (size_t)brow * K;
  const u16* Bb = Bt + (size_t)bcol * K;
  const int toff = lrow * K + lc * 8;
  const int loff = tile_off(lrow, lc);
  u32x4 ra0_0, ra1_0, ra2_0, ra3_0, rb0_0, rb1_0, rb2_0, rb3_0;
  u32x4 ra0_1, ra1_1, ra2_1, ra3_1, rb0_1, rb1_1, rb2_1, rb3_1;
#define GLD(dst, ptr) dst = *(const u32x4*)(ptr)
#define G_LOAD(S, ko)                          \
  GLD(ra0_##S, pa + 0 * 32 * K + (ko));        \
  GLD(ra1_##S, pa + 1 * 32 * K + (ko));        \
  GLD(ra2_##S, pa + 2 * 32 * K + (ko));        \
  GLD(ra3_##S, pa + 3 * 32 * K + (ko));        \
  GLD(rb0_##S, pb + 0 * 32 * K + (ko));        \
  GLD(rb1_##S, pb + 1 * 32 * K + (ko));        \
  GLD(rb2_##S, pb + 2 * 32 * K + (ko));        \
  GLD(rb3_##S, pb + 3 * 32 * K + (ko));
#define VMWAIT(N, S)
#define L_STORE(S, base)                                                \
  *(u32x4*)((base) + loff + 0 * 4096) = ra0_##S;                          \
  *(u32x4*)((base) + loff + 1 * 4096) = ra1_##S;                          \
  *(u32x4*)((base) + loff + 2 * 4096) = ra2_##S;                          \
  *(u32x4*)((base) + loff + 3 * 4096) = ra3_##S;                          \
  *(u32x4*)((base) + 16384 + loff + 0 * 4096) = rb0_##S;                  \
  *(u32x4*)((base) + 16384 + loff + 1 * 4096) = rb1_##S;                  \
  *(u32x4*)((base) + 16384 + loff + 2 * 4096) = rb2_##S;                  \
  *(u32x4*)((base) + 16384 + loff + 3 * 4096) = rb3_##S;
#define MMA_TILE(As_, Bs_)                                                                        \
  {                                                                                               \
    bf16x8 a0[4], b0[4], a1[4], b1[4];                                                            \
    _Pragma("unroll") for (int mi = 0; mi < 4; ++mi) a0[mi] = *(const bf16x8*)((As_) + aoff + mi * 2048);        \
    _Pragma("unroll") for (int ni = 0; ni < 4; ++ni) b0[ni] = *(const bf16x8*)((Bs_) + boff + ni * 2048);        \
    __builtin_amdgcn_sched_barrier(0);                                                            \
    _Pragma("unroll") for (int mi = 0; mi < 4; ++mi) a1[mi] = *(const bf16x8*)((As_) + (aoff ^ 64) + mi * 2048); \
    _Pragma("unroll") for (int ni = 0; ni < 4; ++ni) b1[ni] = *(const bf16x8*)((Bs_) + (boff ^ 64) + ni * 2048); \
    __builtin_amdgcn_sched_barrier(0);                                                            \
    _Pragma("unroll") for (int mi = 0; mi < 4; ++mi)                                              \
      _Pragma("unroll") for (int ni = 0; ni < 4; ++ni)                                            \
        acc[mi][ni] = __builtin_amdgcn_mfma_f32_16x16x32_bf16(a0[mi], b0[ni], acc[mi][ni], 0, 0, 0); \
    __builtin_amdgcn_sched_barrier(0);                                                            \
    _Pragma("unroll") for (int mi = 0; mi < 4; ++mi)                                              \
      _Pragma("unroll") for (int ni = 0; ni < 4; ++ni)                                            \
        acc[mi][ni] = __builtin_amdgcn_mfma_f32_16x16x32_bf16(a1[mi], b1[ni], acc[mi][ni], 0, 0, 0); \
  }
  const int aoff = tile_off(wr * 64 + fr, fq);
  const int boff = tile_off(wc * 64 + fr, fq);
  const u16* pa = Ab + toff;
  const u16* pb = Bb + toff;
  G_LOAD(0, 0)
  VMWAIT(0, 0);
  L_STORE(0, smem)
  G_LOAD(1, 64)
  __syncthreads();
#pragma unroll 1
  for (int kt = 0; kt < nk; kt += 2) {
    if (kt + 2 < nk) { G_LOAD(0, (kt + 2) * 64) }
    __builtin_amdgcn_sched_barrier(0);
    MMA_TILE(smem, smem + 16384)
    __builtin_amdgcn_sched_barrier(0);
    if (kt + 2 < nk) { VMWAIT(8, 1); } else { VMWAIT(0, 1); }
    L_STORE(1, smem + 32768)
    __syncthreads();
    if (kt + 3 < nk) { G_LOAD(1, (kt + 3) * 64) }
    __builtin_amdgcn_sched_barrier(0);
    MMA_TILE(smem + 32768, smem + 32768 + 16384)
    __builtin_amdgcn_sched_barrier(0);
    if (kt + 2 < nk) {
      if (kt + 3 < nk) { VMWAIT(8, 0); } else { VMWAIT(0, 0); }
      L_STORE(0, smem)
    }
    __syncthreads();
  }
#undef GLD
#undef VMWAIT
#undef G_LOAD
#undef L_STORE
#undef MMA_TILE
  const int r0 = brow + wr * 64;
  char* stg = smem + wid * 16384;
  if (EPI == 99) {
  } else if (EPI == 0 || EPI == 3) {
    const int OW = (EPI == 0) ? 1024 : FH;
    u16* outp = p.big();
    const int jch0 = (bcol + wc * 64) >> 1;
#pragma unroll
    for (int pp = 0; pp < 2; ++pp) {
      float b0 = 0.f, b1 = 0.f;
      if (bias) { b0 = bias[jch0 + pp * 16 + fr]; b1 = bias[1024 + jch0 + pp * 16 + fr]; }
#pragma unroll
      for (int mi = 0; mi < 4; ++mi)
#pragma unroll
        for (int j = 0; j < 4; ++j) {
          float a = acc[mi][2 * pp][j] + b0, g = acc[mi][2 * pp + 1][j] + b1;
          float sg = sigmoidf_(EPI == 0 ? g : a);
          float v = (EPI == 0) ? a * sg : a * sg * g;
          *(u16*)(stg + (mi * 16 + fq * 4 + j) * 80 + (pp * 16 + fr) * 2) = f2bf(v);
        }
    }
    __syncthreads();
#pragma unroll
    for (int it = 0; it < 4; ++it) {
      const int row = it * 16 + (lane >> 2), ch = lane & 3;
      u32x4 val = *(const u32x4*)(stg + row * 80 + ch * 16);
      *(u32x4*)(outp + (size_t)(r0 + row) * OW + jch0 + ch * 8) = val;
    }
    __syncthreads();
  } else if (EPI == 2) {
    const int r = brow < TL ? brow / SEQ : 8;
    const float* gate = p.modv() + ((size_t)layer * 9 + r) * 6144 + gidx * 1024;
#pragma unroll
    for (int ni = 0; ni < 4; ++ni) {
      int col = bcol + wc * 64 + ni * 16 + fr;
      float gt = gate[col];
      float bs = bias ? bias[col] : 0.f;
#pragma unroll
      for (int mi = 0; mi < 4; ++mi) {
#pragma unroll
        for (int j = 0; j < 4; ++j) {
          int row = r0 + mi * 16 + fq * 4 + j;
          float* hp = p.h() + (size_t)row * 1024 + col;          *hp = *hp + gt * (acc[mi][ni][j] + bs);
        }
        asm volatile("" ::: "memory");
      }
    }
  } else {
    const int region = nt >> 3, hd = nt & 7;
    const bool lat = brow < TL;
    const int b = lat ? brow / SEQ : (brow - TL) / CTX;
    const int kb = lat ? 256 + (r0 - b * SEQ) : (r0 - TL - b * CTX);
    const size_t bh = (size_t)(b * 8 + hd);
    u16* qb = p.big(); u16* kbuf = p.big() + (size_t)T * 1024; u16* vt = p.big() + (size_t)T * 2048;
    if (region < 2) {
      u16* dst = (region == 0 ? qb : kbuf) + ((bh * 2 + wc) * KEYS + kb) * 64;
      const float qs = region == 0 ? 0.125f * 1.44269504088896f : 1.f;
#pragma unroll
      for (int mi = 0; mi < 4; ++mi)
#pragma unroll
        for (int j = 0; j < 4; ++j) {
          int rl = mi * 16 + fq * 4 + j;
          float x0 = acc[mi][0][j], x1 = acc[mi][1][j], x2 = acc[mi][2][j], x3 = acc[mi][3][j];
          if (lat) {
            int t = kb - 256 + rl;
            float2 cr = p.rope()[(t >> 6) * 16 + fr], cc = p.rope()[(t & 63) * 16 + fr];
            float y0 = x0 * cr.x - x1 * cr.y, y1 = x1 * cr.x + x0 * cr.y;
            float y2 = x2 * cc.x - x3 * cc.y, y3 = x3 * cc.x + x2 * cc.y;
            x0 = y0; x1 = y1; x2 = y2; x3 = y3;
          }
          char* sp = stg + rl * 144 + fr * 2;
          *(u16*)(sp) = f2bf(x0 * qs); *(u16*)(sp + 32) = f2bf(x1 * qs); *(u16*)(sp + 64) = f2bf(x2 * qs); *(u16*)(sp + 96) = f2bf(x3 * qs);
        }
      __syncthreads();
#pragma unroll
      for (int it = 0; it < 8; ++it) {
        const int row = it * 8 + (lane >> 3), ch = lane & 7;
        u32x4 val = *(const u32x4*)(stg + row * 144 + ch * 16);
        *(u32x4*)(dst + (size_t)row * 64 + ch * 8) = val;
      }
      __syncthreads();
    } else {
#pragma unroll
      for (int ni = 0; ni < 4; ++ni) {
        const int e = ni * 16 + fr;
#pragma unroll
        for (int mi = 0; mi < 4; ++mi) {
          int slot = (mi >> 1) * 32 + fq * 8 + (mi & 1) * 4;
          *(uint2*)(stg + e * 144 + slot * 2) = make_uint2(pack2(acc[mi][ni][0], acc[mi][ni][1]), pack2(acc[mi][ni][2], acc[mi][ni][3]));
        }
      }
      __syncthreads();
      u16* dp = vt + (bh * 128 + wc * 64) * KEYS + kb;
#pragma unroll
      for (int it = 0; it < 8; ++it) {
        const int row = it * 8 + (lane >> 3), ch = lane & 7;
        u32x4 val = *(const u32x4*)(stg + row * 144 + ch * 16);
        *(u32x4*)(dp + (size_t)row * KEYS + ch * 8) = val;
      }
      __syncthreads();
    }
  }
}

__device__ void gemm_phase(const Params& p, const u16* A, const u16* Bt, int K, int Mt, int Nt, int epi, int layer, int gidx,
                           const float* bias, char* smem) {
  const int xcd = blockIdx.x & 7, rank = blockIdx.x >> 3, rpx = gridDim.x >> 3;
  const int SN = (Nt & 7) == 0 ? 8 : 4, SM = 64 / SN;
  const int nsn = Nt / SN, total_s = (Mt / SM) * nsn;
  for (int sidx = xcd; sidx < total_s; sidx += 8) {
    const int ms = sidx / nsn, ns = sidx % nsn;
    for (int q = rank; q < 64; q += rpx) {
      const int mt = ms * SM + q / SN, nt = ns * SN + q % SN;
      if (K == 1024) gemm_tile<1024>(p, A, Bt, mt, nt, epi, layer, gidx, bias, smem);
      else gemm_tile<FH>(p, A, Bt, mt, nt, 2, layer, gidx, bias, smem);
    }
  }
}

__device__ void conv_phase(const Params& p, int j, int M, char* smem) {
  const int tid = otid(), wid = tid >> 6, lane = tid & 63;
  float* cbuf = (float*)smem;
  const u16* U = p.big();
  for (int item = blockIdx.x; item < M / 8; item += gridDim.x) {
    const int t0 = item * 8;
    int s0, s1;
    if (t0 < TL) { s0 = (t0 / SEQ) * SEQ; s1 = s0 + SEQ; } else { s0 = TL + ((t0 - TL) / CTX) * CTX; s1 = s0 + CTX; }
#pragma unroll 1
    for (int g = 0; g < 2; ++g) {
      const int c = g * 512 + tid * 2;
      float acc[8][2];
      float w[31][2];
#pragma unroll
      for (int k = 0; k < 31; ++k) { float2 wv = *(const float2*)(p.dw_w() + ((size_t)j * 31 + k) * 1024 + c); w[k][0] = wv.x; w[k][1] = wv.y; }
      float2 bv = *(const float2*)(p.dw_b() + j * 1024 + c);
#pragma unroll
      for (int o = 0; o < 8; ++o) { acc[o][0] = bv.x; acc[o][1] = bv.y; }
#pragma unroll
      for (int ti = 0; ti < 38; ++ti) {
        int tin = t0 - 15 + ti;
        bool valid = tin >= s0 && tin < s1;
        int tc = min(max(tin, s0), s1 - 1);
        unsigned raw = *(const unsigned*)(U + (size_t)tc * 1024 + c);
        if (!valid) raw = 0u;
        float x0 = bf2f(raw & 0xffffu), x1 = bf2f(raw >> 16);
#pragma unroll
        for (int o = 0; o < 8; ++o) {
          const int k = ti - o;
          if (k >= 0 && k < 31) { acc[o][0] += x0 * w[k][0]; acc[o][1] += x1 * w[k][1]; }
        }
      }
#pragma unroll
      for (int o = 0; o < 8; ++o) *(float2*)(cbuf + o * 1024 + c) = make_float2(acc[o][0], acc[o][1]);
    }
    __syncthreads();
#pragma unroll
    for (int tt = 0; tt < 2; ++tt) {
      const int o = wid * 2 + tt;
      float4 v[4];
      float sm = 0.f;
#pragma unroll
      for (int i = 0; i < 4; ++i) { v[i] = *(const float4*)(cbuf + o * 1024 + (lane + 64 * i) * 4); sm += v[i].x + v[i].y + v[i].z + v[i].w; }
#pragma unroll
      for (int sh = 32; sh >= 1; sh >>= 1) sm += __shfl_xor(sm, sh);
      const float mean = sm * (1.f / 1024.f);
      float sq = 0.f;
#pragma unroll
      for (int i = 0; i < 4; ++i) {
        v[i].x -= mean; v[i].y -= mean; v[i].z -= mean; v[i].w -= mean;
        sq += v[i].x * v[i].x + v[i].y * v[i].y + v[i].z * v[i].z + v[i].w * v[i].w;
      }
#pragma unroll
      for (int sh = 32; sh >= 1; sh >>= 1) sq += __shfl_xor(sq, sh);
      const float rstd = rsqrtf(sq * (1.f / 1024.f) + EPS);
      uint2* op = (uint2*)(p.vbuf() + (size_t)(t0 + o) * 1024);
#pragma unroll
      for (int i = 0; i < 4; ++i) {
        int c4 = lane + 64 * i;
        float4 lg = ((const float4*)(p.ln_g() + j * 1024))[c4], lb = ((const float4*)(p.ln_b() + j * 1024))[c4];
        float y0 = v[i].x * rstd * lg.x + lb.x, y1 = v[i].y * rstd * lg.y + lb.y;
        float y2 = v[i].z * rstd * lg.z + lb.z, y3 = v[i].w * rstd * lg.w + lb.w;
        y0 *= sigmoidf_(y0); y1 *= sigmoidf_(y1); y2 *= sigmoidf_(y2); y3 *= sigmoidf_(y3);
        op[c4] = make_uint2(pack2(y0, y1), pack2(y2, y3));
      }
    }
    __syncthreads();
  }
}

__device__ void attn_item(const Params& p, int b, int hd, int q0, int nkeys, int out_row0, float lam, float oscale,
                          const float* __restrict__ subg, char* smem) {
  const int tid = otid(), wid = tid >> 6, lane = tid & 63, fr = lane & 15, fq = lane >> 4;
  const int comp = wid & 1, qg = wid >> 1;
  const size_t bh = (size_t)(b * 8 + hd);
  const u16* qb = p.big(); const u16* kbuf = p.big() + (size_t)T * 1024; const u16* vtb = p.big() + (size_t)T * 2048;
  const u16* Qp = qb + ((bh * 2 + comp) * KEYS + q0 + qg * 32) * 64;
  bf16x8 qf[2][2];
#pragma unroll
  for (int qs = 0; qs < 2; ++qs)
#pragma unroll
    for (int ks = 0; ks < 2; ++ks) qf[qs][ks] = *(const bf16x8*)(Qp + (qs * 16 + fr) * 64 + ks * 32 + fq * 8);
  const u16* K1p = kbuf + (bh * 2 + 0) * KEYS * 64;
  const u16* K2p = kbuf + (bh * 2 + 1) * KEYS * 64;
  const u16* Vp = vtb + bh * 128 * KEYS;
  const int lrow = tid >> 3, lc = tid & 7;
  uint4 rg[8];
#define ATT_GLOAD(kt_)                                                                         \
  {                                                                                            \
    const int key0 = (kt_) * 64;                                                               \
    _Pragma("unroll") for (int i = 0; i < 2; ++i) {                                            \
      rg[i] = *(const uint4*)(K1p + (size_t)(key0 + lrow + i * 32) * 64 + lc * 8);             \
      rg[2 + i] = *(const uint4*)(K2p + (size_t)(key0 + lrow + i * 32) * 64 + lc * 8);         \
    }                                                                                          \
    _Pragma("unroll") for (int i = 0; i < 4; ++i)                                              \
      rg[4 + i] = *(const uint4*)(Vp + (size_t)(lrow + i * 32) * KEYS + key0 + lc * 8);        \
  }
#define ATT_LSTORE(buf_)                                                                       \
  {                                                                                            \
    char* bs_ = smem + (buf_) * 32768;                                                         \
    _Pragma("unroll") for (int i = 0; i < 2; ++i) {                                            \
      *(uint4*)(bs_ + tile_off(lrow + i * 32, lc)) = rg[i];                                    \
      *(uint4*)(bs_ + 8192 + tile_off(lrow + i * 32, lc)) = rg[2 + i];                         \
    }                                                                                          \
    _Pragma("unroll") for (int i = 0; i < 4; ++i)                                              \
      *(uint4*)(bs_ + 16384 + tile_off(lrow + i * 32, lc)) = rg[4 + i];                        \
  }
  f32x4 O[8][2];
#pragma unroll
  for (int e = 0; e < 8; ++e) { O[e][0] = f32x4{0.f, 0.f, 0.f, 0.f}; O[e][1] = f32x4{0.f, 0.f, 0.f, 0.f}; }
  float m[2] = {-1e30f, -1e30f}, l[2] = {0.f, 0.f};
  const int ntile = nkeys >> 6;
  ATT_GLOAD(0);
  ATT_LSTORE(0);
  __syncthreads();
  for (int kt = 0; kt < ntile; ++kt) {
    const int cur = kt & 1;
    if (kt + 1 < ntile) ATT_GLOAD(kt + 1);
    const char* base = smem + cur * 32768;
    const char* Kc = base + comp * 8192;
    const char* Vt = base + 16384;
    f32x4 S[4][2];
#pragma unroll
    for (int i = 0; i < 4; ++i) { S[i][0] = f32x4{0.f, 0.f, 0.f, 0.f}; S[i][1] = f32x4{0.f, 0.f, 0.f, 0.f}; }
#pragma unroll
    for (int ks = 0; ks < 2; ++ks)
#pragma unroll
      for (int ksub = 0; ksub < 4; ++ksub) {
        bf16x8 kf = *(const bf16x8*)(Kc + tile_off(ksub * 16 + fr, ks * 4 + fq));
#pragma unroll
        for (int qs = 0; qs < 2; ++qs) S[ksub][qs] = __builtin_amdgcn_mfma_f32_16x16x32_bf16(kf, qf[qs][ks], S[ksub][qs], 0, 0, 0);
      }
#pragma unroll
    for (int qs = 0; qs < 2; ++qs) {
      float mx = -1e30f;
#pragma unroll
      for (int ksub = 0; ksub < 4; ++ksub)
#pragma unroll
        for (int j = 0; j < 4; ++j) mx = fmaxf(mx, S[ksub][qs][j]);
      mx = fmaxf(mx, __shfl_xor(mx, 16));
      mx = fmaxf(mx, __shfl_xor(mx, 32));
      float mn = fmaxf(m[qs], mx);
      float alpha = fexp2(m[qs] - mn);
      m[qs] = mn;
      float rs = 0.f;
#pragma unroll
      for (int ksub = 0; ksub < 4; ++ksub)
#pragma unroll
        for (int j = 0; j < 4; ++j) { float pv = fexp2(S[ksub][qs][j] - mn); S[ksub][qs][j] = pv; rs += pv; }
      l[qs] = l[qs] * alpha + rs;
      if (__builtin_amdgcn_ballot_w64(alpha != 1.f) != 0) {
#pragma unroll
        for (int e = 0; e < 8; ++e) O[e][qs] *= alpha;
      }
    }
    bf16x8 pf[2][2];
#pragma unroll
    for (int qs = 0; qs < 2; ++qs)
#pragma unroll
      for (int s = 0; s < 2; ++s) {
        unsigned u0 = pack2(S[2 * s][qs][0], S[2 * s][qs][1]), u1 = pack2(S[2 * s][qs][2], S[2 * s][qs][3]);
        unsigned u2 = pack2(S[2 * s + 1][qs][0], S[2 * s + 1][qs][1]), u3 = pack2(S[2 * s + 1][qs][2], S[2 * s + 1][qs][3]);
        uint4 uu = make_uint4(u0, u1, u2, u3);
        pf[qs][s] = *(bf16x8*)&uu;
      }
#pragma unroll
    for (int s = 0; s < 2; ++s)
#pragma unroll
      for (int e = 0; e < 8; ++e) {
        bf16x8 vf = *(const bf16x8*)(Vt + tile_off(e * 16 + fr, s * 4 + fq));
#pragma unroll
        for (int qs = 0; qs < 2; ++qs) O[e][qs] = __builtin_amdgcn_mfma_f32_16x16x32_bf16(vf, pf[qs][s], O[e][qs], 0, 0, 0);
      }
    if (kt + 1 < ntile) ATT_LSTORE(cur ^ 1);
    __syncthreads();
  }
#undef ATT_GLOAD
#undef ATT_LSTORE
#pragma unroll
  for (int qs = 0; qs < 2; ++qs) {
    float ls = l[qs];
    ls += __shfl_xor(ls, 16);
    ls += __shfl_xor(ls, 32);
    float inv = (comp ? lam : 1.f) / ls;
#pragma unroll
    for (int e = 0; e < 8; ++e) O[e][qs] *= inv;
  }
  float* ex = (float*)smem;
  if (comp == 1) {
#pragma unroll
    for (int e = 0; e < 8; ++e)
#pragma unroll
      for (int qs = 0; qs < 2; ++qs) *(f32x4*)(ex + ((((qg * 8 + e) * 2 + qs) * 64 + lane) << 2)) = O[e][qs];
  }
  __syncthreads();
  if (comp == 0) {
#pragma unroll
    for (int qs = 0; qs < 2; ++qs) {
      float ssq = 0.f;
#pragma unroll
      for (int e = 0; e < 8; ++e) {
        f32x4 o2 = *(const f32x4*)(ex + ((((qg * 8 + e) * 2 + qs) * 64 + lane) << 2));
        O[e][qs] -= o2;
#pragma unroll
        for (int j = 0; j < 4; ++j) ssq += O[e][qs][j] * O[e][qs][j];
      }
      ssq += __shfl_xor(ssq, 16);
      ssq += __shfl_xor(ssq, 32);
      float rstd = rsqrtf(ssq * (1.f / 128.f) + EPS) * oscale;
      u16* op = p.vbuf() + (size_t)(out_row0 + qg * 32 + qs * 16 + fr) * 1024 + hd * 128 + fq * 4;
#pragma unroll
      for (int e = 0; e < 8; ++e) {
        float4 sg = *(const float4*)(subg + e * 16 + fq * 4);
        *(uint2*)(op + e * 16) = make_uint2(pack2(O[e][qs][0] * rstd * sg.x, O[e][qs][1] * rstd * sg.y),
                                            pack2(O[e][qs][2] * rstd * sg.z, O[e][qs][3] * rstd * sg.w));
      }
    }
  }
  __syncthreads();
}

__device__ void attn_phase(const Params& p, int layer, bool with_ctx, char* smem) {
  const int ja = layer >> 1;
  const float* lv = p.lam() + ja * 256;
  float d01 = 0.f, d23 = 0.f;
  for (int i = 0; i < 64; ++i) { d01 += lv[i] * lv[64 + i]; d23 += lv[128 + i] * lv[192 + i]; }
  const float lam_init = 0.8f - 0.6f * expf(-0.3f * (float)layer);
  const float lam = expf(d01) - expf(d23) + lam_init;
  const float* subg = p.subln() + ja * 128;
  {
    const int xcd = blockIdx.x & 7, rank = blockIdx.x >> 3, rpx = gridDim.x >> 3;
    for (int r = 0; r < 4; ++r)
      for (int q = rank; q < 64; q += rpx) {
        const int bh = r * 16 + xcd * 2 + (q >> 5), qt = q & 31;
        const int b = bh >> 3, hd = bh & 7;
        attn_item(p, b, hd, 256 + qt * 64, KEYS, b * SEQ + qt * 64, lam, 1.f - lam_init, subg, smem);
      }
  }
  if (with_ctx) {
    for (int it = blockIdx.x; it < 256; it += gridDim.x) {
      const int qt = it & 3, hd = (it >> 2) & 7, b = it >> 5;
      attn_item(p, b, hd, qt * 64, CTX, TL + b * CTX + qt * 64, lam, 1.f - lam_init, subg, smem);
    }
  }
}

__device__ void run_phase(const Params& p, int ph_in, char* smem) {
  const int ph = ph_in & 0xffff; const bool noepi = (ph_in >> 16) != 0;
  if (ph == 0) { prologue_phase(p, smem); return; }
  if (ph == NPH - 1) { final_phase(p); return; }
  const int layer = (ph - 1) / 7, sub = (ph - 1) % 7;
  const bool last = layer == DEPTH - 1;
  const int M = last ? TL : T;
  const bool is_conv = (layer & 1) == 0;
  const int j = layer >> 1;
  if (sub == 0 || sub == 4) { norm_phase(p, layer, sub == 4 ? 1 : 0, sub == 0 ? T : M); return; }
  if (sub == 2) {
    if (is_conv) conv_phase(p, j, T, smem);
    else attn_phase(p, layer, !last, smem);
    return;
  }
  const u16 *A, *Bt; int K = 1024, Nt, epi, gidx = 0, mtiles = M / 128; const float* bias = nullptr;
  if (sub == 1) {
    A = p.nbuf(); mtiles = T / 128;
    if (is_conv) { Bt = p.w_pw1() + (size_t)j * 2048 * 1024; Nt = 16; epi = 0; bias = p.pw1_b() + j * 2048; }
    else { Bt = p.w_qkv() + (size_t)j * 3072 * 1024; Nt = 24; epi = 1; }
  } else if (sub == 3) {
    A = p.vbuf(); Nt = 8; epi = 2; gidx = 2;
    if (is_conv) { Bt = p.w_pw2() + (size_t)j * 1024 * 1024; bias = p.pw2_b() + j * 1024; }
    else Bt = p.w_o() + (size_t)j * 1024 * 1024;
  } else if (sub == 5) {
    A = p.nbuf(); Bt = p.w_fin() + (size_t)layer * 5632 * 1024; Nt = 44; epi = 3;
  } else {
    A = p.big(); Bt = p.w_fout() + (size_t)layer * 1024 * FH; K = FH; Nt = 8; epi = 2; gidx = 5;
  }
  gemm_phase(p, A, Bt, K, mtiles, Nt, noepi ? 99 : epi, layer, gidx, bias, smem);
}

__device__ __forceinline__ void grid_barrier(unsigned* ctr, unsigned target) {
  __syncthreads();
  if (threadIdx.x == 0) {
    __threadfence();
    __hip_atomic_fetch_add(ctr, 1u, __ATOMIC_RELAXED, __HIP_MEMORY_SCOPE_AGENT);
    while (__hip_atomic_load(ctr, __ATOMIC_RELAXED, __HIP_MEMORY_SCOPE_AGENT) < target) __builtin_amdgcn_s_sleep(2);
    __threadfence();
  }
  __syncthreads();
}

__global__ void __launch_bounds__(256, 2) mega(Params p, int ph_begin, int ph_end, int use_sync) {
  __shared__ __attribute__((aligned(16))) char smem[65536];
  cg::grid_group grid = cg::this_grid();
  unsigned* bar = (unsigned*)(p.ws + WS_NEED);
  unsigned target = 0;
  for (int ph = ph_begin; ph < ph_end; ++ph) {
    run_phase(p, ph, smem);
    if (use_sync && ph + 1 < ph_end) {
      if (ph == ph_begin) grid.sync();
      else { target += gridDim.x; grid_barrier(bar, target); }
    }
  }
}

extern "C" void kernel_launch(void* const* d_in, const int* in_sizes, int n_in, void* d_out, int out_size, void* d_ws,
                              size_t ws_size, hipStream_t stream) {
  Params p{};
  for (int i = 0; i < 22; ++i) p.in[i] = (const float*)d_in[i];
  p.outp = (float*)d_out;
  p.ws = (char*)d_ws;
  if (WS_NEED + 256 > ws_size || n_in < 22) return;
  static int grid_blocks = 0;
  if (!grid_blocks) {
    int dev = 0, cus = 0, per_cu = 0;
    hipGetDevice(&dev);
    hipDeviceGetAttribute(&cus, hipDeviceAttributeMultiprocessorCount, dev);
    hipOccupancyMaxActiveBlocksPerMultiprocessor(&per_cu, mega, 256, 0);
    if (per_cu > 2) per_cu = 2;
    if (per_cu < 1) per_cu = 1;
    grid_blocks = cus * per_cu;
  }
#if MULTI_LAUNCH
  for (int ph = 0; ph < NPH; ++ph) mega<<<grid_blocks, 256, 0, stream>>>(p, ph, ph + 1, 0);
#else
  hipMemsetAsync((char*)d_ws + WS_NEED, 0, 256, stream);
  int b = 0, e = NPH, s = 1;
  void* args[] = {&p, &b, &e, &s};
  hipError_t err = hipLaunchCooperativeKernel((void*)mega, dim3(grid_blocks), dim3(256), args, 0, stream);
  if (err != hipSuccess) fprintf(stderr, "cooperative launch failed: %s (grid %d)\n", hipGetErrorString(err), grid_blocks);
#endif
}
```

```cpp
#include <hip/hip_runtime.h>
#include <hip/hip_cooperative_groups.h>
#include <cstdio>
namespace cg = cooperative_groups;

#ifndef DUP_FLAG
#define DUP_FLAG 0
#endif
#ifndef MULTI_LAUNCH
#define MULTI_LAUNCH 0
#endif

typedef unsigned short u16;
using bf16x8 = __attribute__((ext_vector_type(8))) short;
using f32x4 = __attribute__((ext_vector_type(4))) float;
using u32x4 = __attribute__((ext_vector_type(4))) unsigned;

constexpr int D = 1024, NB = 8, SEQ = 2048, CTX = 256, DEPTH = 4;
constexpr int TL = NB * SEQ;
constexpr int TCX = NB * CTX;
constexpr int T = TL + TCX;
constexpr int FH = 2816;
constexpr int KEYS = CTX + SEQ;
constexpr int NPH = 2 + 7 * DEPTH;
constexpr float EPS = 1e-6f;

constexpr size_t al256(size_t x) { return (x + 255) & ~(size_t)255; }
constexpr size_t OFF_WPW1 = 0;
constexpr size_t OFF_WPW2 = OFF_WPW1 + al256((size_t)2 * 2048 * 1024 * 2);
constexpr size_t OFF_WQKV = OFF_WPW2 + al256((size_t)2 * 1024 * 1024 * 2);
constexpr size_t OFF_WO = OFF_WQKV + al256((size_t)2 * 3072 * 1024 * 2);
constexpr size_t OFF_WFIN = OFF_WO + al256((size_t)2 * 1024 * 1024 * 2);
constexpr size_t OFF_WFOUT = OFF_WFIN + al256((size_t)4 * 5632 * 1024 * 2);
constexpr size_t OFF_H = OFF_WFOUT + al256((size_t)4 * 1024 * FH * 2);
constexpr size_t OFF_NBUF = OFF_H + al256((size_t)T * 1024 * 4);
constexpr size_t OFF_BIG = OFF_NBUF + al256((size_t)T * 1024 * 2);
constexpr size_t OFF_VBUF = OFF_BIG + al256((size_t)T * 3072 * 2);
constexpr size_t OFF_MODV = OFF_VBUF + al256((size_t)T * 1024 * 2);
constexpr size_t OFF_ROPE = OFF_MODV + al256((size_t)4 * 9 * 6144 * 4);
constexpr size_t WS_NEED = OFF_ROPE + al256((size_t)1024 * 8);

struct Params {
  const float* in[22];
  float* outp;
  char* ws;
  __device__ __forceinline__ const float* x() const { return in[0]; }
  __device__ __forceinline__ const float* c() const { return in[1]; }
  __device__ __forceinline__ const float* ctx() const { return in[2]; }
  __device__ __forceinline__ const float* c_ctx() const { return in[3]; }
  __device__ __forceinline__ const float* mod_w() const { return in[4]; }
  __device__ __forceinline__ const float* mod_b() const { return in[5]; }
  __device__ __forceinline__ const float* norm_g() const { return in[6]; }
  __device__ __forceinline__ const float* pw1_w() const { return in[7]; }
  __device__ __forceinline__ const float* pw1_b() const { return in[8]; }
  __device__ __forceinline__ const float* dw_w() const { return in[9]; }
  __device__ __forceinline__ const float* dw_b() const { return in[10]; }
  __device__ __forceinline__ const float* ln_g() const { return in[11]; }
  __device__ __forceinline__ const float* ln_b() const { return in[12]; }
  __device__ __forceinline__ const float* pw2_w() const { return in[13]; }
  __device__ __forceinline__ const float* pw2_b() const { return in[14]; }
  __device__ __forceinline__ const float* wqkv() const { return in[15]; }
  __device__ __forceinline__ const float* lam() const { return in[16]; }
  __device__ __forceinline__ const float* subln() const { return in[17]; }
  __device__ __forceinline__ const float* wo() const { return in[18]; }
  __device__ __forceinline__ const float* ffn_in() const { return in[19]; }
  __device__ __forceinline__ const float* ffn_out() const { return in[20]; }
  __device__ __forceinline__ const float* final_g() const { return in[21]; }
  __device__ __forceinline__ float* out() const { return outp; }
  __device__ __forceinline__ u16* w_pw1() const { return (u16*)(ws + OFF_WPW1); }
  __device__ __forceinline__ u16* w_pw2() const { return (u16*)(ws + OFF_WPW2); }
  __device__ __forceinline__ u16* w_qkv() const { return (u16*)(ws + OFF_WQKV); }
  __device__ __forceinline__ u16* w_o() const { return (u16*)(ws + OFF_WO); }
  __device__ __forceinline__ u16* w_fin() const { return (u16*)(ws + OFF_WFIN); }
  __device__ __forceinline__ u16* w_fout() const { return (u16*)(ws + OFF_WFOUT); }
  __device__ __forceinline__ float* h() const { return (float*)(ws + OFF_H); }
  __device__ __forceinline__ u16* nbuf() const { return (u16*)(ws + OFF_NBUF); }
  __device__ __forceinline__ u16* big() const { return (u16*)(ws + OFF_BIG); }
  __device__ __forceinline__ u16* vbuf() const { return (u16*)(ws + OFF_VBUF); }
  __device__ __forceinline__ float* modv() const { return (float*)(ws + OFF_MODV); }
  __device__ __forceinline__ float2* rope() const { return (float2*)(ws + OFF_ROPE); }
};

typedef __bf16 bf2v __attribute__((ext_vector_type(2)));
typedef float f2v __attribute__((ext_vector_type(2)));
__device__ __forceinline__ unsigned pack2(float a, float b) {
  f2v v = {a, b};
  bf2v r = __builtin_convertvector(v, bf2v);
  return *(unsigned*)&r;
}
__device__ __forceinline__ u16 f2bf(float f) { return (u16)(pack2(f, 0.f) & 0xffffu); }
__device__ __forceinline__ float bf2f(unsigned v) { return __uint_as_float(v << 16); }
__device__ __forceinline__ int tile_off(int row, int chunk) { return row * 128 + (((chunk ^ row) & 7) << 4); }
__device__ __forceinline__ float fexp2(float x) { return __builtin_amdgcn_exp2f(x); }
__device__ __forceinline__ float sigmoidf_(float x) { return __builtin_amdgcn_rcpf(1.f + __expf(-x)); }

__device__ __forceinline__ int otid() { int t = threadIdx.x; asm volatile("" : "+v"(t)); return t; }

__device__ void wconv_item(const Params& p, int item, char* smem) {
  float* tl = (float*)smem;
  const int tid = otid();
  int K, N, half = 0, tpl, ntN, base;
  const float* src; u16* dst;
  if (item < 1024)      { base = 0;    K = 1024; N = 2048; half = 1024; tpl = 512;  ntN = 32; src = p.pw1_w();  dst = p.w_pw1(); }
  else if (item < 1536) { base = 1024; K = 1024; N = 1024;              tpl = 256;  ntN = 16; src = p.pw2_w();  dst = p.w_pw2(); }
  else if (item < 3072) { base = 1536; K = 1024; N = 3072;              tpl = 768;  ntN = 48; src = p.wqkv();   dst = p.w_qkv(); }
  else if (item < 3584) { base = 3072; K = 1024; N = 1024;              tpl = 256;  ntN = 16; src = p.wo();     dst = p.w_o(); }
  else if (item < 9216) { base = 3584; K = 1024; N = 5632; half = 2816; tpl = 1408; ntN = 88; src = p.ffn_in(); dst = p.w_fin(); }
  else                  { base = 9216; K = 2816; N = 1024;              tpl = 704;  ntN = 16; src = p.ffn_out(); dst = p.w_fout(); }
  int it = item - base;
  int l = it / tpl, rem = it % tpl, kt = rem / ntN, nt = rem % ntN;
  src += (size_t)l * K * N; dst += (size_t)l * K * N;
  {
    int nl = tid & 63, kk0 = tid >> 6;
    int np = nt * 64 + nl;
    int sc = np;
    if (half) { int blk = np >> 5, w = np & 31; sc = blk * 16 + (w & 15) + ((w >> 4) ? half : 0); }
    const float* sp = src + (size_t)(kt * 64) * N + sc;
#pragma unroll
    for (int i = 0; i < 16; ++i) { int kk = kk0 + 4 * i; tl[kk * 65 + nl] = sp[(size_t)kk * N]; }
  }
  __syncthreads();
  {
    int nl2 = tid >> 2, kq = tid & 3;
    unsigned pk[8];
#pragma unroll
    for (int e = 0; e < 8; ++e) {
      float a = tl[(kq * 16 + 2 * e) * 65 + nl2], b = tl[(kq * 16 + 2 * e + 1) * 65 + nl2];
      pk[e] = pack2(a, b);
    }
    uint4* dp = (uint4*)(dst + (size_t)(nt * 64 + nl2) * K + kt * 64 + kq * 16);
    dp[0] = make_uint4(pk[0], pk[1], pk[2], pk[3]);
    dp[1] = make_uint4(pk[4], pk[5], pk[6], pk[7]);
  }
  __syncthreads();
}

__device__ void prologue_phase(const Params& p, char* smem) {
  const int tid = otid(), wid = tid >> 6, lane = tid & 63;
  if (blockIdx.x < 384) {
    float* s = (float*)smem;
    float* red = (float*)(smem + 36864);
    for (int idx = tid; idx < 9 * 1024; idx += 256) {
      int r = idx >> 10, k = idx & 1023;
      float cv = r < 8 ? p.c()[r * 1024 + k] : p.c_ctx()[k];
      s[idx] = cv * sigmoidf_(cv);
    }
    __syncthreads();
    for (int item = blockIdx.x; item < 384; item += gridDim.x) {
      int i = item / 96, cgp = item % 96;
      float a[9];
#pragma unroll
      for (int r = 0; r < 9; ++r) a[r] = 0.f;
      const float* wp = p.mod_w() + ((size_t)i * 1024 + wid * 256) * 6144 + cgp * 64 + lane;
#pragma unroll 2
      for (int k4 = 0; k4 < 256; k4 += 4) {
        float w0 = wp[(size_t)(k4 + 0) * 6144], w1 = wp[(size_t)(k4 + 1) * 6144];
        float w2 = wp[(size_t)(k4 + 2) * 6144], w3 = wp[(size_t)(k4 + 3) * 6144];
#pragma unroll
        for (int r = 0; r < 9; ++r) {
          float4 sv = *(const float4*)&s[r * 1024 + wid * 256 + k4];
          a[r] += sv.x * w0 + sv.y * w1 + sv.z * w2 + sv.w * w3;
        }
      }
#pragma unroll
      for (int r = 0; r < 9; ++r) red[(wid * 9 + r) * 64 + lane] = a[r];
      __syncthreads();
      for (int idx = tid; idx < 9 * 64; idx += 256) {
        int r = idx >> 6, l = idx & 63;
        float v = red[(0 * 9 + r) * 64 + l] + red[(1 * 9 + r) * 64 + l] + red[(2 * 9 + r) * 64 + l] + red[(3 * 9 + r) * 64 + l];
        v += p.mod_b()[i * 6144 + cgp * 64 + l];
        p.modv()[((size_t)i * 9 + r) * 6144 + cgp * 64 + l] = v;
      }
      __syncthreads();
    }
  }
  if (blockIdx.x == gridDim.x - 1) {
    for (int idx = tid; idx < 1024; idx += 256) {
      int pos = idx >> 4, f = idx & 15;
      float inv = powf(10000.f, -(float)f / 16.f);
      float ang = (float)pos * inv;
      p.rope()[idx] = make_float2(cosf(ang), sinf(ang));
    }
  }
  for (int item = blockIdx.x; item < 12032; item += gridDim.x) wconv_item(p, item, smem);
  {
    const float4* x4 = (const float4*)p.x(); const float4* c4 = (const float4*)p.ctx(); float4* h4 = (float4*)p.h();
    for (int idx = blockIdx.x * 256 + tid; idx < T * 256; idx += gridDim.x * 256)
      h4[idx] = idx < TL * 256 ? x4[idx] : c4[idx - TL * 256];
  }
}

__device__ void norm_phase(const Params& p, int layer, int which, int M) {
  const int tid = otid(), wid = tid >> 6, lane = tid & 63;
  const float* g = p.norm_g() + (layer * 2 + which) * 1024;
  const int stride = gridDim.x * 4;
  for (int row = blockIdx.x * 4 + wid; row < M; row += 2 * stride) {
    const int rowB = row + stride;
    const bool hasB = rowB < M;
    const int rB = hasB ? rowB : row;
    const float4* hpA = (const float4*)(p.h() + (size_t)row * 1024);
    const float4* hpB = (const float4*)(p.h() + (size_t)rB * 1024);
    float4 va[4], vb[4];
#pragma unroll
    for (int i = 0; i < 4; ++i) { va[i] = hpA[lane + 64 * i]; vb[i] = hpB[lane + 64 * i]; }
    float sa = 0.f, sb = 0.f;
#pragma unroll
    for (int i = 0; i < 4; ++i) {
      sa += va[i].x * va[i].x + va[i].y * va[i].y + va[i].z * va[i].z + va[i].w * va[i].w;
      sb += vb[i].x * vb[i].x + vb[i].y * vb[i].y + vb[i].z * vb[i].z + vb[i].w * vb[i].w;
    }
#pragma unroll
    for (int o = 32; o >= 1; o >>= 1) { sa += __shfl_xor(sa, o); sb += __shfl_xor(sb, o); }
    const float rstdA = rsqrtf(sa * (1.f / 1024.f) + EPS), rstdB = rsqrtf(sb * (1.f / 1024.f) + EPS);
    const int ra = row < TL ? row / SEQ : 8, rb = rB < TL ? rB / SEQ : 8;
    const float* mva = p.modv() + ((size_t)layer * 9 + ra) * 6144;
    const float* mvb = p.modv() + ((size_t)layer * 9 + rb) * 6144;
    const int so = (which ? 3 : 0) * 1024, co = (which ? 4 : 1) * 1024;
    uint2* opA = (uint2*)(p.nbuf() + (size_t)row * 1024);
    uint2* opB = (uint2*)(p.nbuf() + (size_t)rB * 1024);
#pragma unroll
    for (int i = 0; i < 4; ++i) {
      const int c4 = lane + 64 * i;
      const float4 gg = ((const float4*)g)[c4];
      {
        const float4 s4 = ((const float4*)(mva + co))[c4], h4 = ((const float4*)(mva + so))[c4];
        float y0 = va[i].x * rstdA * gg.x * (1.f + s4.x) + h4.x, y1 = va[i].y * rstdA * gg.y * (1.f + s4.y) + h4.y;
        float y2 = va[i].z * rstdA * gg.z * (1.f + s4.z) + h4.z, y3 = va[i].w * rstdA * gg.w * (1.f + s4.w) + h4.w;
        opA[c4] = make_uint2(pack2(y0, y1), pack2(y2, y3));
      }
      if (hasB) {
        const float4 s4 = ((const float4*)(mvb + co))[c4], h4 = ((const float4*)(mvb + so))[c4];
        float y0 = vb[i].x * rstdB * gg.x * (1.f + s4.x) + h4.x, y1 = vb[i].y * rstdB * gg.y * (1.f + s4.y) + h4.y;
        float y2 = vb[i].z * rstdB * gg.z * (1.f + s4.z) + h4.z, y3 = vb[i].w * rstdB * gg.w * (1.f + s4.w) + h4.w;
        opB[c4] = make_uint2(pack2(y0, y1), pack2(y2, y3));
      }
    }
  }
}

__device__ void final_phase(const Params& p) {
  const int tid = otid(), wid = tid >> 6, lane = tid & 63;
  for (int row = blockIdx.x * 4 + wid; row < TL; row += gridDim.x * 4) {
    const float4* hp = (const float4*)(p.h() + (size_t)row * 1024);
    float4 v[4];
    float ss = 0.f;
#pragma unroll
    for (int i = 0; i < 4; ++i) { v[i] = hp[lane + 64 * i]; ss += v[i].x * v[i].x + v[i].y * v[i].y + v[i].z * v[i].z + v[i].w * v[i].w; }
#pragma unroll
    for (int o = 32; o >= 1; o >>= 1) ss += __shfl_xor(ss, o);
    float rstd = rsqrtf(ss * (1.f / 1024.f) + EPS);
    float4* op = (float4*)(p.out() + (size_t)row * 1024);
#pragma unroll
    for (int i = 0; i < 4; ++i) {
      int c4 = lane + 64 * i;
      float4 gg = ((const float4*)p.final_g())[c4];
      float4 ov = make_float4(v[i].x * rstd * gg.x, v[i].y * rstd * gg.y, v[i].z * rstd * gg.z, v[i].w * rstd * gg.w);
      op[c4] = ov;
    }
  }
}

template <int K>
__device__ __forceinline__ void gemm_tile(const Params& p, const u16* __restrict__ A, const u16* __restrict__ Bt,
                          int mt, int nt, int EPI, int layer, int gidx, const float* __restrict__ bias, char* smem) {
  const int tid = otid(), wid = tid >> 6, lane = tid & 63, wr = wid >> 1, wc = wid & 1, fr = lane & 15, fq = lane >> 4;
  const int brow = mt * 128, bcol = nt * 128;
  f32x4 acc[4][4];
#pragma unroll
  for (int i = 0; i < 4; ++i)
#pragma unroll
    for (int j = 0; j < 4; ++j) acc[i][j] = f32x4{0.f, 0.f, 0.f, 0.f};
  constexpr int nk = K / 64;
  const int lrow = tid >> 3, lc = tid & 7;
  const u16* Ab = A + (size_t)brow * K;
  const u16* Bb = Bt + (size_t)bcol * K;
  const int toff = lrow * K + lc * 8;
  const int loff = tile_off(lrow, lc);
  u32x4 ra0_0, ra1_0, ra2_0, ra3_0, rb0_0, rb1_0, rb2_0, rb3_0;
  u32x4 ra0_1, ra1_1, ra2_1, ra3_1, rb0_1, rb1_1, rb2_1, rb3_1;
#define GLD(dst, ptr) dst = *(const u32x4*)(ptr)
#define G_LOAD(S, ko)                          \
  GLD(ra0_##S, pa + 0 * 32 * K + (ko));        \
  GLD(ra1_##S, pa + 1 * 32 * K + (ko));        \
  GLD(ra2_##S, pa + 2 * 32 * K + (ko));        \
  GLD(ra3_##S, pa + 3 * 32 * K + (ko));        \
  GLD(rb0_##S, pb + 0 * 32 * K + (ko));        \
  GLD(rb1_##S, pb + 1 * 32 * K + (ko));        \
  GLD(rb2_##S, pb + 2 * 32 * K + (ko));        \
  GLD(rb3_##S, pb + 3 * 32 * K + (ko));
#define VMWAIT(N, S)
#define L_STORE(S, base)                                                \
  *(u32x4*)((base) + loff + 0 * 4096) = ra0_##S;                          \
  *(u32x4*)((base) + loff + 1 * 4096) = ra1_##S;                          \
  *(u32x4*)((base) + loff + 2 * 4096) = ra2_##S;                          \
  *(u32x4*)((base) + loff + 3 * 4096) = ra3_##S;                          \
  *(u32x4*)((base) + 16384 + loff + 0 * 4096) = rb0_##S;                  \
  *(u32x4*)((base) + 16384 + loff + 1 * 4096) = rb1_##S;                  \
  *(u32x4*)((base) + 16384 + loff + 2 * 4096) = rb2_##S;                  \
  *(u32x4*)((base) + 16384 + loff + 3 * 4096) = rb3_##S;
#define MMA_TILE(As_, Bs_)                                                                        \
  {                                                                                               \
    bf16x8 a0[4], b0[4], a1[4], b1[4];                                                            \
    _Pragma("unroll") for (int mi = 0; mi < 4; ++mi) a0[mi] = *(const bf16x8*)((As_) + aoff + mi * 2048);        \
    _Pragma("unroll") for (int ni = 0; ni < 4; ++ni) b0[ni] = *(const bf16x8*)((Bs_) + boff + ni * 2048);        \
    __builtin_amdgcn_sched_barrier(0);                                                            \
    _Pragma("unroll") for (int mi = 0; mi < 4; ++mi) a1[mi] = *(const bf16x8*)((As_) + (aoff ^ 64) + mi * 2048); \
    _Pragma("unroll") for (int ni = 0; ni < 4; ++ni) b1[ni] = *(const bf16x8*)((Bs_) + (boff ^ 64) + ni * 2048); \
    __builtin_amdgcn_sched_barrier(0);                                                            \
    _Pragma("unroll") for (int mi = 0; mi < 4; ++mi)                                              \
      _Pragma("unroll") for (int ni = 0; ni < 4; ++ni)                                            \
        acc[mi][ni] = __builtin_amdgcn_mfma_f32_16x16x32_bf16(a0[mi], b0[ni], acc[mi][ni], 0, 0, 0); \
    __builtin_amdgcn_sched_barrier(0);                                                            \
    _Pragma("unroll") for (int mi = 0; mi < 4; ++mi)                                              \
      _Pragma("unroll") for (int ni = 0; ni < 4; ++ni)                                            \
        acc[mi][ni] = __builtin_amdgcn_mfma_f32_16x16x32_bf16(a1[mi], b1[ni], acc[mi][ni], 0, 0, 0); \
  }
  const int aoff = tile_off(wr * 64 + fr, fq);
  const int boff = tile_off(wc * 64 + fr, fq);
  const u16* pa = Ab + toff;
  const u16* pb = Bb + toff;
  G_LOAD(0, 0)
  VMWAIT(0, 0);
  L_STORE(0, smem)
  G_LOAD(1, 64)
  __syncthreads();
#pragma unroll 1
  for (int kt = 0; kt < nk; kt += 2) {
    if (kt + 2 < nk) { G_LOAD(0, (kt + 2) * 64) }
    __builtin_amdgcn_sched_barrier(0);
    MMA_TILE(smem, smem + 16384)
    __builtin_amdgcn_sched_barrier(0);
    if (kt + 2 < nk) { VMWAIT(8, 1); } else { VMWAIT(0, 1); }
    L_STORE(1, smem + 32768)
    __syncthreads();
    if (kt + 3 < nk) { G_LOAD(1, (kt + 3) * 64) }
    __builtin_amdgcn_sched_barrier(0);
    MMA_TILE(smem + 32768, smem + 32768 + 16384)
    __builtin_amdgcn_sched_barrier(0);
    if (kt + 2 < nk) {
      if (kt + 3 < nk) { VMWAIT(8, 0); } else { VMWAIT(0, 0); }
      L_STORE(0, smem)
    }
    __syncthreads();
  }
#undef GLD
#undef VMWAIT
#undef G_LOAD
#undef L_STORE
#undef MMA_TILE
  const int r0 = brow + wr * 64;
  char* stg = smem + wid * 16384;
  if (EPI == 99) {
  } else if (EPI == 0 || EPI == 3) {
    const int OW = (EPI == 0) ? 1024 : FH;
    u16* outp = p.big();
    const int jch0 = (bcol + wc * 64) >> 1;
#pragma unroll
    for (int pp = 0; pp < 2; ++pp) {
      float b0 = 0.f, b1 = 0.f;
      if (bias) { b0 = bias[jch0 + pp * 16 + fr]; b1 = bias[1024 + jch0 + pp * 16 + fr]; }
#pragma unroll
      for (int mi = 0; mi < 4; ++mi)
#pragma unroll
        for (int j = 0; j < 4; ++j) {
          float a = acc[mi][2 * pp][j] + b0, g = acc[mi][2 * pp + 1][j] + b1;
          float sg = sigmoidf_(EPI == 0 ? g : a);
          float v = (EPI == 0) ? a * sg : a * sg * g;
          *(u16*)(stg + (mi * 16 + fq * 4 + j) * 80 + (pp * 16 + fr) * 2) = f2bf(v);
        }
    }
    __syncthreads();
#pragma unroll
    for (int it = 0; it < 4; ++it) {
      const int row = it * 16 + (lane >> 2), ch = lane & 3;
      u32x4 val = *(const u32x4*)(stg + row * 80 + ch * 16);
      *(u32x4*)(outp + (size_t)(r0 + row) * OW + jch0 + ch * 8) = val;
    }
    __syncthreads();
  } else if (EPI == 2) {
    const int r = brow < TL ? brow / SEQ : 8;
    const float* gate = p.modv() + ((size_t)layer * 9 + r) * 6144 + gidx * 1024;
#pragma unroll
    for (int ni = 0; ni < 4; ++ni) {
      int col = bcol + wc * 64 + ni * 16 + fr;
      float gt = gate[col];
      float bs = bias ? bias[col] : 0.f;
#pragma unroll
      for (int mi = 0; mi < 4; ++mi) {
#pragma unroll
        for (int j = 0; j < 4; ++j) {
          int row = r0 + mi * 16 + fq * 4 + j;
          float* hp = p.h() + (size_t)row * 1024 + col;          *hp = *hp + gt * (acc[mi][ni][j] + bs);
        }
        asm volatile("" ::: "memory");
      }
    }
  } else {
    const int region = nt >> 3, hd = nt & 7;
    const bool lat = brow < TL;
    const int b = lat ? brow / SEQ : (brow - TL) / CTX;
    const int kb = lat ? 256 + (r0 - b * SEQ) : (r0 - TL - b * CTX);
    const size_t bh = (size_t)(b * 8 + hd);
    u16* qb = p.big(); u16* kbuf = p.big() + (size_t)T * 1024; u16* vt = p.big() + (size_t)T * 2048;
    if (region < 2) {
      u16* dst = (region == 0 ? qb : kbuf) + ((bh * 2 + wc) * KEYS + kb) * 64;
      const float qs = region == 0 ? 0.125f * 1.44269504088896f : 1.f;
#pragma unroll
      for (int mi = 0; mi < 4; ++mi)
#pragma unroll
        for (int j = 0; j < 4; ++j) {
          int rl = mi * 16 + fq * 4 + j;
          float x0 = acc[mi][0][j], x1 = acc[mi][1][j], x2 = acc[mi][2][j], x3 = acc[mi][3][j];
          if (lat) {
            int t = kb - 256 + rl;
            float2 cr = p.rope()[(t >> 6) * 16 + fr], cc = p.rope()[(t & 63) * 16 + fr];
            float y0 = x0 * cr.x - x1 * cr.y, y1 = x1 * cr.x + x0 * cr.y;
            float y2 = x2 * cc.x - x3 * cc.y, y3 = x3 * cc.x + x2 * cc.y;
            x0 = y0; x1 = y1; x2 = y2; x3 = y3;
          }
          char* sp = stg + rl * 144 + fr * 2;
          *(u16*)(sp) = f2bf(x0 * qs); *(u16*)(sp + 32) = f2bf(x1 * qs); *(u16*)(sp + 64) = f2bf(x2 * qs); *(u16*)(sp + 96) = f2bf(x3 * qs);
        }
      __syncthreads();
#pragma unroll
      for (int it = 0; it < 8; ++it) {
        const int row = it * 8 + (lane >> 3), ch = lane & 7;
        u32x4 val = *(const u32x4*)(stg + row * 144 + ch * 16);
        *(u32x4*)(dst + (size_t)row * 64 + ch * 8) = val;
      }
      __syncthreads();
    } else {
#pragma unroll
      for (int ni = 0; ni < 4; ++ni) {
        const int e = ni * 16 + fr;
#pragma unroll
        for (int mi = 0; mi < 4; ++mi) {
          int slot = (mi >> 1) * 32 + fq * 8 + (mi & 1) * 4;
          *(uint2*)(stg + e * 144 + slot * 2) = make_uint2(pack2(acc[mi][ni][0], acc[mi][ni][1]), pack2(acc[mi][ni][2], acc[mi][ni][3]));
        }
      }
      __syncthreads();
      u16* dp = vt + (bh * 128 + wc * 64) * KEYS + kb;
#pragma unroll
      for (int it = 0; it < 8; ++it) {
        const int row = it * 8 + (lane >> 3), ch = lane & 7;
        u32x4 val = *(const u32x4*)(stg + row * 144 + ch * 16);
        *(u32x4*)(dp + (size_t)row * KEYS + ch * 8) = val;
      }
      __syncthreads();
    }
  }
}

__device__ void gemm_phase(const Params& p, const u16* A, const u16* Bt, int K, int Mt, int Nt, int epi, int layer, int gidx,
                           const float* bias, char* smem) {
  const int xcd = blockIdx.x & 7, rank = blockIdx.x >> 3, rpx = gridDim.x >> 3;
  const int SN = (Nt & 7) == 0 ? 8 : 4, SM = 64 / SN;
  const int nsn = Nt / SN, total_s = (Mt / SM) * nsn;
  for (int sidx = xcd; sidx < total_s; sidx += 8) {
    const int ms = sidx / nsn, ns = sidx % nsn;
    for (int q = rank; q < 64; q += rpx) {
      const int mt = ms * SM + q / SN, nt = ns * SN + q % SN;
      if (K == 1024) gemm_tile<1024>(p, A, Bt, mt, nt, epi, layer, gidx, bias, smem);
      else gemm_tile<FH>(p, A, Bt, mt, nt, 2, layer, gidx, bias, smem);
    }
  }
}

__device__ void conv_phase(const Params& p, int j, int M, char* smem) {
  const int tid = otid(), wid = tid >> 6, lane = tid & 63;
  float* cbuf = (float*)smem;
  const u16* U = p.big();
  for (int item = blockIdx.x; item < M / 8; item += gridDim.x) {
    const int t0 = item * 8;
    int s0, s1;
    if (t0 < TL) { s0 = (t0 / SEQ) * SEQ; s1 = s0 + SEQ; } else { s0 = TL + ((t0 - TL) / CTX) * CTX; s1 = s0 + CTX; }
#pragma unroll 1
    for (int g = 0; g < 2; ++g) {
      const int c = g * 512 + tid * 2;
      float acc[8][2];
      float w[31][2];
#pragma unroll
      for (int k = 0; k < 31; ++k) { float2 wv = *(const float2*)(p.dw_w() + ((size_t)j * 31 + k) * 1024 + c); w[k][0] = wv.x; w[k][1] = wv.y; }
      float2 bv = *(const float2*)(p.dw_b() + j * 1024 + c);
#pragma unroll
      for (int o = 0; o < 8; ++o) { acc[o][0] = bv.x; acc[o][1] = bv.y; }
#pragma unroll
      for (int ti = 0; ti < 38; ++ti) {
        int tin = t0 - 15 + ti;
        bool valid = tin >= s0 && tin < s1;
        int tc = min(max(tin, s0), s1 - 1);
        unsigned raw = *(const unsigned*)(U + (size_t)tc * 1024 + c);
        if (!valid) raw = 0u;
        float x0 = bf2f(raw & 0xffffu), x1 = bf2f(raw >> 16);
#pragma unroll
        for (int o = 0; o < 8; ++o) {
          const int k = ti - o;
          if (k >= 0 && k < 31) { acc[o][0] += x0 * w[k][0]; acc[o][1] += x1 * w[k][1]; }
        }
      }
#pragma unroll
      for (int o = 0; o < 8; ++o) *(float2*)(cbuf + o * 1024 + c) = make_float2(acc[o][0], acc[o][1]);
    }
    __syncthreads();
#pragma unroll
    for (int tt = 0; tt < 2; ++tt) {
      const int o = wid * 2 + tt;
      float4 v[4];
      float sm = 0.f;
#pragma unroll
      for (int i = 0; i < 4; ++i) { v[i] = *(const float4*)(cbuf + o * 1024 + (lane + 64 * i) * 4); sm += v[i].x + v[i].y + v[i].z + v[i].w; }
#pragma unroll
      for (int sh = 32; sh >= 1; sh >>= 1) sm += __shfl_xor(sm, sh);
      const float mean = sm * (1.f / 1024.f);
      float sq = 0.f;
#pragma unroll
      for (int i = 0; i < 4; ++i) {
        v[i].x -= mean; v[i].y -= mean; v[i].z -= mean; v[i].w -= mean;
        sq += v[i].x * v[i].x + v[i].y * v[i].y + v[i].z * v[i].z + v[i].w * v[i].w;
      }
#pragma unroll
      for (int sh = 32; sh >= 1; sh >>= 1) sq += __shfl_xor(sq, sh);
      const float rstd = rsqrtf(sq * (1.f / 1024.f) + EPS);
      uint2* op = (uint2*)(p.vbuf() + (size_t)(t0 + o) * 1024);
#pragma unroll
      for (int i = 0; i < 4; ++i) {
        int c4 = lane + 64 * i;
        float4 lg = ((const float4*)(p.ln_g() + j * 1024))[c4], lb = ((const float4*)(p.ln_b() + j * 1024))[c4];
        float y0 = v[i].x * rstd * lg.x + lb.x, y1 = v[i].y * rstd * lg.y + lb.y;
        float y2 = v[i].z * rstd * lg.z + lb.z, y3 = v[i].w * rstd * lg.w + lb.w;
        y0 *= sigmoidf_(y0); y1 *= sigmoidf_(y1); y2 *= sigmoidf_(y2); y3 *= sigmoidf_(y3);
        op[c4] = make_uint2(pack2(y0, y1), pack2(y2, y3));
      }
    }
    __syncthreads();
  }
}

__device__ void attn_item(const Params& p, int b, int hd, int q0, int nkeys, int out_row0, float lam, float oscale,
                          const float* __restrict__ subg, char* smem) {
  const int tid = otid(), wid = tid >> 6, lane = tid & 63, fr = lane & 15, fq = lane >> 4;
  const int comp = wid & 1, qg = wid >> 1;
  const size_t bh = (size_t)(b * 8 + hd);
  const u16* qb = p.big(); const u16* kbuf = p.big() + (size_t)T * 1024; const u16* vtb = p.big() + (size_t)T * 2048;
  const u16* Qp = qb + ((bh * 2 + comp) * KEYS + q0 + qg * 32) * 64;
  bf16x8 qf[2][2];
#pragma unroll
  for (int qs = 0; qs < 2; ++qs)
#pragma unroll
    for (int ks = 0; ks < 2; ++ks) qf[qs][ks] = *(const bf16x8*)(Qp + (qs * 16 + fr) * 64 + ks * 32 + fq * 8);
  const u16* K1p = kbuf + (bh * 2 + 0) * KEYS * 64;
  const u16* K2p = kbuf + (bh * 2 + 1) * KEYS * 64;
  const u16* Vp = vtb + bh * 128 * KEYS;
  const int lrow = tid >> 3, lc = tid & 7;
  uint4 rg[8];
#define ATT_GLOAD(kt_)                                                                         \
  {                                                                                            \
    const int key0 = (kt_) * 64;                                                               \
    _Pragma("unroll") for (int i = 0; i < 2; ++i) {                                            \
      rg[i] = *(const uint4*)(K1p + (size_t)(key0 + lrow + i * 32) * 64 + lc * 8);             \
      rg[2 + i] = *(const uint4*)(K2p + (size_t)(key0 + lrow + i * 32) * 64 + lc * 8);         \
    }                                                                                          \
    _Pragma("unroll") for (int i = 0; i < 4; ++i)                                              \
      rg[4 + i] = *(const uint4*)(Vp + (size_t)(lrow + i * 32) * KEYS + key0 + lc * 8);        \
  }
#define ATT_LSTORE(buf_)                                                                       \
  {                                                                                            \
    char* bs_ = smem + (buf_) * 32768;                                                         \
    _Pragma("unroll") for (int i = 0; i < 2; ++i) {                                            \
      *(uint4*)(bs_ + tile_off(lrow + i * 32, lc)) = rg[i];                                    \
      *(uint4*)(bs_ + 8192 + tile_off(lrow + i * 32, lc)) = rg[2 + i];                         \
    }                                                                                          \
    _Pragma("unroll") for (int i = 0; i < 4; ++i)                                              \
      *(uint4*)(bs_ + 16384 + tile_off(lrow + i * 32, lc)) = rg[4 + i];                        \
  }
  f32x4 O[8][2];
#pragma unroll
  for (int e = 0; e < 8; ++e) { O[e][0] = f32x4{0.f, 0.f, 0.f, 0.f}; O[e][1] = f32x4{0.f, 0.f, 0.f, 0.f}; }
  float m[2] = {-1e30f, -1e30f}, l[2] = {0.f, 0.f};
  const int ntile = nkeys >> 6;
  ATT_GLOAD(0);
  ATT_LSTORE(0);
  __syncthreads();
  for (int kt = 0; kt < ntile; ++kt) {
    const int cur = kt & 1;
    if (kt + 1 < ntile) ATT_GLOAD(kt + 1);
    const char* base = smem + cur * 32768;
    const char* Kc = base + comp * 8192;
    const char* Vt = base + 16384;
    f32x4 S[4][2];
#pragma unroll
    for (int i = 0; i < 4; ++i) { S[i][0] = f32x4{0.f, 0.f, 0.f, 0.f}; S[i][1] = f32x4{0.f, 0.f, 0.f, 0.f}; }
#pragma unroll
    for (int ks = 0; ks < 2; ++ks)
#pragma unroll
      for (int ksub = 0; ksub < 4; ++ksub) {
        bf16x8 kf = *(const bf16x8*)(Kc + tile_off(ksub * 16 + fr, ks * 4 + fq));
#pragma unroll
        for (int qs = 0; qs < 2; ++qs) S[ksub][qs] = __builtin_amdgcn_mfma_f32_16x16x32_bf16(kf, qf[qs][ks], S[ksub][qs], 0, 0, 0);
      }
#pragma unroll
    for (int qs = 0; qs < 2; ++qs) {
      float mx = -1e30f;
#pragma unroll
      for (int ksub = 0; ksub < 4; ++ksub)
#pragma unroll
        for (int j = 0; j < 4; ++j) mx = fmaxf(mx, S[ksub][qs][j]);
      mx = fmaxf(mx, __shfl_xor(mx, 16));
      mx = fmaxf(mx, __shfl_xor(mx, 32));
      float mn = fmaxf(m[qs], mx);
      float alpha = fexp2(m[qs] - mn);
      m[qs] = mn;
      float rs = 0.f;
#pragma unroll
      for (int ksub = 0; ksub < 4; ++ksub)
#pragma unroll
        for (int j = 0; j < 4; ++j) { float pv = fexp2(S[ksub][qs][j] - mn); S[ksub][qs][j] = pv; rs += pv; }
      l[qs] = l[qs] * alpha + rs;
      if (__builtin_amdgcn_ballot_w64(alpha != 1.f) != 0) {
#pragma unroll
        for (int e = 0; e < 8; ++e) O[e][qs] *= alpha;
      }
    }
    bf16x8 pf[2][2];
#pragma unroll
    for (int qs = 0; qs < 2; ++qs)
#pragma unroll
      for (int s = 0; s < 2; ++s) {
        unsigned u0 = pack2(S[2 * s][qs][0], S[2 * s][qs][1]), u1 = pack2(S[2 * s][qs][2], S[2 * s][qs][3]);
        unsigned u2 = pack2(S[2 * s + 1][qs][0], S[2 * s + 1][qs][1]), u3 = pack2(S[2 * s + 1][qs][2], S[2 * s + 1][qs][3]);
        uint4 uu = make_uint4(u0, u1, u2, u3);
        pf[qs][s] = *(bf16x8*)&uu;
      }
#pragma unroll
    for (int s = 0; s < 2; ++s)
#pragma unroll
      for (int e = 0; e < 8; ++e) {
        bf16x8 vf = *(const bf16x8*)(Vt + tile_off(e * 16 + fr, s * 4 + fq));
#pragma unroll
        for (int qs = 0; qs < 2; ++qs) O[e][qs] = __builtin_amdgcn_mfma_f32_16x16x32_bf16(vf, pf[qs][s], O[e][qs], 0, 0, 0);
      }
    if (kt + 1 < ntile) ATT_LSTORE(cur ^ 1);
    __syncthreads();
  }
#undef ATT_GLOAD
#undef ATT_LSTORE
#pragma unroll
  for (int qs = 0; qs < 2; ++qs) {
    float ls = l[qs];
    ls += __shfl_xor(ls, 16);
    ls += __shfl_xor(ls, 32);
    float inv = (comp ? lam : 1.f) / ls;
#pragma unroll
    for (int e = 0; e < 8; ++e) O[e][qs] *= inv;
  }
  float* ex = (float*)smem;
  if (comp == 1) {
#pragma unroll
    for (int e = 0; e < 8; ++e)
#pragma unroll
      for (int qs = 0; qs < 2; ++qs) *(f32x4*)(ex + ((((qg * 8 + e) * 2 + qs) * 64 + lane) << 2)) = O[e][qs];
  }
  __syncthreads();
  if (comp == 0) {
#pragma unroll
    for (int qs = 0; qs < 2; ++qs) {
      float ssq = 0.f;
#pragma unroll
      for (int e = 0; e < 8; ++e) {
        f32x4 o2 = *(const f32x4*)(ex + ((((qg * 8 + e) * 2 + qs) * 64 + lane) << 2));
        O[e][qs] -= o2;
#pragma unroll
        for (int j = 0; j < 4; ++j) ssq += O[e][qs][j] * O[e][qs][j];
      }
      ssq += __shfl_xor(ssq, 16);
      ssq += __shfl_xor(ssq, 32);
      float rstd = rsqrtf(ssq * (1.f / 128.f) + EPS) * oscale;
      u16* op = p.vbuf() + (size_t)(out_row0 + qg * 32 + qs * 16 + fr) * 1024 + hd * 128 + fq * 4;
#pragma unroll
      for (int e = 0; e < 8; ++e) {
        float4 sg = *(const float4*)(subg + e * 16 + fq * 4);
        *(uint2*)(op + e * 16) = make_uint2(pack2(O[e][qs][0] * rstd * sg.x, O[e][qs][1] * rstd * sg.y),
                                            pack2(O[e][qs][2] * rstd * sg.z, O[e][qs][3] * rstd * sg.w));
      }
    }
  }
  __syncthreads();
}

__device__ void attn_phase(const Params& p, int layer, bool with_ctx, char* smem) {
  const int ja = layer >> 1;
  const float* lv = p.lam() + ja * 256;
  float d01 = 0.f, d23 = 0.f;
  for (int i = 0; i < 64; ++i) { d01 += lv[i] * lv[64 + i]; d23 += lv[128 + i] * lv[192 + i]; }
  const float lam_init = 0.8f - 0.6f * expf(-0.3f * (float)layer);
  const float lam = expf(d01) - expf(d23) + lam_init;
  const float* subg = p.subln() + ja * 128;
  {
    const int xcd = blockIdx.x & 7, rank = blockIdx.x >> 3, rpx = gridDim.x >> 3;
    for (int r = 0; r < 4; ++r)
      for (int q = rank; q < 64; q += rpx) {
        const int bh = r * 16 + xcd * 2 + (q >> 5), qt = q & 31;
        const int b = bh >> 3, hd = bh & 7;
        attn_item(p, b, hd, 256 + qt * 64, KEYS, b * SEQ + qt * 64, lam, 1.f - lam_init, subg, smem);
      }
  }
  if (with_ctx) {
    for (int it = blockIdx.x; it < 256; it += gridDim.x) {
      const int qt = it & 3, hd = (it >> 2) & 7, b = it >> 5;
      attn_item(p, b, hd, qt * 64, CTX, TL + b * CTX + qt * 64, lam, 1.f - lam_init, subg, smem);
    }
  }
}

__device__ void run_phase(const Params& p, int ph_in, char* smem) {
  const int ph = ph_in & 0xffff; const bool noepi = (ph_in >> 16) != 0;
  if (ph == 0) { prologue_phase(p, smem); return; }
  if (ph == NPH - 1) { final_phase(p); return; }
  const int layer = (ph - 1) / 7, sub = (ph - 1) % 7;
  const bool last = layer == DEPTH - 1;
  const int M = last ? TL : T;
  const bool is_conv = (layer & 1) == 0;
  const int j = layer >> 1;
  if (sub == 0 || sub == 4) { norm_phase(p, layer, sub == 4 ? 1 : 0, sub == 0 ? T : M); return; }
  if (sub == 2) {
    if (is_conv) conv_phase(p, j, T, smem);
    else attn_phase(p, layer, !last, smem);
    return;
  }
  const u16 *A, *Bt; int K = 1024, Nt, epi, gidx = 0, mtiles = M / 128; const float* bias = nullptr;
  if (sub == 1) {
    A = p.nbuf(); mtiles = T / 128;
    if (is_conv) { Bt = p.w_pw1() + (size_t)j * 2048 * 1024; Nt = 16; epi = 0; bias = p.pw1_b() + j * 2048; }
    else { Bt = p.w_qkv() + (size_t)j * 3072 * 1024; Nt = 24; epi = 1; }
  } else if (sub == 3) {
    A = p.vbuf(); Nt = 8; epi = 2; gidx = 2;
    if (is_conv) { Bt = p.w_pw2() + (size_t)j * 1024 * 1024; bias = p.pw2_b() + j * 1024; }
    else Bt = p.w_o() + (size_t)j * 1024 * 1024;
  } else if (sub == 5) {
    A = p.nbuf(); Bt = p.w_fin() + (size_t)layer * 5632 * 1024; Nt = 44; epi = 3;
  } else {
    A = p.big(); Bt = p.w_fout() + (size_t)layer * 1024 * FH; K = FH; Nt = 8; epi = 2; gidx = 5;
  }
  gemm_phase(p, A, Bt, K, mtiles, Nt, noepi ? 99 : epi, layer, gidx, bias, smem);
}

__device__ __forceinline__ void grid_barrier(unsigned* ctr, unsigned target) {
  __syncthreads();
  if (threadIdx.x == 0) {
    __threadfence();
    __hip_atomic_fetch_add(ctr, 1u, __ATOMIC_RELAXED, __HIP_MEMORY_SCOPE_AGENT);
    while (__hip_atomic_load(ctr, __ATOMIC_RELAXED, __HIP_MEMORY_SCOPE_AGENT) < target) __builtin_amdgcn_s_sleep(2);
    __threadfence();
  }
  __syncthreads();
}

__global__ void __launch_bounds__(256, 2) mega(Params p, int ph_begin, int ph_end, int use_sync) {
  __shared__ __attribute__((aligned(16))) char smem[65536];
  cg::grid_group grid = cg::this_grid();
  unsigned* bar = (unsigned*)(p.ws + WS_NEED);
  unsigned target = 0;
  for (int ph = ph_begin; ph < ph_end; ++ph) {
    run_phase(p, ph, smem);
    if (use_sync && ph + 1 < ph_end) {
      if (ph == ph_begin) grid.sync();
      else { target += gridDim.x; grid_barrier(bar, target); }
    }
  }
}

extern "C" void kernel_launch(void* const* d_in, const int* in_sizes, int n_in, void* d_out, int out_size, void* d_ws,
                              size_t ws_size, hipStream_t stream) {
  Params p{};
  for (int i = 0; i < 22; ++i) p.in[i] = (const float*)d_in[i];
  p.outp = (float*)d_out;
  p.ws = (char*)d_ws;
  if (WS_NEED + 256 > ws_size || n_in < 22) return;
  static int grid_blocks = 0;
  if (!grid_blocks) {
    int dev = 0, cus = 0, per_cu = 0;
    hipGetDevice(&dev);
    hipDeviceGetAttribute(&cus, hipDeviceAttributeMultiprocessorCount, dev);
    hipOccupancyMaxActiveBlocksPerMultiprocessor(&per_cu, mega, 256, 0);
    if (per_cu > 2) per_cu = 2;
    if (per_cu < 1) per_cu = 1;
    grid_blocks = cus * per_cu;
  }
#if MULTI_LAUNCH
  for (int ph = 0; ph < NPH; ++ph) mega<<<grid_blocks, 256, 0, stream>>>(p, ph, ph + 1, 0);
#else
  hipMemsetAsync((char*)d_ws + WS_NEED, 0, 256, stream);
  int b = 0, e = NPH, s = 1;
  void* args[] = {&p, &b, &e, &s};
  hipError_t err = hipLaunchCooperativeKernel((void*)mega, dim3(grid_blocks), dim3(256), args, 0, stream);
  if (err != hipSuccess) fprintf(stderr, "cooperative launch failed: %s (grid %d)\n", hipGetErrorString(err), grid_blocks);
#endif
}
```

```cpp
#include <hip/hip_runtime.h>
#include <hip/hip_cooperative_groups.h>
#include <cstdio>
namespace cg = cooperative_groups;

#ifndef DUP_FLAG
#define DUP_FLAG 0
#endif
#ifndef MULTI_LAUNCH
#define MULTI_LAUNCH 0
#endif

typedef unsigned short u16;
using bf16x8 = __attribute__((ext_vector_type(8))) short;
using f32x4 = __attribute__((ext_vector_type(4))) float;
using u32x4 = __attribute__((ext_vector_type(4))) unsigned;

constexpr int D = 1024, NB = 8, SEQ = 2048, CTX = 256, DEPTH = 4;
constexpr int TL = NB * SEQ;
constexpr int TCX = NB * CTX;
constexpr int T = TL + TCX;
constexpr int FH = 2816;
constexpr int KEYS = CTX + SEQ;
constexpr int NPH = 2 + 7 * DEPTH;
constexpr float EPS = 1e-6f;

constexpr size_t al256(size_t x) { return (x + 255) & ~(size_t)255; }
constexpr size_t OFF_WPW1 = 0;
constexpr size_t OFF_WPW2 = OFF_WPW1 + al256((size_t)2 * 2048 * 1024 * 2);
constexpr size_t OFF_WQKV = OFF_WPW2 + al256((size_t)2 * 1024 * 1024 * 2);
constexpr size_t OFF_WO = OFF_WQKV + al256((size_t)2 * 3072 * 1024 * 2);
constexpr size_t OFF_WFIN = OFF_WO + al256((size_t)2 * 1024 * 1024 * 2);
constexpr size_t OFF_WFOUT = OFF_WFIN + al256((size_t)4 * 5632 * 1024 * 2);
constexpr size_t OFF_H = OFF_WFOUT + al256((size_t)4 * 1024 * FH * 2);
constexpr size_t OFF_NBUF = OFF_H + al256((size_t)T * 1024 * 4);
constexpr size_t OFF_BIG = OFF_NBUF + al256((size_t)T * 1024 * 2);
constexpr size_t OFF_VBUF = OFF_BIG + al256((size_t)T * 3072 * 2);
constexpr size_t OFF_MODV = OFF_VBUF + al256((size_t)T * 1024 * 2);
constexpr size_t OFF_ROPE = OFF_MODV + al256((size_t)4 * 9 * 6144 * 4);
constexpr size_t WS_NEED = OFF_ROPE + al256((size_t)1024 * 8);

struct Params {
  const float* in[22];
  float* outp;
  char* ws;
  __device__ __forceinline__ const float* x() const { return in[0]; }
  __device__ __forceinline__ const float* c() const { return in[1]; }
  __device__ __forceinline__ const float* ctx() const { return in[2]; }
  __device__ __forceinline__ const float* c_ctx() const { return in[3]; }
  __device__ __forceinline__ const float* mod_w() const { return in[4]; }
  __device__ __forceinline__ const float* mod_b() const { return in[5]; }
  __device__ __forceinline__ const float* norm_g() const { return in[6]; }
  __device__ __forceinline__ const float* pw1_w() const { return in[7]; }
  __device__ __forceinline__ const float* pw1_b() const { return in[8]; }
  __device__ __forceinline__ const float* dw_w() const { return in[9]; }
  __device__ __forceinline__ const float* dw_b() const { return in[10]; }
  __device__ __forceinline__ const float* ln_g() const { return in[11]; }
  __device__ __forceinline__ const float* ln_b() const { return in[12]; }
  __device__ __forceinline__ const float* pw2_w() const { return in[13]; }
  __device__ __forceinline__ const float* pw2_b() const { return in[14]; }
  __device__ __forceinline__ const float* wqkv() const { return in[15]; }
  __device__ __forceinline__ const float* lam() const { return in[16]; }
  __device__ __forceinline__ const float* subln() const { return in[17]; }
  __device__ __forceinline__ const float* wo() const { return in[18]; }
  __device__ __forceinline__ const float* ffn_in() const { return in[19]; }
  __device__ __forceinline__ const float* ffn_out() const { return in[20]; }
  __device__ __forceinline__ const float* final_g() const { return in[21]; }
  __device__ __forceinline__ float* out() const { return outp; }
  __device__ __forceinline__ u16* w_pw1() const { return (u16*)(ws + OFF_WPW1); }
  __device__ __forceinline__ u16* w_pw2() const { return (u16*)(ws + OFF_WPW2); }
  __device__ __forceinline__ u16* w_qkv() const { return (u16*)(ws + OFF_WQKV); }
  __device__ __forceinline__ u16* w_o() const { return (u16*)(ws + OFF_WO); }
  __device__ __forceinline__ u16* w_fin() const { return (u16*)(ws + OFF_WFIN); }
  __device__ __forceinline__ u16* w_fout() const { return (u16*)(ws + OFF_WFOUT); }
  __device__ __forceinline__ float* h() const { return (float*)(ws + OFF_H); }
  __device__ __forceinline__ u16* nbuf() const { return (u16*)(ws + OFF_NBUF); }
  __device__ __forceinline__ u16* big() const { return (u16*)(ws + OFF_BIG); }
  __device__ __forceinline__ u16* vbuf() const { return (u16*)(ws + OFF_VBUF); }
  __device__ __forceinline__ float* modv() const { return (float*)(ws + OFF_MODV); }
  __device__ __forceinline__ float2* rope() const { return (float2*)(ws + OFF_ROPE); }
};

typedef __bf16 bf2v __attribute__((ext_vector_type(2)));
typedef float f2v __attribute__((ext_vector_type(2)));
__device__ __forceinline__ unsigned pack2(float a, float b) {
  f2v v = {a, b};
  bf2v r = __builtin_convertvector(v, bf2v);
  return *(unsigned*)&r;
}
__device__ __forceinline__ u16 f2bf(float f) { return (u16)(pack2(f, 0.f) & 0xffffu); }
__device__ __forceinline__ float bf2f(unsigned v) { return __uint_as_float(v << 16); }
__device__ __forceinline__ int tile_off(int row, int chunk) { return row * 128 + (((chunk ^ row) & 7) << 4); }
__device__ __forceinline__ float fexp2(float x) { return __builtin_amdgcn_exp2f(x); }
__device__ __forceinline__ float sigmoidf_(float x) { return __builtin_amdgcn_rcpf(1.f + __expf(-x)); }

__device__ __forceinline__ int otid() { int t = threadIdx.x; asm volatile("" : "+v"(t)); return t; }

__device__ void wconv_item(const Params& p, int item, char* smem) {
  float* tl = (float*)smem;
  const int tid = otid();
  int K, N, half = 0, tpl, ntN, base;
  const float* src; u16* dst;
  if (item < 1024)      { base = 0;    K = 1024; N = 2048; half = 1024; tpl = 512;  ntN = 32; src = p.pw1_w();  dst = p.w_pw1(); }
  else if (item < 1536) { base = 1024; K = 1024; N = 1024;              tpl = 256;  ntN = 16; src = p.pw2_w();  dst = p.w_pw2(); }
  else if (item < 3072) { base = 1536; K = 1024; N = 3072;              tpl = 768;  ntN = 48; src = p.wqkv();   dst = p.w_qkv(); }
  else if (item < 3584) { base = 3072; K = 1024; N = 1024;              tpl = 256;  ntN = 16; src = p.wo();     dst = p.w_o(); }
  else if (item < 9216) { base = 3584; K = 1024; N = 5632; half = 2816; tpl = 1408; ntN = 88; src = p.ffn_in(); dst = p.w_fin(); }
  else                  { base = 9216; K = 2816; N = 1024;              tpl = 704;  ntN = 16; src = p.ffn_out(); dst = p.w_fout(); }
  int it = item - base;
  int l = it / tpl, rem = it % tpl, kt = rem / ntN, nt = rem % ntN;
  src += (size_t)l * K * N; dst += (size_t)l * K * N;
  {
    int nl = tid & 63, kk0 = tid >> 6;
    int np = nt * 64 + nl;
    int sc = np;
    if (half) { int blk = np >> 5, w = np & 31; sc = blk * 16 + (w & 15) + ((w >> 4) ? half : 0); }
    const float* sp = src + (size_t)(kt * 64) * N + sc;
#pragma unroll
    for (int i = 0; i < 16; ++i) { int kk = kk0 + 4 * i; tl[kk * 65 + nl] = sp[(size_t)kk * N]; }
  }
  __syncthreads();
  {
    int nl2 = tid >> 2, kq = tid & 3;
    unsigned pk[8];
#pragma unroll
    for (int e = 0; e < 8; ++e) {
      float a = tl[(kq * 16 + 2 * e) * 65 + nl2], b = tl[(kq * 16 + 2 * e + 1) * 65 + nl2];
      pk[e] = pack2(a, b);
    }
    uint4* dp = (uint4*)(dst + (size_t)(nt * 64 + nl2) * K + kt * 64 + kq * 16);
    dp[0] = make_uint4(pk[0], pk[1], pk[2], pk[3]);
    dp[1] = make_uint4(pk[4], pk[5], pk[6], pk[7]);
  }
  __syncthreads();
}

__device__ void prologue_phase(const Params& p, char* smem) {
  const int tid = otid(), wid = tid >> 6, lane = tid & 63;
  if (blockIdx.x < 384) {
    float* s = (float*)smem;
    float* red = (float*)(smem + 36864);
    for (int idx = tid; idx < 9 * 1024; idx += 256) {
      int r = idx >> 10, k = idx & 1023;
      float cv = r < 8 ? p.c()[r * 1024 + k] : p.c_ctx()[k];
      s[idx] = cv * sigmoidf_(cv);
    }
    __syncthreads();
    for (int item = blockIdx.x; item < 384; item += gridDim.x) {
      int i = item / 96, cgp = item % 96;
      float a[9];
#pragma unroll
      for (int r = 0; r < 9; ++r) a[r] = 0.f;
      const float* wp = p.mod_w() + ((size_t)i * 1024 + wid * 256) * 6144 + cgp * 64 + lane;
#pragma unroll 2
      for (int k4 = 0; k4 < 256; k4 += 4) {
        float w0 = wp[(size_t)(k4 + 0) * 6144], w1 = wp[(size_t)(k4 + 1) * 6144];
        float w2 = wp[(size_t)(k4 + 2) * 6144], w3 = wp[(size_t)(k4 + 3) * 6144];
#pragma unroll
        for (int r = 0; r < 9; ++r) {
          float4 sv = *(const float4*)&s[r * 1024 + wid * 256 + k4];
          a[r] += sv.x * w0 + sv.y * w1 + sv.z * w2 + sv.w * w3;
        }
      }
#pragma unroll
      for (int r = 0; r < 9; ++r) red[(wid * 9 + r) * 64 + lane] = a[r];
      __syncthreads();
      for (int idx = tid; idx < 9 * 64; idx += 256) {
        int r = idx >> 6, l = idx & 63;
        float v = red[(0 * 9 + r) * 64 + l] + red[(1 * 9 + r) * 64 + l] + red[(2 * 9 + r) * 64 + l] + red[(3 * 9 + r) * 64 + l];
        v += p.mod_b()[i * 6144 + cgp * 64 + l];
        p.modv()[((size_t)i * 9 + r) * 6144 + cgp * 64 + l] = v;
      }
      __syncthreads();
    }
  }
  if (blockIdx.x == gridDim.x - 1) {
    for (int idx = tid; idx < 1024; idx += 256) {
      int pos = idx >> 4, f = idx & 15;
      float inv = powf(10000.f, -(float)f / 16.f);
      float ang = (float)pos * inv;
      p.rope()[idx] = make_float2(cosf(ang), sinf(ang));
    }
  }
  for (int item = blockIdx.x; item < 12032; item += gridDim.x) wconv_item(p, item, smem);
  {
    const float4* x4 = (const float4*)p.x(); const float4* c4 = (const float4*)p.ctx(); float4* h4 = (float4*)p.h();
    for (int idx = blockIdx.x * 256 + tid; idx < T * 256; idx += gridDim.x * 256)
      h4[idx] = idx < TL * 256 ? x4[idx] : c4[idx - TL * 256];
  }
}

__device__ void norm_phase(const Params& p, int layer, int which, int M) {
  const int tid = otid(), wid = tid >> 6, lane = tid & 63;
  const float* g = p.norm_g() + (layer * 2 + which) * 1024;
  const int stride = gridDim.x * 4;
  for (int row = blockIdx.x * 4 + wid; row < M; row += 2 * stride) {
    const int rowB = row + stride;
    const bool hasB = rowB < M;
    const int rB = hasB ? rowB : row;
    const float4* hpA = (const float4*)(p.h() + (size_t)row * 1024);
    const float4* hpB = (const float4*)(p.h() + (size_t)rB * 1024);
    float4 va[4], vb[4];
#pragma unroll
    for (int i = 0; i < 4; ++i) { va[i] = hpA[lane + 64 * i]; vb[i] = hpB[lane + 64 * i]; }
    float sa = 0.f, sb = 0.f;
#pragma unroll
    for (int i = 0; i < 4; ++i) {
      sa += va[i].x * va[i].x + va[i].y * va[i].y + va[i].z * va[i].z + va[i].w * va[i].w;
      sb += vb[i].x * vb[i].x + vb[i].y * vb[i].y + vb[i].z * vb[i].z + vb[i].w * vb[i].w;
    }
#pragma unroll
    for (int o = 32; o >= 1; o >>= 1) { sa += __shfl_xor(sa, o); sb += __shfl_xor(sb, o); }
    const float rstdA = rsqrtf(sa * (1.f / 1024.f) + EPS), rstdB = rsqrtf(sb * (1.f / 1024.f) + EPS);
    const int ra = row < TL ? row / SEQ : 8, rb = rB < TL ? rB / SEQ : 8;
    const float* mva = p.modv() + ((size_t)layer * 9 + ra) * 6144;
    const float* mvb = p.modv() + ((size_t)layer * 9 + rb) * 6144;
    const int so = (which ? 3 : 0) * 1024, co = (which ? 4 : 1) * 1024;
    uint2* opA = (uint2*)(p.nbuf() + (size_t)row * 1024);
    uint2* opB = (uint2*)(p.nbuf() + (size_t)rB * 1024);
#pragma unroll
    for (int i = 0; i < 4; ++i) {
      const int c4 = lane + 64 * i;
      const float4 gg = ((const float4*)g)[c4];
      {
        const float4 s4 = ((const float4*)(mva + co))[c4], h4 = ((const float4*)(mva + so))[c4];
        float y0 = va[i].x * rstdA * gg.x * (1.f + s4.x) + h4.x, y1 = va[i].y * rstdA * gg.y * (1.f + s4.y) + h4.y;
        float y2 = va[i].z * rstdA * gg.z * (1.f + s4.z) + h4.z, y3 = va[i].w * rstdA * gg.w * (1.f + s4.w) + h4.w;
        opA[c4] = make_uint2(pack2(y0, y1), pack2(y2, y3));
      }
      if (hasB) {
        const float4 s4 = ((const float4*)(mvb + co))[c4], h4 = ((const float4*)(mvb + so))[c4];
        float y0 = vb[i].x * rstdB * gg.x * (1.f + s4.x) + h4.x, y1 = vb[i].y * rstdB * gg.y * (1.f + s4.y) + h4.y;
        float y2 = vb[i].z * rstdB * gg.z * (1.f + s4.z) + h4.z, y3 = vb[i].w * rstdB * gg.w * (1.f + s4.w) + h4.w;
        opB[c4] = make_uint2(pack2(y0, y1), pack2(y2, y3));
      }
    }
  }
}

__device__ void final_phase(const Params& p) {
  const int tid = otid(), wid = tid >> 6, lane = tid & 63;
  for (int row = blockIdx.x * 4 + wid; row < TL; row += gridDim.x * 4) {
    const float4* hp = (const float4*)(p.h() + (size_t)row * 1024);
    float4 v[4];
    float ss = 0.f;
#pragma unroll
    for (int i = 0; i < 4; ++i) { v[i] = hp[lane + 64 * i]; ss += v[i].x * v[i].x + v[i].y * v[i].y + v[i].z * v[i].z + v[i].w * v[i].w; }
#pragma unroll
    for (int o = 32; o >= 1; o >>= 1) ss += __shfl_xor(ss, o);
    float rstd = rsqrtf(ss * (1.f / 1024.f) + EPS);
    float4* op = (float4*)(p.out() + (size_t)row * 1024);
#pragma unroll
    for (int i = 0; i < 4; ++i) {
      int c4 = lane + 64 * i;
      float4 gg = ((const float4*)p.final_g())[c4];
      float4 ov = make_float4(v[i].x * rstd * gg.x, v[i].y * rstd * gg.y, v[i].z * rstd * gg.z, v[i].w * rstd * gg.w);
      op[c4] = ov;
    }
  }
}

template <int K>
__device__ __forceinline__ void gemm_tile(const Params& p, const u16* __restrict__ A, const u16* __restrict__ Bt,
                          int mt, int nt, int EPI, int layer, int gidx, const float* __restrict__ bias, char* smem) {
  const int tid = otid(), wid = tid >> 6, lane = tid & 63, wr = wid >> 1, wc = wid & 1, fr = lane & 15, fq = lane >> 4;
  const int brow = mt * 128, bcol = nt * 128;
  f32x4 acc[4][4];
#pragma unroll
  for (int i = 0; i < 4; ++i)
#pragma unroll
    for (int j = 0; j < 4; ++j) acc[i][j] = f32x4{0.f, 0.f, 0.f, 0.f};
  constexpr int nk = K / 64;
  const int lrow = tid >> 3, lc = tid & 7;
  const u16* Ab = A + (size_t)brow * K;
  const u16* Bb = Bt + (size_t)bcol * K;
  const int toff = lrow * K + lc * 8;
  const int loff = tile_off(lrow, lc);
  u32x4 ra0_0, ra1_0, ra2_0, ra3_0, rb0_0, rb1_0, rb2_0, rb3_0;
  u32x4 ra0_1, ra1_1, ra2_1, ra3_1, rb0_1, rb1_1, rb2_1, rb3_1;
#define GLD(dst, ptr) dst = *(const u32x4*)(ptr)
#define G_LOAD(S, ko)                          \
  GLD(ra0_##S, pa + 0 * 32 * K + (ko));        \
  GLD(ra1_##S, pa + 1 * 32 * K + (ko));        \
  GLD(ra2_##S, pa + 2 * 32 * K + (ko));        \
  GLD(ra3_##S, pa + 3 * 32 * K + (ko));        \
  GLD(rb0_##S, pb + 0 * 32 * K + (ko));        \
  GLD(rb1_##S, pb + 1 * 32 * K + (ko));        \
  GLD(rb2_##S, pb + 2 * 32 * K + (ko));        \
  GLD(rb3_##S, pb + 3 * 32 * K + (ko));
#define VMWAIT(N, S)
#define L_STORE(S, base)                                                \
  *(u32x4*)((base) + loff + 0 * 4096) = ra0_##S;                          \
  *(u32x4*)((base) + loff + 1 * 4096) = ra1_##S;                          \
  *(u32x4*)((base) + loff + 2 * 4096) = ra2_##S;                          \
  *(u32x4*)((base) + loff + 3 * 4096) = ra3_##S;                          \
  *(u32x4*)((base) + 16384 + loff + 0 * 4096) = rb0_##S;                  \
  *(u32x4*)((base) + 16384 + loff + 1 * 4096) = rb1_##S;                  \
  *(u32x4*)((base) + 16384 + loff + 2 * 4096) = rb2_##S;                  \
  *(u32x4*)((base) + 16384 + loff + 3 * 4096) = rb3_##S;
#define MMA_TILE(As_, Bs_)                                                                        \
  {                                                                                               \
    bf16x8 a0[4], b0[4], a1[4], b1[4];                                                            \
    _Pragma("unroll") for (int mi = 0; mi < 4; ++mi) a0[mi] = *(const bf16x8*)((As_) + aoff + mi * 2048);        \
    _Pragma("unroll") for (int ni = 0; ni < 4; ++ni) b0[ni] = *(const bf16x8*)((Bs_) + boff + ni * 2048);        \
    __builtin_amdgcn_sched_barrier(0);                                                            \
    _Pragma("unroll") for (int mi = 0; mi < 4; ++mi) a1[mi] = *(const bf16x8*)((As_) + (aoff ^ 64) + mi * 2048); \
    _Pragma("unroll") for (int ni = 0; ni < 4; ++ni) b1[ni] = *(const bf16x8*)((Bs_) + (boff ^ 64) + ni * 2048); \
    __builtin_amdgcn_sched_barrier(0);                                                            \
    _Pragma("unroll") for (int mi = 0; mi < 4; ++mi)                                              \
      _Pragma("unroll") for (int ni = 0; ni < 4; ++ni)                                            \
        acc[mi][ni] = __builtin_amdgcn_mfma_f32_16x16x32_bf16(a0[mi], b0[ni], acc[mi][ni], 0, 0, 0); \
    __builtin_amdgcn_sched_barrier(0);                                                            \
    _Pragma("unroll") for (int mi = 0; mi < 4; ++mi)                                              \
      _Pragma("unroll") for (int ni = 0; ni < 4; ++ni)                                            \
        acc[mi][ni] = __builtin_amdgcn_mfma_f32_16x16x32_bf16(a1[mi], b1[ni], acc[mi][ni], 0, 0, 0); \
  }
  const int aoff = tile_off(wr * 64 + fr, fq);
  const int boff = tile_off(wc * 64 + fr, fq);
  const u16* pa = Ab + toff;
  const u16* pb = Bb + toff;
  G_LOAD(0, 0)
  VMWAIT(0, 0);
  L_STORE(0, smem)
  G_LOAD(1, 64)
  __syncthreads();
#pragma unroll 1
  for (int kt = 0; kt < nk; kt += 2) {
    if (kt + 2 < nk) { G_LOAD(0, (kt + 2) * 64) }
    __builtin_amdgcn_sched_barrier(0);
    MMA_TILE(smem, smem + 16384)
    __builtin_amdgcn_sched_barrier(0);
    if (kt + 2 < nk) { VMWAIT(8, 1); } else { VMWAIT(0, 1); }
    L_STORE(1, smem + 32768)
    __syncthreads();
    if (kt + 3 < nk) { G_LOAD(1, (kt + 3) * 64) }
    __builtin_amdgcn_sched_barrier(0);
    MMA_TILE(smem + 32768, smem + 32768 + 16384)
    __builtin_amdgcn_sched_barrier(0);
    if (kt + 2 < nk) {
      if (kt + 3 < nk) { VMWAIT(8, 0); } else { VMWAIT(0, 0); }
      L_STORE(0, smem)
    }
    __syncthreads();
  }
#undef GLD
#undef VMWAIT
#undef G_LOAD
#undef L_STORE
#undef MMA_TILE
  const int r0 = brow + wr * 64;
  char* stg = smem + wid * 16384;
  if (EPI == 99) {
  } else if (EPI == 0 || EPI == 3) {
    const int OW = (EPI == 0) ? 1024 : FH;
    u16* outp = p.big();
    const int jch0 = (bcol + wc * 64) >> 1;
#pragma unroll
    for (int pp = 0; pp < 2; ++pp) {
      float b0 = 0.f, b1 = 0.f;
      if (bias) { b0 = bias[jch0 + pp * 16 + fr]; b1 = bias[1024 + jch0 + pp * 16 + fr]; }
#pragma unroll
      for (int mi = 0; mi < 4; ++mi)
#pragma unroll
        for (int j = 0; j < 4; ++j) {
          float a = acc[mi][2 * pp][j] + b0, g = acc[mi][2 * pp + 1][j] + b1;
          float sg = sigmoidf_(EPI == 0 ? g : a);
          float v = (EPI == 0) ? a * sg : a * sg * g;
          *(u16*)(stg + (mi * 16 + fq * 4 + j) * 80 + (pp * 16 + fr) * 2) = f2bf(v);
        }
    }
    __syncthreads();
#pragma unroll
    for (int it = 0; it < 4; ++it) {
      const int row = it * 16 + (lane >> 2), ch = lane & 3;
      u32x4 val = *(const u32x4*)(stg + row * 80 + ch * 16);
      *(u32x4*)(outp + (size_t)(r0 + row) * OW + jch0 + ch * 8) = val;
    }
    __syncthreads();
  } else if (EPI == 2) {
    const int r = brow < TL ? brow / SEQ : 8;
    const float* gate = p.modv() + ((size_t)layer * 9 + r) * 6144 + gidx * 1024;
#pragma unroll
    for (int ni = 0; ni < 4; ++ni) {
      int col = bcol + wc * 64 + ni * 16 + fr;
      float gt = gate[col];
      float bs = bias ? bias[col] : 0.f;
#pragma unroll
      for (int mi = 0; mi < 4; ++mi) {
#pragma unroll
        for (int j = 0; j < 4; ++j) {
          int row = r0 + mi * 16 + fq * 4 + j;
          float* hp = p.h() + (size_t)row * 1024 + col;          *hp = *hp + gt * (acc[mi][ni][j] + bs);
        }
        asm volatile("" ::: "memory");
      }
    }
  } else {
    const int region = nt >> 3, hd = nt & 7;
    const bool lat = brow < TL;
    const int b = lat ? brow / SEQ : (brow - TL) / CTX;
    const int kb = lat ? 256 + (r0 - b * SEQ) : (r0 - TL - b * CTX);
    const size_t bh = (size_t)(b * 8 + hd);
    u16* qb = p.big(); u16* kbuf = p.big() + (size_t)T * 1024; u16* vt = p.big() + (size_t)T * 2048;
    if (region < 2) {
      u16* dst = (region == 0 ? qb : kbuf) + ((bh * 2 + wc) * KEYS + kb) * 64;
      const float qs = region == 0 ? 0.125f * 1.44269504088896f : 1.f;
#pragma unroll
      for (int mi = 0; mi < 4; ++mi)
#pragma unroll
        for (int j = 0; j < 4; ++j) {
          int rl = mi * 16 + fq * 4 + j;
          float x0 = acc[mi][0][j], x1 = acc[mi][1][j], x2 = acc[mi][2][j], x3 = acc[mi][3][j];
          if (lat) {
            int t = kb - 256 + rl;
            float2 cr = p.rope()[(t >> 6) * 16 + fr], cc = p.rope()[(t & 63) * 16 + fr];
            float y0 = x0 * cr.x - x1 * cr.y, y1 = x1 * cr.x + x0 * cr.y;
            float y2 = x2 * cc.x - x3 * cc.y, y3 = x3 * cc.x + x2 * cc.y;
            x0 = y0; x1 = y1; x2 = y2; x3 = y3;
          }
          char* sp = stg + rl * 144 + fr * 2;
          *(u16*)(sp) = f2bf(x0 * qs); *(u16*)(sp + 32) = f2bf(x1 * qs); *(u16*)(sp + 64) = f2bf(x2 * qs); *(u16*)(sp + 96) = f2bf(x3 * qs);
        }
      __syncthreads();
#pragma unroll
      for (int it = 0; it < 8; ++it) {
        const int row = it * 8 + (lane >> 3), ch = lane & 7;
        u32x4 val = *(const u32x4*)(stg + row * 144 + ch * 16);
        *(u32x4*)(dst + (size_t)row * 64 + ch * 8) = val;
      }
      __syncthreads();
    } else {
#pragma unroll
      for (int ni = 0; ni < 4; ++ni) {
        const int e = ni * 16 + fr;
#pragma unroll
        for (int mi = 0; mi < 4; ++mi) {
          int slot = (mi >> 1) * 32 + fq * 8 + (mi & 1) * 4;
          *(uint2*)(stg + e * 144 + slot * 2) = make_uint2(pack2(acc[mi][ni][0], acc[mi][ni][1]), pack2(acc[mi][ni][2], acc[mi][ni][3]));
        }
      }
      __syncthreads();
      u16* dp = vt + (bh * 128 + wc * 64) * KEYS + kb;
#pragma unroll
      for (int it = 0; it < 8; ++it) {
        const int row = it * 8 + (lane >> 3), ch = lane & 7;
        u32x4 val = *(const u32x4*)(stg + row * 144 + ch * 16);
        *(u32x4*)(dp + (size_t)row * KEYS + ch * 8) = val;
      }
      __syncthreads();
    }
  }
}

__device__ void gemm_phase(const Params& p, const u16* A, const u16* Bt, int K, int Mt, int Nt, int epi, int layer, int gidx,
                           const float* bias, char* smem) {
  const int xcd = blockIdx.x & 7, rank = blockIdx.x >> 3, rpx = gridDim.x >> 3;
  const int SN = (Nt & 7) == 0 ? 8 : 4, SM = 64 / SN;
  const int nsn = Nt / SN, total_s = (Mt / SM) * nsn;
  for (int sidx = xcd; sidx < total_s; sidx += 8) {
    const int ms = sidx / nsn, ns = sidx % nsn;
    for (int q = rank; q < 64; q += rpx) {
      const int mt = ms * SM + q / SN, nt = ns * SN + q % SN;
      if (K == 1024) gemm_tile<1024>(p, A, Bt, mt, nt, epi, layer, gidx, bias, smem);
      else gemm_tile<FH>(p, A, Bt, mt, nt, 2, layer, gidx, bias, smem);
    }
  }
}

__device__ void conv_phase(const Params& p, int j, int M, char* smem) {
  const int tid = otid(), wid = tid >> 6, lane = tid & 63;
  float* cbuf = (float*)smem;
  const u16* U = p.big();
  for (int item = blockIdx.x; item < M / 8; item += gridDim.x) {
    const int t0 = item * 8;
    int s0, s1;
    if (t0 < TL) { s0 = (t0 / SEQ) * SEQ; s1 = s0 + SEQ; } else { s0 = TL + ((t0 - TL) / CTX) * CTX; s1 = s0 + CTX; }
#pragma unroll 1
    for (int g = 0; g < 2; ++g) {
      const int c = g * 512 + tid * 2;
      float acc[8][2];
      float w[31][2];
#pragma unroll
      for (int k = 0; k < 31; ++k) { float2 wv = *(const float2*)(p.dw_w() + ((size_t)j * 31 + k) * 1024 + c); w[k][0] = wv.x; w[k][1] = wv.y; }
      float2 bv = *(const float2*)(p.dw_b() + j * 1024 + c);
#pragma unroll
      for (int o = 0; o < 8; ++o) { acc[o][0] = bv.x; acc[o][1] = bv.y; }
#pragma unroll
      for (int ti = 0; ti < 38; ++ti) {
        int tin = t0 - 15 + ti;
        bool valid = tin >= s0 && tin < s1;
        int tc = min(max(tin, s0), s1 - 1);
        unsigned raw = *(const unsigned*)(U + (size_t)tc * 1024 + c);
        if (!valid) raw = 0u;
        float x0 = bf2f(raw & 0xffffu), x1 = bf2f(raw >> 16);
#pragma unroll
        for (int o = 0; o < 8; ++o) {
          const int k = ti - o;
          if (k >= 0 && k < 31) { acc[o][0] += x0 * w[k][0]; acc[o][1] += x1 * w[k][1]; }
        }
      }
#pragma unroll
      for (int o = 0; o < 8; ++o) *(float2*)(cbuf + o * 1024 + c) = make_float2(acc[o][0], acc[o][1]);
    }
    __syncthreads();
#pragma unroll
    for (int tt = 0; tt < 2; ++tt) {
      const int o = wid * 2 + tt;
      float4 v[4];
      float sm = 0.f;
#pragma unroll
      for (int i = 0; i < 4; ++i) { v[i] = *(const float4*)(cbuf + o * 1024 + (lane + 64 * i) * 4); sm += v[i].x + v[i].y + v[i].z + v[i].w; }
#pragma unroll
      for (int sh = 32; sh >= 1; sh >>= 1) sm += __shfl_xor(sm, sh);
      const float mean = sm * (1.f / 1024.f);
      float sq = 0.f;
#pragma unroll
      for (int i = 0; i < 4; ++i) {
        v[i].x -= mean; v[i].y -= mean; v[i].z -= mean; v[i].w -= mean;
        sq += v[i].x * v[i].x + v[i].y * v[i].y + v[i].z * v[i].z + v[i].w * v[i].w;
      }
#pragma unroll
      for (int sh = 32; sh >= 1; sh >>= 1) sq += __shfl_xor(sq, sh);
      const float rstd = rsqrtf(sq * (1.f / 1024.f) + EPS);
      uint2* op = (uint2*)(p.vbuf() + (size_t)(t0 + o) * 1024);
#pragma unroll
      for (int i = 0; i < 4; ++i) {
        int c4 = lane + 64 * i;
        float4 lg = ((const float4*)(p.ln_g() + j * 1024))[c4], lb = ((const float4*)(p.ln_b() + j * 1024))[c4];
        float y0 = v[i].x * rstd * lg.x + lb.x, y1 = v[i].y * rstd * lg.y + lb.y;
        float y2 = v[i].z * rstd * lg.z + lb.z, y3 = v[i].w * rstd * lg.w + lb.w;
        y0 *= sigmoidf_(y0); y1 *= sigmoidf_(y1); y2 *= sigmoidf_(y2); y3 *= sigmoidf_(y3);
        op[c4] = make_uint2(pack2(y0, y1), pack2(y2, y3));
      }
    }
    __syncthreads();
  }
}

__device__ void attn_item(const Params& p, int b, int hd, int q0, int nkeys, int out_row0, float lam, float oscale,
                          const float* __restrict__ subg, char* smem) {
  const int tid = otid(), wid = tid >> 6, lane = tid & 63, fr = lane & 15, fq = lane >> 4;
  const int comp = wid & 1, qg = wid >> 1;
  const size_t bh = (size_t)(b * 8 + hd);
  const u16* qb = p.big(); const u16* kbuf = p.big() + (size_t)T * 1024; const u16* vtb = p.big() + (size_t)T * 2048;
  const u16* Qp = qb + ((bh * 2 + comp) * KEYS + q0 + qg * 32) * 64;
  bf16x8 qf[2][2];
#pragma unroll
  for (int qs = 0; qs < 2; ++qs)
#pragma unroll
    for (int ks = 0; ks < 2; ++ks) qf[qs][ks] = *(const bf16x8*)(Qp + (qs * 16 + fr) * 64 + ks * 32 + fq * 8);
  const u16* K1p = kbuf + (bh * 2 + 0) * KEYS * 64;
  const u16* K2p = kbuf + (bh * 2 + 1) * KEYS * 64;
  const u16* Vp = vtb + bh * 128 * KEYS;
  const int lrow = tid >> 3, lc = tid & 7;
  uint4 rg[8];
#define ATT_GLOAD(kt_)                                                                         \
  {                                                                                            \
    const int key0 = (kt_) * 64;                                                               \
    _Pragma("unroll") for (int i = 0; i < 2; ++i) {                                            \
      rg[i] = *(const uint4*)(K1p + (size_t)(key0 + lrow + i * 32) * 64 + lc * 8);             \
      rg[2 + i] = *(const uint4*)(K2p + (size_t)(key0 + lrow + i * 32) * 64 + lc * 8);         \
    }                                                                                          \
    _Pragma("unroll") for (int i = 0; i < 4; ++i)                                              \
      rg[4 + i] = *(const uint4*)(Vp + (size_t)(lrow + i * 32) * KEYS + key0 + lc * 8);        \
  }
#define ATT_LSTORE(buf_)                                                                       \
  {                                                                                            \
    char* bs_ = smem + (buf_) * 32768;                                                         \
    _Pragma("unroll") for (int i = 0; i < 2; ++i) {                                            \
      *(uint4*)(bs_ + tile_off(lrow + i * 32, lc)) = rg[i];                                    \
      *(uint4*)(bs_ + 8192 + tile_off(lrow + i * 32, lc)) = rg[2 + i];                         \
    }                                                                                          \
    _Pragma("unroll") for (int i = 0; i < 4; ++i)                                              \
      *(uint4*)(bs_ + 16384 + tile_off(lrow + i * 32, lc)) = rg[4 + i];                        \
  }
  f32x4 O[8][2];
#pragma unroll
  for (int e = 0; e < 8; ++e) { O[e][0] = f32x4{0.f, 0.f, 0.f, 0.f}; O[e][1] = f32x4{0.f, 0.f, 0.f, 0.f}; }
  float m[2] = {-1e30f, -1e30f}, l[2] = {0.f, 0.f};
  const int ntile = nkeys >> 6;
  ATT_GLOAD(0);
  ATT_LSTORE(0);
  __syncthreads();
  for (int kt = 0; kt < ntile; ++kt) {
    const int cur = kt & 1;
    if (kt + 1 < ntile) ATT_GLOAD(kt + 1);
    const char* base = smem + cur * 32768;
    const char* Kc = base + comp * 8192;
    const char* Vt = base + 16384;
    f32x4 S[4][2];
#pragma unroll
    for (int i = 0; i < 4; ++i) { S[i][0] = f32x4{0.f, 0.f, 0.f, 0.f}; S[i][1] = f32x4{0.f, 0.f, 0.f, 0.f}; }
#pragma unroll
    for (int ks = 0; ks < 2; ++ks)
#pragma unroll
      for (int ksub = 0; ksub < 4; ++ksub) {
        bf16x8 kf = *(const bf16x8*)(Kc + tile_off(ksub * 16 + fr, ks * 4 + fq));
#pragma unroll
        for (int qs = 0; qs < 2; ++qs) S[ksub][qs] = __builtin_amdgcn_mfma_f32_16x16x32_bf16(kf, qf[qs][ks], S[ksub][qs], 0, 0, 0);
      }
#pragma unroll
    for (int qs = 0; qs < 2; ++qs) {
      float mx = -1e30f;
#pragma unroll
      for (int ksub = 0; ksub < 4; ++ksub)
#pragma unroll
        for (int j = 0; j < 4; ++j) mx = fmaxf(mx, S[ksub][qs][j]);
      mx = fmaxf(mx, __shfl_xor(mx, 16));
      mx = fmaxf(mx, __shfl_xor(mx, 32));
      float mn = fmaxf(m[qs], mx);
      float alpha = fexp2(m[qs] - mn);
      m[qs] = mn;
      float rs = 0.f;
#pragma unroll
      for (int ksub = 0; ksub < 4; ++ksub)
#pragma unroll
        for (int j = 0; j < 4; ++j) { float pv = fexp2(S[ksub][qs][j] - mn); S[ksub][qs][j] = pv; rs += pv; }
      l[qs] = l[qs] * alpha + rs;
      if (__builtin_amdgcn_ballot_w64(alpha != 1.f) != 0) {
#pragma unroll
        for (int e = 0; e < 8; ++e) O[e][qs] *= alpha;
      }
    }
    bf16x8 pf[2][2];
#pragma unroll
    for (int qs = 0; qs < 2; ++qs)
#pragma unroll
      for (int s = 0; s < 2; ++s) {
        unsigned u0 = pack2(S[2 * s][qs][0], S[2 * s][qs][1]), u1 = pack2(S[2 * s][qs][2], S[2 * s][qs][3]);
        unsigned u2 = pack2(S[2 * s + 1][qs][0], S[2 * s + 1][qs][1]), u3 = pack2(S[2 * s + 1][qs][2], S[2 * s + 1][qs][3]);
        uint4 uu = make_uint4(u0, u1, u2, u3);
        pf[qs][s] = *(bf16x8*)&uu;
      }
#pragma unroll
    for (int s = 0; s < 2; ++s)
#pragma unroll
      for (int e = 0; e < 8; ++e) {
        bf16x8 vf = *(const bf16x8*)(Vt + tile_off(e * 16 + fr, s * 4 + fq));
#pragma unroll
        for (int qs = 0; qs < 2; ++qs) O[e][qs] = __builtin_amdgcn_mfma_f32_16x16x32_bf16(vf, pf[qs][s], O[e][qs], 0, 0, 0);
      }
    if (kt + 1 < ntile) ATT_LSTORE(cur ^ 1);
    __syncthreads();
  }
#undef ATT_GLOAD
#undef ATT_LSTORE
#pragma unroll
  for (int qs = 0; qs < 2; ++qs) {
    float ls = l[qs];
    ls += __shfl_xor(ls, 16);
    ls += __shfl_xor(ls, 32);
    float inv = (comp ? lam : 1.f) / ls;
#pragma unroll
    for (int e = 0; e < 8; ++e) O[e][qs] *= inv;
  }
  float* ex = (float*)smem;
  if (comp == 1) {
#pragma unroll
    for (int e = 0; e < 8; ++e)
#pragma unroll
      for (int qs = 0; qs < 2; ++qs) *(f32x4*)(ex + ((((qg * 8 + e) * 2 + qs) * 64 + lane) << 2)) = O[e][qs];
  }
  __syncthreads();
  if (comp == 0) {
#pragma unroll
    for (int qs = 0; qs < 2; ++qs) {
      float ssq = 0.f;
#pragma unroll
      for (int e = 0; e < 8; ++e) {
        f32x4 o2 = *(const f32x4*)(ex + ((((qg * 8 + e) * 2 + qs) * 64 + lane) << 2));
        O[e][qs] -= o2;
#pragma unroll
        for (int j = 0; j < 4; ++j) ssq += O[e][qs][j] * O[e][qs][j];
      }
      ssq += __shfl_xor(ssq, 16);
      ssq += __shfl_xor(ssq, 32);
      float rstd = rsqrtf(ssq * (1.f / 128.f) + EPS) * oscale;
      u16* op = p.vbuf() + (size_t)(out_row0 + qg * 32 + qs * 16 + fr) * 1024 + hd * 128 + fq * 4;
#pragma unroll
      for (int e = 0; e < 8; ++e) {
        float4 sg = *(const float4*)(subg + e * 16 + fq * 4);
        *(uint2*)(op + e * 16) = make_uint2(pack2(O[e][qs][0] * rstd * sg.x, O[e][qs][1] * rstd * sg.y),
                                            pack2(O[e][qs][2] * rstd * sg.z, O[e][qs][3] * rstd * sg.w));
      }
    }
  }
  __syncthreads();
}

__device__ void attn_phase(const Params& p, int layer, bool with_ctx, char* smem) {
  const int ja = layer >> 1;
  const float* lv = p.lam() + ja * 256;
  float d01 = 0.f, d23 = 0.f;
  for (int i = 0; i < 64; ++i) { d01 += lv[i] * lv[64 + i]; d23 += lv[128 + i] * lv[192 + i]; }
  const float lam_init = 0.8f - 0.6f * expf(-0.3f * (float)layer);
  const float lam = expf(d01) - expf(d23) + lam_init;
  const float* subg = p.subln() + ja * 128;
  {
    const int xcd = blockIdx.x & 7, rank = blockIdx.x >> 3, rpx = gridDim.x >> 3;
    for (int r = 0; r < 4; ++r)
      for (int q = rank; q < 64; q += rpx) {
        const int bh = r * 16 + xcd * 2 + (q >> 5), qt = q & 31;
        const int b = bh >> 3, hd = bh & 7;
        attn_item(p, b, hd, 256 + qt * 64, KEYS, b * SEQ + qt * 64, lam, 1.f - lam_init, subg, smem);
      }
  }
  if (with_ctx) {
    for (int it = blockIdx.x; it < 256; it += gridDim.x) {
      const int qt = it & 3, hd = (it >> 2) & 7, b = it >> 5;
      attn_item(p, b, hd, qt * 64, CTX, TL + b * CTX + qt * 64, lam, 1.f - lam_init, subg, smem);
    }
  }
}

__device__ void run_phase(const Params& p, int ph_in, char* smem) {
  const int ph = ph_in & 0xffff; const bool noepi = (ph_in >> 16) != 0;
  if (ph == 0) { prologue_phase(p, smem); return; }
  if (ph == NPH - 1) { final_phase(p); return; }
  const int layer = (ph - 1) / 7, sub = (ph - 1) % 7;
  const bool last = layer == DEPTH - 1;
  const int M = last ? TL : T;
  const bool is_conv = (layer & 1) == 0;
  const int j = layer >> 1;
  if (sub == 0 || sub == 4) { norm_phase(p, layer, sub == 4 ? 1 : 0, sub == 0 ? T : M); return; }
  if (sub == 2) {
    if (is_conv) conv_phase(p, j, T, smem);
    else attn_phase(p, layer, !last, smem);
    return;
  }
  const u16 *A, *Bt; int K = 1024, Nt, epi, gidx = 0, mtiles = M / 128; const float* bias = nullptr;
  if (sub == 1) {
    A = p.nbuf(); mtiles = T / 128;
    if (is_conv) { Bt = p.w_pw1() + (size_t)j * 2048 * 1024; Nt = 16; epi = 0; bias = p.pw1_b() + j * 2048; }
    else { Bt = p.w_qkv() + (size_t)j * 3072 * 1024; Nt = 24; epi = 1; }
  } else if (sub == 3) {
    A = p.vbuf(); Nt = 8; epi = 2; gidx = 2;
    if (is_conv) { Bt = p.w_pw2() + (size_t)j * 1024 * 1024; bias = p.pw2_b() + j * 1024; }
    else Bt = p.w_o() + (size_t)j * 1024 * 1024;
  } else if (sub == 5) {
    A = p.nbuf(); Bt = p.w_fin() + (size_t)layer * 5632 * 1024; Nt = 44; epi = 3;
  } else {
    A = p.big(); Bt = p.w_fout() + (size_t)layer * 1024 * FH; K = FH; Nt = 8; epi = 2; gidx = 5;
  }
  gemm_phase(p, A, Bt, K, mtiles, Nt, noepi ? 99 : epi, layer, gidx, bias, smem);
}

__device__ __forceinline__ unsigned xcc_id() { return (unsigned)__builtin_amdgcn_s_getreg((3 << 11) | 20) & 0xFu; }
__device__ __forceinline__ void grid_barrier(unsigned* bar, unsigned xcc, unsigned k, unsigned nloc, unsigned nx) {
  __syncthreads();
  if (threadIdx.x == 0) {
    unsigned a = __hip_atomic_fetch_add(&bar[1024 + xcc * 64], 1u, __ATOMIC_RELAXED, __HIP_MEMORY_SCOPE_AGENT) + 1u;
    if (a == k * nloc) {
      __builtin_amdgcn_fence(__ATOMIC_RELEASE, "agent");
      asm volatile("s_waitcnt vmcnt(0)" ::: "memory");
      __hip_atomic_fetch_add(&bar[2048], 1u, __ATOMIC_RELAXED, __HIP_MEMORY_SCOPE_AGENT);
    }
    while (__hip_atomic_load(&bar[2048], __ATOMIC_RELAXED, __HIP_MEMORY_SCOPE_AGENT) < k * nx) __builtin_amdgcn_s_sleep(2);
    __builtin_amdgcn_fence(__ATOMIC_ACQUIRE, "agent");
    asm volatile("s_waitcnt vmcnt(0)" ::: "memory");
  }
  __syncthreads();
}

__global__ void __launch_bounds__(256, 2) mega(Params p, int ph_begin, int ph_end, int use_sync) {
  __shared__ __attribute__((aligned(16))) char smem[65536];
  __shared__ unsigned s_cnt[2];
  cg::grid_group grid = cg::this_grid();
  unsigned* bar = (unsigned*)(p.ws + WS_NEED);
  const unsigned xcc = xcc_id();
  if (use_sync && threadIdx.x == 0) __hip_atomic_fetch_add(&bar[xcc * 64], 1u, __ATOMIC_RELAXED, __HIP_MEMORY_SCOPE_AGENT);
  unsigned k = 0, nloc = 1, nx = 1;
  for (int ph = ph_begin; ph < ph_end; ++ph) {
    run_phase(p, ph, smem);
    if (use_sync && ph + 1 < ph_end) {
      if (ph == ph_begin) {
        grid.sync();
        if (threadIdx.x == 0) {
          unsigned cnt = 0;
          for (int j = 0; j < 16; ++j) cnt += __hip_atomic_load(&bar[j * 64], __ATOMIC_RELAXED, __HIP_MEMORY_SCOPE_AGENT) ? 1u : 0u;
          s_cnt[0] = __hip_atomic_load(&bar[xcc * 64], __ATOMIC_RELAXED, __HIP_MEMORY_SCOPE_AGENT);
          s_cnt[1] = cnt;
        }
        __syncthreads();
        nloc = s_cnt[0]; nx = s_cnt[1];
      } else {
        ++k;
        grid_barrier(bar, xcc, k, nloc, nx);
      }
    }
  }
}

extern "C" void kernel_launch(void* const* d_in, const int* in_sizes, int n_in, void* d_out, int out_size, void* d_ws,
                              size_t ws_size, hipStream_t stream) {
  Params p{};
  for (int i = 0; i < 22; ++i) p.in[i] = (const float*)d_in[i];
  p.outp = (float*)d_out;
  p.ws = (char*)d_ws;
  if (WS_NEED + 16384 > ws_size || n_in < 22) return;
  static int grid_blocks = 0;
  if (!grid_blocks) {
    int dev = 0, cus = 0, per_cu = 0;
    hipGetDevice(&dev);
    hipDeviceGetAttribute(&cus, hipDeviceAttributeMultiprocessorCount, dev);
    hipOccupancyMaxActiveBlocksPerMultiprocessor(&per_cu, mega, 256, 0);
    if (per_cu > 2) per_cu = 2;
    if (per_cu < 1) per_cu = 1;
    grid_blocks = cus * per_cu;
  }
#if MULTI_LAUNCH
  for (int ph = 0; ph < NPH; ++ph) mega<<<grid_blocks, 256, 0, stream>>>(p, ph, ph + 1, 0);
#else
  hipMemsetAsync((char*)d_ws + WS_NEED, 0, 16384, stream);
  int b = 0, e = NPH, s = 1;
  void* args[] = {&p, &b, &e, &s};
  hipError_t err = hipLaunchCooperativeKernel((void*)mega, dim3(grid_blocks), dim3(256), args, 0, stream);
  if (err != hipSuccess) fprintf(stderr, "cooperative launch failed: %s (grid %d)\n", hipGetErrorString(err), grid_blocks);
#endif
}
```

```cpp
#include <hip/hip_runtime.h>
#include <hip/hip_cooperative_groups.h>
#include <cstdio>
namespace cg = cooperative_groups;

#ifndef DUP_FLAG
#define DUP_FLAG 0
#endif
#ifndef MULTI_LAUNCH
#define MULTI_LAUNCH 0
#endif

typedef unsigned short u16;
using bf16x8 = __attribute__((ext_vector_type(8))) short;
using f32x4 = __attribute__((ext_vector_type(4))) float;
using u32x4 = __attribute__((ext_vector_type(4))) unsigned;

constexpr int D = 1024, NB = 8, SEQ = 2048, CTX = 256, DEPTH = 4;
constexpr int TL = NB * SEQ;
constexpr int TCX = NB * CTX;
constexpr int T = TL + TCX;
constexpr int FH = 2816;
constexpr int KEYS = CTX + SEQ;
constexpr int NPH = 2 + 7 * DEPTH;
constexpr float EPS = 1e-6f;

constexpr size_t al256(size_t x) { return (x + 255) & ~(size_t)255; }
constexpr size_t OFF_WPW1 = 0;
constexpr size_t OFF_WPW2 = OFF_WPW1 + al256((size_t)2 * 2048 * 1024 * 2);
constexpr size_t OFF_WQKV = OFF_WPW2 + al256((size_t)2 * 1024 * 1024 * 2);
constexpr size_t OFF_WO = OFF_WQKV + al256((size_t)2 * 3072 * 1024 * 2);
constexpr size_t OFF_WFIN = OFF_WO + al256((size_t)2 * 1024 * 1024 * 2);
constexpr size_t OFF_WFOUT = OFF_WFIN + al256((size_t)4 * 5632 * 1024 * 2);
constexpr size_t OFF_H = OFF_WFOUT + al256((size_t)4 * 1024 * FH * 2);
constexpr size_t OFF_NBUF = OFF_H + al256((size_t)T * 1024 * 4);
constexpr size_t OFF_BIG = OFF_NBUF + al256((size_t)T * 1024 * 2);
constexpr size_t OFF_VBUF = OFF_BIG + al256((size_t)T * 3072 * 2);
constexpr size_t OFF_MODV = OFF_VBUF + al256((size_t)T * 1024 * 2);
constexpr size_t OFF_ROPE = OFF_MODV + al256((size_t)4 * 9 * 6144 * 4);
constexpr size_t WS_NEED = OFF_ROPE + al256((size_t)1024 * 8);

struct Params {
  const float* in[22];
  float* outp;
  char* ws;
  __device__ __forceinline__ const float* x() const { return in[0]; }
  __device__ __forceinline__ const float* c() const { return in[1]; }
  __device__ __forceinline__ const float* ctx() const { return in[2]; }
  __device__ __forceinline__ const float* c_ctx() const { return in[3]; }
  __device__ __forceinline__ const float* mod_w() const { return in[4]; }
  __device__ __forceinline__ const float* mod_b() const { return in[5]; }
  __device__ __forceinline__ const float* norm_g() const { return in[6]; }
  __device__ __forceinline__ const float* pw1_w() const { return in[7]; }
  __device__ __forceinline__ const float* pw1_b() const { return in[8]; }
  __device__ __forceinline__ const float* dw_w() const { return in[9]; }
  __device__ __forceinline__ const float* dw_b() const { return in[10]; }
  __device__ __forceinline__ const float* ln_g() const { return in[11]; }
  __device__ __forceinline__ const float* ln_b() const { return in[12]; }
  __device__ __forceinline__ const float* pw2_w() const { return in[13]; }
  __device__ __forceinline__ const float* pw2_b() const { return in[14]; }
  __device__ __forceinline__ const float* wqkv() const { return in[15]; }
  __device__ __forceinline__ const float* lam() const { return in[16]; }
  __device__ __forceinline__ const float* subln() const { return in[17]; }
  __device__ __forceinline__ const float* wo() const { return in[18]; }
  __device__ __forceinline__ const float* ffn_in() const { return in[19]; }
  __device__ __forceinline__ const float* ffn_out() const { return in[20]; }
  __device__ __forceinline__ const float* final_g() const { return in[21]; }
  __device__ __forceinline__ float* out() const { return outp; }
  __device__ __forceinline__ u16* w_pw1() const { return (u16*)(ws + OFF_WPW1); }
  __device__ __forceinline__ u16* w_pw2() const { return (u16*)(ws + OFF_WPW2); }
  __device__ __forceinline__ u16* w_qkv() const { return (u16*)(ws + OFF_WQKV); }
  __device__ __forceinline__ u16* w_o() const { return (u16*)(ws + OFF_WO); }
  __device__ __forceinline__ u16* w_fin() const { return (u16*)(ws + OFF_WFIN); }
  __device__ __forceinline__ u16* w_fout() const { return (u16*)(ws + OFF_WFOUT); }
  __device__ __forceinline__ float* h() const { return (float*)(ws + OFF_H); }
  __device__ __forceinline__ u16* nbuf() const { return (u16*)(ws + OFF_NBUF); }
  __device__ __forceinline__ u16* big() const { return (u16*)(ws + OFF_BIG); }
  __device__ __forceinline__ u16* vbuf() const { return (u16*)(ws + OFF_VBUF); }
  __device__ __forceinline__ float* modv() const { return (float*)(ws + OFF_MODV); }
  __device__ __forceinline__ float2* rope() const { return (float2*)(ws + OFF_ROPE); }
};

typedef __bf16 bf2v __attribute__((ext_vector_type(2)));
typedef float f2v __attribute__((ext_vector_type(2)));
__device__ __forceinline__ unsigned pack2(float a, float b) {
  f2v v = {a, b};
  bf2v r = __builtin_convertvector(v, bf2v);
  return *(unsigned*)&r;
}
__device__ __forceinline__ u16 f2bf(float f) { return (u16)(pack2(f, 0.f) & 0xffffu); }
__device__ __forceinline__ float bf2f(unsigned v) { return __uint_as_float(v << 16); }
__device__ __forceinline__ int tile_off(int row, int chunk) { return row * 128 + (((chunk ^ row) & 7) << 4); }
__device__ __forceinline__ float fexp2(float x) { return __builtin_amdgcn_exp2f(x); }
__device__ __forceinline__ float sigmoidf_(float x) { return __builtin_amdgcn_rcpf(1.f + __expf(-x)); }

__device__ __forceinline__ int otid() { int t = threadIdx.x; asm volatile("" : "+v"(t)); return t; }

struct WDesc { const float* sp; u16* dp; int N, K; };
__device__ __forceinline__ WDesc wconv_decode(const Params& p, int item, int tid) {
  int K, N, half = 0, tpl, ntN, base;
  const float* src; u16* dst;
  if (item < 1024)      { base = 0;    K = 1024; N = 2048; half = 1024; tpl = 512;  ntN = 32; src = p.pw1_w();  dst = p.w_pw1(); }
  else if (item < 1536) { base = 1024; K = 1024; N = 1024;              tpl = 256;  ntN = 16; src = p.pw2_w();  dst = p.w_pw2(); }
  else if (item < 3072) { base = 1536; K = 1024; N = 3072;              tpl = 768;  ntN = 48; src = p.wqkv();   dst = p.w_qkv(); }
  else if (item < 3584) { base = 3072; K = 1024; N = 1024;              tpl = 256;  ntN = 16; src = p.wo();     dst = p.w_o(); }
  else if (item < 9216) { base = 3584; K = 1024; N = 5632; half = 2816; tpl = 1408; ntN = 88; src = p.ffn_in(); dst = p.w_fin(); }
  else                  { base = 9216; K = 2816; N = 1024;              tpl = 704;  ntN = 16; src = p.ffn_out(); dst = p.w_fout(); }
  const int it = item - base;
  const int l = it / tpl, rem = it % tpl, kt = rem / ntN, nt = rem % ntN;
  src += (size_t)l * K * N; dst += (size_t)l * K * N;
  const int nl = tid & 63, kk0 = tid >> 6;
  const int np = nt * 64 + nl;
  int sc = np;
  if (half) { int blk = np >> 5, w = np & 31; sc = blk * 16 + (w & 15) + ((w >> 4) ? half : 0); }
  WDesc d;
  d.sp = src + (size_t)(kt * 64 + kk0) * N + sc;
  d.dp = dst + (size_t)(nt * 64 + (tid >> 2)) * K + kt * 64 + (tid & 3) * 16;
  d.N = N; d.K = K;
  return d;
}

__device__ void wconv_loop(const Params& p, char* smem) {
  float* tl = (float*)smem;
  const int tid = otid();
  const int nl = tid & 63, kk0 = tid >> 6, nl2 = tid >> 2, kq = tid & 3;
  int item = blockIdx.x;
  if (item >= 12032) return;
  float v[16];
  WDesc d = wconv_decode(p, item, tid);
#pragma unroll
  for (int i = 0; i < 16; ++i) v[i] = d.sp[(size_t)(4 * i) * d.N];
  for (; item < 12032; item += gridDim.x) {
#pragma unroll
    for (int i = 0; i < 16; ++i) tl[(kk0 + 4 * i) * 65 + nl] = v[i];
    u16* dp = d.dp;
    const int nxt = item + gridDim.x;
    if (nxt < 12032) {
      d = wconv_decode(p, nxt, tid);
#pragma unroll
      for (int i = 0; i < 16; ++i) v[i] = d.sp[(size_t)(4 * i) * d.N];
    }
    __syncthreads();
    unsigned pk[8];
#pragma unroll
    for (int e = 0; e < 8; ++e) pk[e] = pack2(tl[(kq * 16 + 2 * e) * 65 + nl2], tl[(kq * 16 + 2 * e + 1) * 65 + nl2]);
    ((uint4*)dp)[0] = make_uint4(pk[0], pk[1], pk[2], pk[3]);
    ((uint4*)dp)[1] = make_uint4(pk[4], pk[5], pk[6], pk[7]);
    __syncthreads();
  }
}

__device__ void prologue_phase(const Params& p, char* smem) {
  const int tid = otid(), wid = tid >> 6, lane = tid & 63;
  if (blockIdx.x < 384) {
    float* s = (float*)smem;
    float* red = (float*)(smem + 36864);
    for (int idx = tid; idx < 9 * 1024; idx += 256) {
      int r = idx >> 10, k = idx & 1023;
      float cv = r < 8 ? p.c()[r * 1024 + k] : p.c_ctx()[k];
      s[idx] = cv * sigmoidf_(cv);
    }
    __syncthreads();
    for (int item = blockIdx.x; item < 384; item += gridDim.x) {
      int i = item / 96, cgp = item % 96;
      float a[9];
#pragma unroll
      for (int r = 0; r < 9; ++r) a[r] = 0.f;
      const float* wp = p.mod_w() + ((size_t)i * 1024 + wid * 256) * 6144 + cgp * 64 + lane;
#pragma unroll 4
      for (int k4 = 0; k4 < 256; k4 += 4) {
        float w0 = wp[(size_t)(k4 + 0) * 6144], w1 = wp[(size_t)(k4 + 1) * 6144];
        float w2 = wp[(size_t)(k4 + 2) * 6144], w3 = wp[(size_t)(k4 + 3) * 6144];
#pragma unroll
        for (int r = 0; r < 9; ++r) {
          float4 sv = *(const float4*)&s[r * 1024 + wid * 256 + k4];
          a[r] += sv.x * w0 + sv.y * w1 + sv.z * w2 + sv.w * w3;
        }
      }
#pragma unroll
      for (int r = 0; r < 9; ++r) red[(wid * 9 + r) * 64 + lane] = a[r];
      __syncthreads();
      for (int idx = tid; idx < 9 * 64; idx += 256) {
        int r = idx >> 6, l = idx & 63;
        float v = red[(0 * 9 + r) * 64 + l] + red[(1 * 9 + r) * 64 + l] + red[(2 * 9 + r) * 64 + l] + red[(3 * 9 + r) * 64 + l];
        v += p.mod_b()[i * 6144 + cgp * 64 + l];
        p.modv()[((size_t)i * 9 + r) * 6144 + cgp * 64 + l] = v;
      }
      __syncthreads();
    }
  }
  if (blockIdx.x == gridDim.x - 1) {
    for (int idx = tid; idx < 1024; idx += 256) {
      int pos = idx >> 4, f = idx & 15;
      float inv = powf(10000.f, -(float)f / 16.f);
      float ang = (float)pos * inv;
      p.rope()[idx] = make_float2(cosf(ang), sinf(ang));
    }
  }
  wconv_loop(p, smem);
  {
    const float4* x4 = (const float4*)p.x(); const float4* c4 = (const float4*)p.ctx(); float4* h4 = (float4*)p.h();
    for (int idx = blockIdx.x * 256 + tid; idx < T * 256; idx += gridDim.x * 256)
      h4[idx] = idx < TL * 256 ? x4[idx] : c4[idx - TL * 256];
  }
}

__device__ void norm_phase(const Params& p, int layer, int which, int M) {
  const int tid = otid(), wid = tid >> 6, lane = tid & 63;
  const float* g = p.norm_g() + (layer * 2 + which) * 1024;
  const int stride = gridDim.x * 4;
  for (int row = blockIdx.x * 4 + wid; row < M; row += 2 * stride) {
    const int rowB = row + stride;
    const bool hasB = rowB < M;
    const int rB = hasB ? rowB : row;
    const float4* hpA = (const float4*)(p.h() + (size_t)row * 1024);
    const float4* hpB = (const float4*)(p.h() + (size_t)rB * 1024);
    float4 va[4], vb[4];
#pragma unroll
    for (int i = 0; i < 4; ++i) { va[i] = hpA[lane + 64 * i]; vb[i] = hpB[lane + 64 * i]; }
    float sa = 0.f, sb = 0.f;
#pragma unroll
    for (int i = 0; i < 4; ++i) {
      sa += va[i].x * va[i].x + va[i].y * va[i].y + va[i].z * va[i].z + va[i].w * va[i].w;
      sb += vb[i].x * vb[i].x + vb[i].y * vb[i].y + vb[i].z * vb[i].z + vb[i].w * vb[i].w;
    }
#pragma unroll
    for (int o = 32; o >= 1; o >>= 1) { sa += __shfl_xor(sa, o); sb += __shfl_xor(sb, o); }
    const float rstdA = rsqrtf(sa * (1.f / 1024.f) + EPS), rstdB = rsqrtf(sb * (1.f / 1024.f) + EPS);
    const int ra = row < TL ? row / SEQ : 8, rb = rB < TL ? rB / SEQ : 8;
    const float* mva = p.modv() + ((size_t)layer * 9 + ra) * 6144;
    const float* mvb = p.modv() + ((size_t)layer * 9 + rb) * 6144;
    const int so = (which ? 3 : 0) * 1024, co = (which ? 4 : 1) * 1024;
    uint2* opA = (uint2*)(p.nbuf() + (size_t)row * 1024);
    uint2* opB = (uint2*)(p.nbuf() + (size_t)rB * 1024);
#pragma unroll
    for (int i = 0; i < 4; ++i) {
      const int c4 = lane + 64 * i;
      const float4 gg = ((const float4*)g)[c4];
      {
        const float4 s4 = ((const float4*)(mva + co))[c4], h4 = ((const float4*)(mva + so))[c4];
        float y0 = va[i].x * rstdA * gg.x * (1.f + s4.x) + h4.x, y1 = va[i].y * rstdA * gg.y * (1.f + s4.y) + h4.y;
        float y2 = va[i].z * rstdA * gg.z * (1.f + s4.z) + h4.z, y3 = va[i].w * rstdA * gg.w * (1.f + s4.w) + h4.w;
        opA[c4] = make_uint2(pack2(y0, y1), pack2(y2, y3));
      }
      if (hasB) {
        const float4 s4 = ((const float4*)(mvb + co))[c4], h4 = ((const float4*)(mvb + so))[c4];
        float y0 = vb[i].x * rstdB * gg.x * (1.f + s4.x) + h4.x, y1 = vb[i].y * rstdB * gg.y * (1.f + s4.y) + h4.y;
        float y2 = vb[i].z * rstdB * gg.z * (1.f + s4.z) + h4.z, y3 = vb[i].w * rstdB * gg.w * (1.f + s4.w) + h4.w;
        opB[c4] = make_uint2(pack2(y0, y1), pack2(y2, y3));
      }
    }
  }
}

__device__ void final_phase(const Params& p) {
  const int tid = otid(), wid = tid >> 6, lane = tid & 63;
  for (int row = blockIdx.x * 4 + wid; row < TL; row += gridDim.x * 4) {
    const float4* hp = (const float4*)(p.h() + (size_t)row * 1024);
    float4 v[4];
    float ss = 0.f;
#pragma unroll
    for (int i = 0; i < 4; ++i) { v[i] = hp[lane + 64 * i]; ss += v[i].x * v[i].x + v[i].y * v[i].y + v[i].z * v[i].z + v[i].w * v[i].w; }
#pragma unroll
    for (int o = 32; o >= 1; o >>= 1) ss += __shfl_xor(ss, o);
    float rstd = rsqrtf(ss * (1.f / 1024.f) + EPS);
    float4* op = (float4*)(p.out() + (size_t)row * 1024);
#pragma unroll
    for (int i = 0; i < 4; ++i) {
      int c4 = lane + 64 * i;
      float4 gg = ((const float4*)p.final_g())[c4];
      float4 ov = make_float4(v[i].x * rstd * gg.x, v[i].y * rstd * gg.y, v[i].z * rstd * gg.z, v[i].w * rstd * gg.w);
      op[c4] = ov;
    }
  }
}

template <int K, int EPI>
__device__ __forceinline__ void gemm_run(const Params& p, const u16* __restrict__ A, const u16* __restrict__ Bt,
                          int Mt, int Nt, int layer, int gidx, const float* __restrict__ bias, char* smem) {
  const int tid = otid(), wid = tid >> 6, lane = tid & 63, wr = wid >> 1, wc = wid & 1, fr = lane & 15, fq = lane >> 4;
  const int xcd = blockIdx.x & 7, rank = blockIdx.x >> 3, rpx = gridDim.x >> 3;
  const int SN = (Nt & 7) == 0 ? 8 : 4, SM = 64 / SN;
  const int nsn = Nt / SN, total_s = (Mt / SM) * nsn;
  const int cq = rank < 64 ? (64 - rank + rpx - 1) / rpx : 0;
  const int nsx = xcd < total_s ? (total_s - xcd + 7) / 8 : 0;
  const int ntile = cq * nsx;
  if (ntile == 0) return;
#define TILE_MN(i_, mt_, nt_)                                              \
  {                                                                        \
    const int si_ = (i_) / cq, qi_ = (i_) - si_ * cq;                      \
    const int sidx_ = xcd + 8 * si_, q_ = rank + rpx * qi_;                \
    const int ms_ = sidx_ / nsn, ns_ = sidx_ - ms_ * nsn;                  \
    mt_ = ms_ * SM + q_ / SN;                                              \
    nt_ = ns_ * SN + q_ % SN;                                              \
  }
  constexpr int nk = K / 64;
  const int lrow = tid >> 3, lc = tid & 7;
  const int toff = lrow * K + lc * 8;
  const int loff = tile_off(lrow, lc);
  const int aoff = tile_off(wr * 64 + fr, fq);
  const int boff = tile_off(wc * 64 + fr, fq);
  u32x4 ra0_0, ra1_0, ra2_0, ra3_0, rb0_0, rb1_0, rb2_0, rb3_0;
  u32x4 ra0_1, ra1_1, ra2_1, ra3_1, rb0_1, rb1_1, rb2_1, rb3_1;
#define GLD(dst, ptr) dst = *(const u32x4*)(ptr)
#define G_LOAD(S, ko)                          \
  GLD(ra0_##S, pa + 0 * 32 * K + (ko));        \
  GLD(ra1_##S, pa + 1 * 32 * K + (ko));        \
  GLD(ra2_##S, pa + 2 * 32 * K + (ko));        \
  GLD(ra3_##S, pa + 3 * 32 * K + (ko));        \
  GLD(rb0_##S, pb + 0 * 32 * K + (ko));        \
  GLD(rb1_##S, pb + 1 * 32 * K + (ko));        \
  GLD(rb2_##S, pb + 2 * 32 * K + (ko));        \
  GLD(rb3_##S, pb + 3 * 32 * K + (ko));
#define VMWAIT(N, S)
#define L_STORE(S, base)                                                \
  *(u32x4*)((base) + loff + 0 * 4096) = ra0_##S;                          \
  *(u32x4*)((base) + loff + 1 * 4096) = ra1_##S;                          \
  *(u32x4*)((base) + loff + 2 * 4096) = ra2_##S;                          \
  *(u32x4*)((base) + loff + 3 * 4096) = ra3_##S;                          \
  *(u32x4*)((base) + 16384 + loff + 0 * 4096) = rb0_##S;                  \
  *(u32x4*)((base) + 16384 + loff + 1 * 4096) = rb1_##S;                  \
  *(u32x4*)((base) + 16384 + loff + 2 * 4096) = rb2_##S;                  \
  *(u32x4*)((base) + 16384 + loff + 3 * 4096) = rb3_##S;
#define MMA_TILE(As_, Bs_)                                                                        \
  _Pragma("unroll") for (int ks = 0; ks < 2; ++ks) {                                              \
    bf16x8 af[4], bfr[4];                                                                         \
    _Pragma("unroll") for (int mi = 0; mi < 4; ++mi) af[mi] = *(const bf16x8*)((As_) + (aoff ^ (ks << 6)) + mi * 2048);  \
    _Pragma("unroll") for (int ni = 0; ni < 4; ++ni) bfr[ni] = *(const bf16x8*)((Bs_) + (boff ^ (ks << 6)) + ni * 2048); \
    _Pragma("unroll") for (int mi = 0; mi < 4; ++mi)                                              \
      _Pragma("unroll") for (int ni = 0; ni < 4; ++ni)                                            \
        acc[mi][ni] = __builtin_amdgcn_mfma_f32_16x16x32_bf16(af[mi], bfr[ni], acc[mi][ni], 0, 0, 0); \
  }
  int mt, nt;
  TILE_MN(0, mt, nt)
  const u16* pa = A + (size_t)mt * 128 * K + toff;
  const u16* pb = Bt + (size_t)nt * 128 * K + toff;
  G_LOAD(0, 0)
#pragma unroll 1
  for (int ti = 0; ti < ntile; ++ti) {
  const int brow = mt * 128, bcol = nt * 128;
  f32x4 acc[4][4];
#pragma unroll
  for (int i = 0; i < 4; ++i)
#pragma unroll
    for (int j = 0; j < 4; ++j) acc[i][j] = f32x4{0.f, 0.f, 0.f, 0.f};
  L_STORE(0, smem)
  if constexpr (EPI != 1) {
  G_LOAD(1, 64)
  __syncthreads();
#pragma unroll
  for (int kt = 0; kt < nk; kt += 2) {
    if (kt + 2 < nk) { G_LOAD(0, (kt + 2) * 64) }
    __builtin_amdgcn_sched_barrier(0);
    MMA_TILE(smem, smem + 16384)
    __builtin_amdgcn_sched_barrier(0);
    L_STORE(1, smem + 32768)
    __syncthreads();
    if (kt + 3 < nk) { G_LOAD(1, (kt + 3) * 64) }
    __builtin_amdgcn_sched_barrier(0);
    MMA_TILE(smem + 32768, smem + 32768 + 16384)
    __builtin_amdgcn_sched_barrier(0);
    if (kt + 2 < nk) { L_STORE(0, smem) }
    __syncthreads();
  }
  } else {
  __syncthreads();
#pragma unroll 1
  for (int kt = 0; kt < nk; ++kt) {
    const int cur = kt & 1;
    if (kt + 1 < nk) { G_LOAD(0, (kt + 1) * 64) }
    __builtin_amdgcn_sched_barrier(0);
    MMA_TILE(smem + cur * 32768, smem + cur * 32768 + 16384)
    __builtin_amdgcn_sched_barrier(0);
    if (kt + 1 < nk) { L_STORE(0, smem + (cur ^ 1) * 32768) }
    __syncthreads();
  }
  }
  int mt2 = mt, nt2 = nt;
  if (ti + 1 < ntile) {
    TILE_MN(ti + 1, mt2, nt2)
    pa = A + (size_t)mt2 * 128 * K + toff;
    pb = Bt + (size_t)nt2 * 128 * K + toff;
    if constexpr (EPI != 1) { G_LOAD(0, 0) }
  }
  __builtin_amdgcn_sched_barrier(0);
  const int r0 = brow + wr * 64;
  char* stg = smem + wid * 16384;
  if constexpr (EPI == 0 || EPI == 3) {
    const int OW = (EPI == 0) ? 1024 : FH;
    u16* outp = p.big();
    const int jch0 = (bcol + wc * 64) >> 1;
#pragma unroll
    for (int pp = 0; pp < 2; ++pp) {
      float b0 = 0.f, b1 = 0.f;
      if (bias) { b0 = bias[jch0 + pp * 16 + fr]; b1 = bias[1024 + jch0 + pp * 16 + fr]; }
#pragma unroll
      for (int mi = 0; mi < 4; ++mi)
#pragma unroll
        for (int j = 0; j < 4; ++j) {
          float a = acc[mi][2 * pp][j] + b0, g = acc[mi][2 * pp + 1][j] + b1;
          float sg = sigmoidf_(EPI == 0 ? g : a);
          float v = (EPI == 0) ? a * sg : a * sg * g;
          *(u16*)(stg + (mi * 16 + fq * 4 + j) * 80 + (pp * 16 + fr) * 2) = f2bf(v);
        }
    }
    __syncthreads();
#pragma unroll
    for (int it = 0; it < 4; ++it) {
      const int row = it * 16 + (lane >> 2), ch = lane & 3;
      u32x4 val = *(const u32x4*)(stg + row * 80 + ch * 16);
      *(u32x4*)(outp + (size_t)(r0 + row) * OW + jch0 + ch * 8) = val;
    }
    __syncthreads();
  } else if constexpr (EPI == 2) {
    float* sf = (float*)stg;
#pragma unroll
    for (int mi = 0; mi < 4; ++mi)
#pragma unroll
      for (int ni = 0; ni < 4; ++ni)
#pragma unroll
        for (int j = 0; j < 4; ++j) sf[(mi * 16 + fq * 4 + j) * 64 + ((ni ^ fq) << 4) + fr] = acc[mi][ni][j];
    __syncthreads();
    {
      const int r = brow < TL ? brow / SEQ : 8;
      const int c = lane & 15, rsub = lane >> 4;
      const int col0 = bcol + wc * 64 + c * 4;
      const float4 g4 = *(const float4*)(p.modv() + ((size_t)layer * 9 + r) * 6144 + gidx * 1024 + col0);
      float4 b4 = make_float4(0.f, 0.f, 0.f, 0.f);
      if (bias) b4 = *(const float4*)(bias + col0);
      float* hrow = p.h() + (size_t)(r0 + rsub) * 1024 + col0;
      const float* srow = sf + rsub * 64 + (c & 3) * 4;
#pragma unroll 1
      for (int it4 = 0; it4 < 4; ++it4) {
#pragma unroll
        for (int u = 0; u < 4; ++u) {
          const int grp = (c >> 2) ^ u;
          const float4 a4 = *(const float4*)(srow + u * 256 + grp * 16);
          float4* hp = (float4*)(hrow + u * 4096);
          float4 hv = *hp;
          hv.x += g4.x * (a4.x + b4.x); hv.y += g4.y * (a4.y + b4.y); hv.z += g4.z * (a4.z + b4.z); hv.w += g4.w * (a4.w + b4.w);
          *hp = hv;
        }
        hrow += 16 * 1024;
        srow += 16 * 64;
      }
    }
    __syncthreads();
  } else {
    const int region = nt >> 3, hd = nt & 7;
    const bool lat = brow < TL;
    const int b = lat ? brow / SEQ : (brow - TL) / CTX;
    const int kb = lat ? 256 + (r0 - b * SEQ) : (r0 - TL - b * CTX);
    const size_t bh = (size_t)(b * 8 + hd);
    u16* qb = p.big(); u16* kbuf = p.big() + (size_t)T * 1024; u16* vt = p.big() + (size_t)T * 2048;
    if (region < 2) {
      u16* dst = (region == 0 ? qb : kbuf) + ((bh * 2 + wc) * KEYS + kb) * 64;
      const float qs = region == 0 ? 0.125f * 1.44269504088896f : 1.f;
#pragma unroll
      for (int mi = 0; mi < 4; ++mi)
#pragma unroll
        for (int j = 0; j < 4; ++j) {
          int rl = mi * 16 + fq * 4 + j;
          float x0 = acc[mi][0][j], x1 = acc[mi][1][j], x2 = acc[mi][2][j], x3 = acc[mi][3][j];
          if (lat) {
            int t = kb - 256 + rl;
            float2 cr = p.rope()[(t >> 6) * 16 + fr], cc = p.rope()[(t & 63) * 16 + fr];
            float y0 = x0 * cr.x - x1 * cr.y, y1 = x1 * cr.x + x0 * cr.y;
            float y2 = x2 * cc.x - x3 * cc.y, y3 = x3 * cc.x + x2 * cc.y;
            x0 = y0; x1 = y1; x2 = y2; x3 = y3;
          }
          char* sp = stg + rl * 144 + fr * 2;
          *(u16*)(sp) = f2bf(x0 * qs); *(u16*)(sp + 32) = f2bf(x1 * qs); *(u16*)(sp + 64) = f2bf(x2 * qs); *(u16*)(sp + 96) = f2bf(x3 * qs);
          if (j == 3) asm volatile("" ::: "memory");
        }
      __syncthreads();
#pragma unroll
      for (int it = 0; it < 8; ++it) {
        const int row = it * 8 + (lane >> 3), ch = lane & 7;
        u32x4 val = *(const u32x4*)(stg + row * 144 + ch * 16);
        *(u32x4*)(dst + (size_t)row * 64 + ch * 8) = val;
      }
      __syncthreads();
    } else {
#pragma unroll
      for (int ni = 0; ni < 4; ++ni) {
        const int e = ni * 16 + fr;
#pragma unroll
        for (int mi = 0; mi < 4; ++mi) {
          int slot = (mi >> 1) * 32 + fq * 8 + (mi & 1) * 4;
          *(uint2*)(stg + e * 144 + slot * 2) = make_uint2(pack2(acc[mi][ni][0], acc[mi][ni][1]), pack2(acc[mi][ni][2], acc[mi][ni][3]));
        }
      }
      __syncthreads();
      u16* dp = vt + (bh * 128 + wc * 64) * KEYS + kb;
#pragma unroll
      for (int it = 0; it < 8; ++it) {
        const int row = it * 8 + (lane >> 3), ch = lane & 7;
        u32x4 val = *(const u32x4*)(stg + row * 144 + ch * 16);
        *(u32x4*)(dp + (size_t)row * KEYS + ch * 8) = val;
      }
      __syncthreads();
    }
  }
  if constexpr (EPI == 1) { if (ti + 1 < ntile) { G_LOAD(0, 0) } }
  mt = mt2; nt = nt2;
  }
#undef GLD
#undef VMWAIT
#undef G_LOAD
#undef L_STORE
#undef MMA_TILE
#undef TILE_MN
}

__device__ void gemm_phase(const Params& p, const u16* A, const u16* Bt, int K, int Mt, int Nt, int epi, int layer, int gidx,
                           const float* bias, char* smem) {
  if (K != 1024) gemm_run<FH, 2>(p, A, Bt, Mt, Nt, layer, gidx, bias, smem);
  else if (epi == 0) gemm_run<1024, 0>(p, A, Bt, Mt, Nt, layer, gidx, bias, smem);
  else if (epi == 1) gemm_run<1024, 1>(p, A, Bt, Mt, Nt, layer, gidx, bias, smem);
  else if (epi == 2) gemm_run<1024, 2>(p, A, Bt, Mt, Nt, layer, gidx, bias, smem);
  else gemm_run<1024, 3>(p, A, Bt, Mt, Nt, layer, gidx, bias, smem);
}

__device__ void conv_phase(const Params& p, int j, int M, char* smem) {
  const int tid = otid(), wid = tid >> 6, lane = tid & 63;
  float* cbuf = (float*)smem;
  const u16* U = p.big();
  for (int item = blockIdx.x; item < M / 8; item += gridDim.x) {
    const int t0 = item * 8;
    int s0, s1;
    if (t0 < TL) { s0 = (t0 / SEQ) * SEQ; s1 = s0 + SEQ; } else { s0 = TL + ((t0 - TL) / CTX) * CTX; s1 = s0 + CTX; }
#pragma unroll 1
    for (int g = 0; g < 2; ++g) {
      const int c = g * 512 + tid * 2;
      float acc[8][2];
      float w[31][2];
#pragma unroll
      for (int k = 0; k < 31; ++k) { float2 wv = *(const float2*)(p.dw_w() + ((size_t)j * 31 + k) * 1024 + c); w[k][0] = wv.x; w[k][1] = wv.y; }
      float2 bv = *(const float2*)(p.dw_b() + j * 1024 + c);
#pragma unroll
      for (int o = 0; o < 8; ++o) { acc[o][0] = bv.x; acc[o][1] = bv.y; }
#pragma unroll
      for (int ti = 0; ti < 38; ++ti) {
        int tin = t0 - 15 + ti;
        bool valid = tin >= s0 && tin < s1;
        int tc = min(max(tin, s0), s1 - 1);
        unsigned raw = *(const unsigned*)(U + (size_t)tc * 1024 + c);
        if (!valid) raw = 0u;
        float x0 = bf2f(raw & 0xffffu), x1 = bf2f(raw >> 16);
#pragma unroll
        for (int o = 0; o < 8; ++o) {
          const int k = ti - o;
          if (k >= 0 && k < 31) { acc[o][0] += x0 * w[k][0]; acc[o][1] += x1 * w[k][1]; }
        }
      }
#pragma unroll
      for (int o = 0; o < 8; ++o) *(float2*)(cbuf + o * 1024 + c) = make_float2(acc[o][0], acc[o][1]);
    }
    __syncthreads();
#pragma unroll
    for (int tt = 0; tt < 2; ++tt) {
      const int o = wid * 2 + tt;
      float4 v[4];
      float sm = 0.f;
#pragma unroll
      for (int i = 0; i < 4; ++i) { v[i] = *(const float4*)(cbuf + o * 1024 + (lane + 64 * i) * 4); sm += v[i].x + v[i].y + v[i].z + v[i].w; }
#pragma unroll
      for (int sh = 32; sh >= 1; sh >>= 1) sm += __shfl_xor(sm, sh);
      const float mean = sm * (1.f / 1024.f);
      float sq = 0.f;
#pragma unroll
      for (int i = 0; i < 4; ++i) {
        v[i].x -= mean; v[i].y -= mean; v[i].z -= mean; v[i].w -= mean;
        sq += v[i].x * v[i].x + v[i].y * v[i].y + v[i].z * v[i].z + v[i].w * v[i].w;
      }
#pragma unroll
      for (int sh = 32; sh >= 1; sh >>= 1) sq += __shfl_xor(sq, sh);
      const float rstd = rsqrtf(sq * (1.f / 1024.f) + EPS);
      uint2* op = (uint2*)(p.vbuf() + (size_t)(t0 + o) * 1024);
#pragma unroll
      for (int i = 0; i < 4; ++i) {
        int c4 = lane + 64 * i;
        float4 lg = ((const float4*)(p.ln_g() + j * 1024))[c4], lb = ((const float4*)(p.ln_b() + j * 1024))[c4];
        float y0 = v[i].x * rstd * lg.x + lb.x, y1 = v[i].y * rstd * lg.y + lb.y;
        float y2 = v[i].z * rstd * lg.z + lb.z, y3 = v[i].w * rstd * lg.w + lb.w;
        y0 *= sigmoidf_(y0); y1 *= sigmoidf_(y1); y2 *= sigmoidf_(y2); y3 *= sigmoidf_(y3);
        op[c4] = make_uint2(pack2(y0, y1), pack2(y2, y3));
      }
    }
    __syncthreads();
  }
}

__device__ void attn_item(const Params& p, int b, int hd, int q0, int nkeys, int out_row0, float lam, float oscale,
                          const float* __restrict__ subg, char* smem) {
  const int tid = otid(), wid = tid >> 6, lane = tid & 63, fr = lane & 15, fq = lane >> 4;
  const int comp = wid & 1, qg = wid >> 1;
  const size_t bh = (size_t)(b * 8 + hd);
  const u16* qb = p.big(); const u16* kbuf = p.big() + (size_t)T * 1024; const u16* vtb = p.big() + (size_t)T * 2048;
  const u16* Qp = qb + ((bh * 2 + comp) * KEYS + q0 + qg * 32) * 64;
  bf16x8 qf[2][2];
#pragma unroll
  for (int qs = 0; qs < 2; ++qs)
#pragma unroll
    for (int ks = 0; ks < 2; ++ks) qf[qs][ks] = *(const bf16x8*)(Qp + (qs * 16 + fr) * 64 + ks * 32 + fq * 8);
  const u16* K1p = kbuf + (bh * 2 + 0) * KEYS * 64;
  const u16* K2p = kbuf + (bh * 2 + 1) * KEYS * 64;
  const u16* Vp = vtb + bh * 128 * KEYS;
  const int lrow = tid >> 3, lc = tid & 7;
  uint4 rg[8];
#define ATT_GLOAD(kt_)                                                                         \
  {                                                                                            \
    const int key0 = (kt_) * 64;                                                               \
    _Pragma("unroll") for (int i = 0; i < 2; ++i) {                                            \
      rg[i] = *(const uint4*)(K1p + (size_t)(key0 + lrow + i * 32) * 64 + lc * 8);             \
      rg[2 + i] = *(const uint4*)(K2p + (size_t)(key0 + lrow + i * 32) * 64 + lc * 8);         \
    }                                                                                          \
    _Pragma("unroll") for (int i = 0; i < 4; ++i)                                              \
      rg[4 + i] = *(const uint4*)(Vp + (size_t)(lrow + i * 32) * KEYS + key0 + lc * 8);        \
  }
#define ATT_LSTORE(buf_)                                                                       \
  {                                                                                            \
    char* bs_ = smem + (buf_) * 32768;                                                         \
    _Pragma("unroll") for (int i = 0; i < 2; ++i) {                                            \
      *(uint4*)(bs_ + tile_off(lrow + i * 32, lc)) = rg[i];                                    \
      *(uint4*)(bs_ + 8192 + tile_off(lrow + i * 32, lc)) = rg[2 + i];                         \
    }                                                                                          \
    _Pragma("unroll") for (int i = 0; i < 4; ++i)                                              \
      *(uint4*)(bs_ + 16384 + tile_off(lrow + i * 32, lc)) = rg[4 + i];                        \
  }
  f32x4 O[8][2];
#pragma unroll
  for (int e = 0; e < 8; ++e) { O[e][0] = f32x4{0.f, 0.f, 0.f, 0.f}; O[e][1] = f32x4{0.f, 0.f, 0.f, 0.f}; }
  float m[2] = {-1e30f, -1e30f}, l[2] = {0.f, 0.f};
  const int ntile = nkeys >> 6;
  ATT_GLOAD(0);
  ATT_LSTORE(0);
  __syncthreads();
  for (int kt = 0; kt < ntile; ++kt) {
    const int cur = kt & 1;
    if (kt + 1 < ntile) ATT_GLOAD(kt + 1);
    const char* base = smem + cur * 32768;
    const char* Kc = base + comp * 8192;
    const char* Vt = base + 16384;
    f32x4 S[4][2];
#pragma unroll
    for (int i = 0; i < 4; ++i) { S[i][0] = f32x4{0.f, 0.f, 0.f, 0.f}; S[i][1] = f32x4{0.f, 0.f, 0.f, 0.f}; }
#pragma unroll
    for (int ks = 0; ks < 2; ++ks)
#pragma unroll
      for (int ksub = 0; ksub < 4; ++ksub) {
        bf16x8 kf = *(const bf16x8*)(Kc + tile_off(ksub * 16 + fr, ks * 4 + fq));
#pragma unroll
        for (int qs = 0; qs < 2; ++qs) S[ksub][qs] = __builtin_amdgcn_mfma_f32_16x16x32_bf16(kf, qf[qs][ks], S[ksub][qs], 0, 0, 0);
      }
#pragma unroll
    for (int qs = 0; qs < 2; ++qs) {
      float mx = -1e30f;
#pragma unroll
      for (int ksub = 0; ksub < 4; ++ksub)
#pragma unroll
        for (int j = 0; j < 4; ++j) mx = fmaxf(mx, S[ksub][qs][j]);
      mx = fmaxf(mx, __shfl_xor(mx, 16));
      mx = fmaxf(mx, __shfl_xor(mx, 32));
      float mn = fmaxf(m[qs], mx);
      float alpha = fexp2(m[qs] - mn);
      m[qs] = mn;
      float rs = 0.f;
#pragma unroll
      for (int ksub = 0; ksub < 4; ++ksub)
#pragma unroll
        for (int j = 0; j < 4; ++j) { float pv = fexp2(S[ksub][qs][j] - mn); S[ksub][qs][j] = pv; rs += pv; }
      l[qs] = l[qs] * alpha + rs;
      if (__builtin_amdgcn_ballot_w64(alpha != 1.f) != 0) {
#pragma unroll
        for (int e = 0; e < 8; ++e) O[e][qs] *= alpha;
      }
    }
    bf16x8 pf[2][2];
#pragma unroll
    for (int qs = 0; qs < 2; ++qs)
#pragma unroll
      for (int s = 0; s < 2; ++s) {
        unsigned u0 = pack2(S[2 * s][qs][0], S[2 * s][qs][1]), u1 = pack2(S[2 * s][qs][2], S[2 * s][qs][3]);
        unsigned u2 = pack2(S[2 * s + 1][qs][0], S[2 * s + 1][qs][1]), u3 = pack2(S[2 * s + 1][qs][2], S[2 * s + 1][qs][3]);
        uint4 uu = make_uint4(u0, u1, u2, u3);
        pf[qs][s] = *(bf16x8*)&uu;
      }
#pragma unroll
    for (int s = 0; s < 2; ++s)
#pragma unroll
      for (int e = 0; e < 8; ++e) {
        bf16x8 vf = *(const bf16x8*)(Vt + tile_off(e * 16 + fr, s * 4 + fq));
#pragma unroll
        for (int qs = 0; qs < 2; ++qs) O[e][qs] = __builtin_amdgcn_mfma_f32_16x16x32_bf16(vf, pf[qs][s], O[e][qs], 0, 0, 0);
      }
    if (kt + 1 < ntile) ATT_LSTORE(cur ^ 1);
    __syncthreads();
  }
#undef ATT_GLOAD
#undef ATT_LSTORE
#pragma unroll
  for (int qs = 0; qs < 2; ++qs) {
    float ls = l[qs];
    ls += __shfl_xor(ls, 16);
    ls += __shfl_xor(ls, 32);
    float inv = (comp ? lam : 1.f) / ls;
#pragma unroll
    for (int e = 0; e < 8; ++e) O[e][qs] *= inv;
  }
  float* ex = (float*)smem;
  if (comp == 1) {
#pragma unroll
    for (int e = 0; e < 8; ++e)
#pragma unroll
      for (int qs = 0; qs < 2; ++qs) *(f32x4*)(ex + ((((qg * 8 + e) * 2 + qs) * 64 + lane) << 2)) = O[e][qs];
  }
  __syncthreads();
  if (comp == 0) {
#pragma unroll
    for (int qs = 0; qs < 2; ++qs) {
      float ssq = 0.f;
#pragma unroll
      for (int e = 0; e < 8; ++e) {
        f32x4 o2 = *(const f32x4*)(ex + ((((qg * 8 + e) * 2 + qs) * 64 + lane) << 2));
        O[e][qs] -= o2;
#pragma unroll
        for (int j = 0; j < 4; ++j) ssq += O[e][qs][j] * O[e][qs][j];
      }
      ssq += __shfl_xor(ssq, 16);
      ssq += __shfl_xor(ssq, 32);
      float rstd = rsqrtf(ssq * (1.f / 128.f) + EPS) * oscale;
      u16* op = p.vbuf() + (size_t)(out_row0 + qg * 32 + qs * 16 + fr) * 1024 + hd * 128 + fq * 4;
#pragma unroll
      for (int e = 0; e < 8; ++e) {
        float4 sg = *(const float4*)(subg + e * 16 + fq * 4);
        *(uint2*)(op + e * 16) = make_uint2(pack2(O[e][qs][0] * rstd * sg.x, O[e][qs][1] * rstd * sg.y),
                                            pack2(O[e][qs][2] * rstd * sg.z, O[e][qs][3] * rstd * sg.w));
      }
    }
  }
  __syncthreads();
}

__device__ void attn_phase(const Params& p, int layer, bool with_ctx, char* smem) {
  const int ja = layer >> 1;
  const float* lv = p.lam() + ja * 256;
  float d01 = 0.f, d23 = 0.f;
  for (int i = 0; i < 64; ++i) { d01 += lv[i] * lv[64 + i]; d23 += lv[128 + i] * lv[192 + i]; }
  const float lam_init = 0.8f - 0.6f * expf(-0.3f * (float)layer);
  const float lam = expf(d01) - expf(d23) + lam_init;
  const float* subg = p.subln() + ja * 128;
  {
    const int xcd = blockIdx.x & 7, rank = blockIdx.x >> 3, rpx = gridDim.x >> 3;
    for (int r = 0; r < 4; ++r)
      for (int q = rank; q < 64; q += rpx) {
        const int bh = r * 16 + xcd * 2 + (q >> 5), qt = q & 31;
        const int b = bh >> 3, hd = bh & 7;
        attn_item(p, b, hd, 256 + qt * 64, KEYS, b * SEQ + qt * 64, lam, 1.f - lam_init, subg, smem);
      }
  }
  if (with_ctx) {
    for (int it = blockIdx.x; it < 256; it += gridDim.x) {
      const int qt = it & 3, hd = (it >> 2) & 7, b = it >> 5;
      attn_item(p, b, hd, qt * 64, CTX, TL + b * CTX + qt * 64, lam, 1.f - lam_init, subg, smem);
    }
  }
}

__device__ void run_phase(const Params& p, int ph_in, char* smem) {
  const int ph = ph_in & 0xffff; const bool noepi = (ph_in >> 16) != 0;
  if (ph == 0) { prologue_phase(p, smem); return; }
  if (ph == NPH - 1) { final_phase(p); return; }
  const int layer = (ph - 1) / 7, sub = (ph - 1) % 7;
  const bool last = layer == DEPTH - 1;
  const int M = last ? TL : T;
  const bool is_conv = (layer & 1) == 0;
  const int j = layer >> 1;
  if (sub == 0 || sub == 4) { norm_phase(p, layer, sub == 4 ? 1 : 0, sub == 0 ? T : M); return; }
  if (sub == 2) {
    if (is_conv) conv_phase(p, j, T, smem);
    else attn_phase(p, layer, !last, smem);
    return;
  }
  const u16 *A, *Bt; int K = 1024, Nt, epi, gidx = 0, mtiles = M / 128; const float* bias = nullptr;
  if (sub == 1) {
    A = p.nbuf(); mtiles = T / 128;
    if (is_conv) { Bt = p.w_pw1() + (size_t)j * 2048 * 1024; Nt = 16; epi = 0; bias = p.pw1_b() + j * 2048; }
    else { Bt = p.w_qkv() + (size_t)j * 3072 * 1024; Nt = 24; epi = 1; }
  } else if (sub == 3) {
    A = p.vbuf(); Nt = 8; epi = 2; gidx = 2;
    if (is_conv) { Bt = p.w_pw2() + (size_t)j * 1024 * 1024; bias = p.pw2_b() + j * 1024; }
    else Bt = p.w_o() + (size_t)j * 1024 * 1024;
  } else if (sub == 5) {
    A = p.nbuf(); Bt = p.w_fin() + (size_t)layer * 5632 * 1024; Nt = 44; epi = 3;
  } else {
    A = p.big(); Bt = p.w_fout() + (size_t)layer * 1024 * FH; K = FH; Nt = 8; epi = 2; gidx = 5;
  }
  gemm_phase(p, A, Bt, K, mtiles, Nt, epi, layer, gidx, bias, smem);
}

__device__ __forceinline__ unsigned xcc_id() { return (unsigned)__builtin_amdgcn_s_getreg((3 << 11) | 20) & 0xFu; }
__device__ __forceinline__ void grid_barrier(unsigned* bar, unsigned xcc, unsigned k, unsigned nloc, unsigned nx) {
  __syncthreads();
  if (threadIdx.x == 0) {
    unsigned a = __hip_atomic_fetch_add(&bar[1024 + xcc * 64], 1u, __ATOMIC_RELAXED, __HIP_MEMORY_SCOPE_AGENT) + 1u;
    if (a == k * nloc) {
      __builtin_amdgcn_fence(__ATOMIC_RELEASE, "agent");
      asm volatile("s_waitcnt vmcnt(0)" ::: "memory");
      __hip_atomic_fetch_add(&bar[2048], 1u, __ATOMIC_RELAXED, __HIP_MEMORY_SCOPE_AGENT);
    }
    while (__hip_atomic_load(&bar[2048], __ATOMIC_RELAXED, __HIP_MEMORY_SCOPE_AGENT) < k * nx) __builtin_amdgcn_s_sleep(2);
    __builtin_amdgcn_fence(__ATOMIC_ACQUIRE, "agent");
    asm volatile("s_waitcnt vmcnt(0)" ::: "memory");
  }
  __syncthreads();
}

__global__ void __launch_bounds__(256, 2) mega(Params p, int ph_begin, int ph_end, int use_sync) {
  __shared__ __attribute__((aligned(16))) char smem[65536];
  __shared__ unsigned s_cnt[2];
  cg::grid_group grid = cg::this_grid();
  unsigned* bar = (unsigned*)(p.ws + WS_NEED);
  const unsigned xcc = xcc_id();
  if (use_sync && threadIdx.x == 0) __hip_atomic_fetch_add(&bar[xcc * 64], 1u, __ATOMIC_RELAXED, __HIP_MEMORY_SCOPE_AGENT);
  unsigned k = 0, nloc = 1, nx = 1;
  for (int ph = ph_begin; ph < ph_end; ++ph) {
    run_phase(p, ph, smem);
#ifdef DUP_MASK
    if (ph > ph_begin) {
      const int sub = (ph >= 1 && ph < NPH - 1) ? (ph - 1) % 7 : -1, layer = (ph - 1) / 7;
      bool dup = false;
      if ((DUP_MASK & 1) && sub == 2 && (layer & 1)) dup = true;
      if ((DUP_MASK & 2) && (sub == 1 || sub == 5)) dup = true;
      if ((DUP_MASK & 4) && sub == 2 && !(layer & 1)) dup = true;
      if ((DUP_MASK & 8) && (sub == 0 || sub == 4)) dup = true;
      if (dup) { ++k; grid_barrier(bar, xcc, k, nloc, nx); run_phase(p, ph | DUP_FLAG, smem); }
    }
#endif
    if (use_sync && ph + 1 < ph_end) {
      if (ph == ph_begin) {
        grid.sync();
        if (threadIdx.x == 0) {
          unsigned cnt = 0;
          for (int j = 0; j < 16; ++j) cnt += __hip_atomic_load(&bar[j * 64], __ATOMIC_RELAXED, __HIP_MEMORY_SCOPE_AGENT) ? 1u : 0u;
          s_cnt[0] = __hip_atomic_load(&bar[xcc * 64], __ATOMIC_RELAXED, __HIP_MEMORY_SCOPE_AGENT);
          s_cnt[1] = cnt;
        }
        __syncthreads();
        nloc = __builtin_amdgcn_readfirstlane(s_cnt[0]); nx = __builtin_amdgcn_readfirstlane(s_cnt[1]);
      } else {
        ++k;
        grid_barrier(bar, xcc, k, nloc, nx);
      }
    }
  }
}

extern "C" void kernel_launch(void* const* d_in, const int* in_sizes, int n_in, void* d_out, int out_size, void* d_ws,
                              size_t ws_size, hipStream_t stream) {
  Params p{};
  for (int i = 0; i < 22; ++i) p.in[i] = (const float*)d_in[i];
  p.outp = (float*)d_out;
  p.ws = (char*)d_ws;
  if (WS_NEED + 16384 > ws_size || n_in < 22) return;
  static int grid_blocks = 0;
  if (!grid_blocks) {
    int dev = 0, cus = 0, per_cu = 0;
    hipGetDevice(&dev);
    hipDeviceGetAttribute(&cus, hipDeviceAttributeMultiprocessorCount, dev);
    hipOccupancyMaxActiveBlocksPerMultiprocessor(&per_cu, mega, 256, 0);
    if (per_cu > 2) per_cu = 2;
    if (per_cu < 1) per_cu = 1;
    grid_blocks = cus * per_cu;
  }
#if MULTI_LAUNCH
  for (int ph = 0; ph < NPH; ++ph) mega<<<grid_blocks, 256, 0, stream>>>(p, ph, ph + 1, 0);
#else
  hipMemsetAsync((char*)d_ws + WS_NEED, 0, 16384, stream);
  int b = 0, e = NPH, s = 1;
  void* args[] = {&p, &b, &e, &s};
  hipError_t err = hipLaunchCooperativeKernel((void*)mega, dim3(grid_blocks), dim3(256), args, 0, stream);
  if (err != hipSuccess) fprintf(stderr, "cooperative launch failed: %s (grid %d)\n", hipGetErrorString(err), grid_blocks);
#endif
}
```

```cpp
#include <hip/hip_runtime.h>
#include <hip/hip_cooperative_groups.h>
#include <cstdio>
namespace cg = cooperative_groups;

#ifndef DUP_FLAG
#define DUP_FLAG 0
#endif
#ifndef MULTI_LAUNCH
#define MULTI_LAUNCH 0
#endif

typedef unsigned short u16;
using bf16x8 = __attribute__((ext_vector_type(8))) short;
using f32x4 = __attribute__((ext_vector_type(4))) float;
using u32x4 = __attribute__((ext_vector_type(4))) unsigned;

constexpr int D = 1024, NB = 8, SEQ = 2048, CTX = 256, DEPTH = 4;
constexpr int TL = NB * SEQ;
constexpr int TCX = NB * CTX;
constexpr int T = TL + TCX;
constexpr int FH = 2816;
constexpr int KEYS = CTX + SEQ;
constexpr int NPH = 2 + 7 * DEPTH;
constexpr float EPS = 1e-6f;

constexpr size_t al256(size_t x) { return (x + 255) & ~(size_t)255; }
constexpr size_t OFF_WPW1 = 0;
constexpr size_t OFF_WPW2 = OFF_WPW1 + al256((size_t)2 * 2048 * 1024 * 2);
constexpr size_t OFF_WQKV = OFF_WPW2 + al256((size_t)2 * 1024 * 1024 * 2);
constexpr size_t OFF_WO = OFF_WQKV + al256((size_t)2 * 3072 * 1024 * 2);
constexpr size_t OFF_WFIN = OFF_WO + al256((size_t)2 * 1024 * 1024 * 2);
constexpr size_t OFF_WFOUT = OFF_WFIN + al256((size_t)4 * 5632 * 1024 * 2);
constexpr size_t OFF_H = OFF_WFOUT + al256((size_t)4 * 1024 * FH * 2);
constexpr size_t OFF_NBUF = OFF_H + al256((size_t)T * 1024 * 4);
constexpr size_t OFF_BIG = OFF_NBUF + al256((size_t)T * 1024 * 2);
constexpr size_t OFF_VBUF = OFF_BIG + al256((size_t)T * 3072 * 2);
constexpr size_t OFF_MODV = OFF_VBUF + al256((size_t)T * 1024 * 2);
constexpr size_t OFF_ROPE = OFF_MODV + al256((size_t)4 * 9 * 6144 * 4);
constexpr size_t WS_NEED = OFF_ROPE + al256((size_t)1024 * 8);

struct Params {
  const float* in[22];
  float* outp;
  char* ws;
  __device__ __forceinline__ const float* x() const { return in[0]; }
  __device__ __forceinline__ const float* c() const { return in[1]; }
  __device__ __forceinline__ const float* ctx() const { return in[2]; }
  __device__ __forceinline__ const float* c_ctx() const { return in[3]; }
  __device__ __forceinline__ const float* mod_w() const { return in[4]; }
  __device__ __forceinline__ const float* mod_b() const { return in[5]; }
  __device__ __forceinline__ const float* norm_g() const { return in[6]; }
  __device__ __forceinline__ const float* pw1_w() const { return in[7]; }
  __device__ __forceinline__ const float* pw1_b() const { return in[8]; }
  __device__ __forceinline__ const float* dw_w() const { return in[9]; }
  __device__ __forceinline__ const float* dw_b() const { return in[10]; }
  __device__ __forceinline__ const float* ln_g() const { return in[11]; }
  __device__ __forceinline__ const float* ln_b() const { return in[12]; }
  __device__ __forceinline__ const float* pw2_w() const { return in[13]; }
  __device__ __forceinline__ const float* pw2_b() const { return in[14]; }
  __device__ __forceinline__ const float* wqkv() const { return in[15]; }
  __device__ __forceinline__ const float* lam() const { return in[16]; }
  __device__ __forceinline__ const float* subln() const { return in[17]; }
  __device__ __forceinline__ const float* wo() const { return in[18]; }
  __device__ __forceinline__ const float* ffn_in() const { return in[19]; }
  __device__ __forceinline__ const float* ffn_out() const { return in[20]; }
  __device__ __forceinline__ const float* final_g() const { return in[21]; }
  __device__ __forceinline__ float* out() const { return outp; }
  __device__ __forceinline__ u16* w_pw1() const { return (u16*)(ws + OFF_WPW1); }
  __device__ __forceinline__ u16* w_pw2() const { return (u16*)(ws + OFF_WPW2); }
  __device__ __forceinline__ u16* w_qkv() const { return (u16*)(ws + OFF_WQKV); }
  __device__ __forceinline__ u16* w_o() const { return (u16*)(ws + OFF_WO); }
  __device__ __forceinline__ u16* w_fin() const { return (u16*)(ws + OFF_WFIN); }
  __device__ __forceinline__ u16* w_fout() const { return (u16*)(ws + OFF_WFOUT); }
  __device__ __forceinline__ float* h() const { return (float*)(ws + OFF_H); }
  __device__ __forceinline__ u16* nbuf() const { return (u16*)(ws + OFF_NBUF); }
  __device__ __forceinline__ u16* big() const { return (u16*)(ws + OFF_BIG); }
  __device__ __forceinline__ u16* vbuf() const { return (u16*)(ws + OFF_VBUF); }
  __device__ __forceinline__ float* modv() const { return (float*)(ws + OFF_MODV); }
  __device__ __forceinline__ float2* rope() const { return (float2*)(ws + OFF_ROPE); }
};

typedef __bf16 bf2v __attribute__((ext_vector_type(2)));
typedef float f2v __attribute__((ext_vector_type(2)));
__device__ __forceinline__ unsigned pack2(float a, float b) {
  f2v v = {a, b};
  bf2v r = __builtin_convertvector(v, bf2v);
  return *(unsigned*)&r;
}
__device__ __forceinline__ u16 f2bf(float f) { return (u16)(pack2(f, 0.f) & 0xffffu); }
__device__ __forceinline__ float bf2f(unsigned v) { return __uint_as_float(v << 16); }
__device__ __forceinline__ int tile_off(int row, int chunk) { return row * 128 + (((chunk ^ row) & 7) << 4); }
__device__ __forceinline__ float fexp2(float x) { return __builtin_amdgcn_exp2f(x); }
__device__ __forceinline__ float sigmoidf_(float x) { return __builtin_amdgcn_rcpf(1.f + __expf(-x)); }

__device__ __forceinline__ int otid() { int t = threadIdx.x; asm volatile("" : "+v"(t)); return t; }

struct WDesc { const float* sp; u16* dp; int N, K; };
__device__ __forceinline__ WDesc wconv_decode(const Params& p, int item, int tid) {
  int K, N, half = 0, tpl, ntN, base;
  const float* src; u16* dst;
  if (item < 1024)      { base = 0;    K = 1024; N = 2048; half = 1024; tpl = 512;  ntN = 32; src = p.pw1_w();  dst = p.w_pw1(); }
  else if (item < 1536) { base = 1024; K = 1024; N = 1024;              tpl = 256;  ntN = 16; src = p.pw2_w();  dst = p.w_pw2(); }
  else if (item < 3072) { base = 1536; K = 1024; N = 3072;              tpl = 768;  ntN = 48; src = p.wqkv();   dst = p.w_qkv(); }
  else if (item < 3584) { base = 3072; K = 1024; N = 1024;              tpl = 256;  ntN = 16; src = p.wo();     dst = p.w_o(); }
  else if (item < 9216) { base = 3584; K = 1024; N = 5632; half = 2816; tpl = 1408; ntN = 88; src = p.ffn_in(); dst = p.w_fin(); }
  else                  { base = 9216; K = 2816; N = 1024;              tpl = 704;  ntN = 16; src = p.ffn_out(); dst = p.w_fout(); }
  const int it = item - base;
  const int l = it / tpl, rem = it % tpl, kt = rem / ntN, nt = rem % ntN;
  src += (size_t)l * K * N; dst += (size_t)l * K * N;
  const int nl = tid & 63, kk0 = tid >> 6;
  const int np = nt * 64 + nl;
  int sc = np;
  if (half) { int blk = np >> 5, w = np & 31; sc = blk * 16 + (w & 15) + ((w >> 4) ? half : 0); }
  WDesc d;
  d.sp = src + (size_t)(kt * 64 + kk0) * N + sc;
  d.dp = dst + (size_t)(nt * 64 + (tid >> 2)) * K + kt * 64 + (tid & 3) * 16;
  d.N = N; d.K = K;
  return d;
}

__device__ void wconv_loop(const Params& p, char* smem) {
  float* tl = (float*)smem;
  const int tid = otid();
  const int nl = tid & 63, kk0 = tid >> 6, nl2 = tid >> 2, kq = tid & 3;
  int item = blockIdx.x;
  if (item >= 12032) return;
  float v[16];
  WDesc d = wconv_decode(p, item, tid);
#pragma unroll
  for (int i = 0; i < 16; ++i) v[i] = d.sp[(size_t)(4 * i) * d.N];
  for (; item < 12032; item += gridDim.x) {
#pragma unroll
    for (int i = 0; i < 16; ++i) tl[(kk0 + 4 * i) * 65 + nl] = v[i];
    u16* dp = d.dp;
    const int nxt = item + gridDim.x;
    if (nxt < 12032) {
      d = wconv_decode(p, nxt, tid);
#pragma unroll
      for (int i = 0; i < 16; ++i) v[i] = d.sp[(size_t)(4 * i) * d.N];
    }
    __syncthreads();
    unsigned pk[8];
#pragma unroll
    for (int e = 0; e < 8; ++e) pk[e] = pack2(tl[(kq * 16 + 2 * e) * 65 + nl2], tl[(kq * 16 + 2 * e + 1) * 65 + nl2]);
    ((uint4*)dp)[0] = make_uint4(pk[0], pk[1], pk[2], pk[3]);
    ((uint4*)dp)[1] = make_uint4(pk[4], pk[5], pk[6], pk[7]);
    __syncthreads();
  }
}

__device__ void prologue_phase(const Params& p, char* smem) {
  const int tid = otid(), wid = tid >> 6, lane = tid & 63;
  if (blockIdx.x < 384) {
    float* s = (float*)smem;
    float* red = (float*)(smem + 36864);
    for (int idx = tid; idx < 9 * 1024; idx += 256) {
      int r = idx >> 10, k = idx & 1023;
      float cv = r < 8 ? p.c()[r * 1024 + k] : p.c_ctx()[k];
      s[idx] = cv * sigmoidf_(cv);
    }
    __syncthreads();
    for (int item = blockIdx.x; item < 384; item += gridDim.x) {
      int i = item / 96, cgp = item % 96;
      float a[9];
#pragma unroll
      for (int r = 0; r < 9; ++r) a[r] = 0.f;
      const float* wp = p.mod_w() + ((size_t)i * 1024 + wid * 256) * 6144 + cgp * 64 + lane;
#pragma unroll 4
      for (int k4 = 0; k4 < 256; k4 += 4) {
        float w0 = wp[(size_t)(k4 + 0) * 6144], w1 = wp[(size_t)(k4 + 1) * 6144];
        float w2 = wp[(size_t)(k4 + 2) * 6144], w3 = wp[(size_t)(k4 + 3) * 6144];
#pragma unroll
        for (int r = 0; r < 9; ++r) {
          float4 sv = *(const float4*)&s[r * 1024 + wid * 256 + k4];
          a[r] += sv.x * w0 + sv.y * w1 + sv.z * w2 + sv.w * w3;
        }
      }
#pragma unroll
      for (int r = 0; r < 9; ++r) red[(wid * 9 + r) * 64 + lane] = a[r];
      __syncthreads();
      for (int idx = tid; idx < 9 * 64; idx += 256) {
        int r = idx >> 6, l = idx & 63;
        float v = red[(0 * 9 + r) * 64 + l] + red[(1 * 9 + r) * 64 + l] + red[(2 * 9 + r) * 64 + l] + red[(3 * 9 + r) * 64 + l];
        v += p.mod_b()[i * 6144 + cgp * 64 + l];
        p.modv()[((size_t)i * 9 + r) * 6144 + cgp * 64 + l] = v;
      }
      __syncthreads();
    }
  }
  if (blockIdx.x == gridDim.x - 1) {
    for (int idx = tid; idx < 1024; idx += 256) {
      int pos = idx >> 4, f = idx & 15;
      float inv = powf(10000.f, -(float)f / 16.f);
      float ang = (float)pos * inv;
      p.rope()[idx] = make_float2(cosf(ang), sinf(ang));
    }
  }
  wconv_loop(p, smem);
  {
    const float4* x4 = (const float4*)p.x(); const float4* c4 = (const float4*)p.ctx(); float4* h4 = (float4*)p.h();
    for (int idx = blockIdx.x * 256 + tid; idx < T * 256; idx += gridDim.x * 256)
      h4[idx] = idx < TL * 256 ? x4[idx] : c4[idx - TL * 256];
  }
}

__device__ void norm_phase(const Params& p, int layer, int which, int M) {
  const int tid = otid(), wid = tid >> 6, lane = tid & 63;
  const float* g = p.norm_g() + (layer * 2 + which) * 1024;
  const int stride = gridDim.x * 4;
  for (int row = blockIdx.x * 4 + wid; row < M; row += 2 * stride) {
    const int rowB = row + stride;
    const bool hasB = rowB < M;
    const int rB = hasB ? rowB : row;
    const float4* hpA = (const float4*)(p.h() + (size_t)row * 1024);
    const float4* hpB = (const float4*)(p.h() + (size_t)rB * 1024);
    float4 va[4], vb[4];
#pragma unroll
    for (int i = 0; i < 4; ++i) { va[i] = hpA[lane + 64 * i]; vb[i] = hpB[lane + 64 * i]; }
    float sa = 0.f, sb = 0.f;
#pragma unroll
    for (int i = 0; i < 4; ++i) {
      sa += va[i].x * va[i].x + va[i].y * va[i].y + va[i].z * va[i].z + va[i].w * va[i].w;
      sb += vb[i].x * vb[i].x + vb[i].y * vb[i].y + vb[i].z * vb[i].z + vb[i].w * vb[i].w;
    }
#pragma unroll
    for (int o = 32; o >= 1; o >>= 1) { sa += __shfl_xor(sa, o); sb += __shfl_xor(sb, o); }
    const float rstdA = rsqrtf(sa * (1.f / 1024.f) + EPS), rstdB = rsqrtf(sb * (1.f / 1024.f) + EPS);
    const int ra = row < TL ? row / SEQ : 8, rb = rB < TL ? rB / SEQ : 8;
    const float* mva = p.modv() + ((size_t)layer * 9 + ra) * 6144;
    const float* mvb = p.modv() + ((size_t)layer * 9 + rb) * 6144;
    const int so = (which ? 3 : 0) * 1024, co = (which ? 4 : 1) * 1024;
    uint2* opA = (uint2*)(p.nbuf() + (size_t)row * 1024);
    uint2* opB = (uint2*)(p.nbuf() + (size_t)rB * 1024);
#pragma unroll
    for (int i = 0; i < 4; ++i) {
      const int c4 = lane + 64 * i;
      const float4 gg = ((const float4*)g)[c4];
      {
        const float4 s4 = ((const float4*)(mva + co))[c4], h4 = ((const float4*)(mva + so))[c4];
        float y0 = va[i].x * rstdA * gg.x * (1.f + s4.x) + h4.x, y1 = va[i].y * rstdA * gg.y * (1.f + s4.y) + h4.y;
        float y2 = va[i].z * rstdA * gg.z * (1.f + s4.z) + h4.z, y3 = va[i].w * rstdA * gg.w * (1.f + s4.w) + h4.w;
        opA[c4] = make_uint2(pack2(y0, y1), pack2(y2, y3));
      }
      if (hasB) {
        const float4 s4 = ((const float4*)(mvb + co))[c4], h4 = ((const float4*)(mvb + so))[c4];
        float y0 = vb[i].x * rstdB * gg.x * (1.f + s4.x) + h4.x, y1 = vb[i].y * rstdB * gg.y * (1.f + s4.y) + h4.y;
        float y2 = vb[i].z * rstdB * gg.z * (1.f + s4.z) + h4.z, y3 = vb[i].w * rstdB * gg.w * (1.f + s4.w) + h4.w;
        opB[c4] = make_uint2(pack2(y0, y1), pack2(y2, y3));
      }
    }
  }
}

__device__ void final_phase(const Params& p) {
  const int tid = otid(), wid = tid >> 6, lane = tid & 63;
  for (int row = blockIdx.x * 4 + wid; row < TL; row += gridDim.x * 4) {
    const float4* hp = (const float4*)(p.h() + (size_t)row * 1024);
    float4 v[4];
    float ss = 0.f;
#pragma unroll
    for (int i = 0; i < 4; ++i) { v[i] = hp[lane + 64 * i]; ss += v[i].x * v[i].x + v[i].y * v[i].y + v[i].z * v[i].z + v[i].w * v[i].w; }
#pragma unroll
    for (int o = 32; o >= 1; o >>= 1) ss += __shfl_xor(ss, o);
    float rstd = rsqrtf(ss * (1.f / 1024.f) + EPS);
    float4* op = (float4*)(p.out() + (size_t)row * 1024);
#pragma unroll
    for (int i = 0; i < 4; ++i) {
      int c4 = lane + 64 * i;
      float4 gg = ((const float4*)p.final_g())[c4];
      float4 ov = make_float4(v[i].x * rstd * gg.x, v[i].y * rstd * gg.y, v[i].z * rstd * gg.z, v[i].w * rstd * gg.w);
      op[c4] = ov;
    }
  }
}

template <int K, int EPI>
__device__ __forceinline__ void gemm_run(const Params& p, const u16* __restrict__ A, const u16* __restrict__ Bt,
                          int Mt, int Nt, int layer, int gidx, const float* __restrict__ bias, char* smem) {
  const int tid = otid(), wid = tid >> 6, lane = tid & 63, wr = wid >> 1, wc = wid & 1, fr = lane & 15, fq = lane >> 4;
  const int xcd = blockIdx.x & 7, rank = blockIdx.x >> 3, rpx = gridDim.x >> 3;
  const int SN = (Nt & 7) == 0 ? 8 : 4, SM = 64 / SN;
  const int nsn = Nt / SN, total_s = (Mt / SM) * nsn;
  const int cq = rank < 64 ? (64 - rank + rpx - 1) / rpx : 0;
  const int nsx = xcd < total_s ? (total_s - xcd + 7) / 8 : 0;
  const int ntile = cq * nsx;
  if (ntile == 0) return;
#define TILE_MN(i_, mt_, nt_)                                              \
  {                                                                        \
    const int si_ = (i_) / cq, qi_ = (i_) - si_ * cq;                      \
    const int sidx_ = xcd + 8 * si_, q_ = rank + rpx * qi_;                \
    const int ms_ = sidx_ / nsn, ns_ = sidx_ - ms_ * nsn;                  \
    mt_ = ms_ * SM + q_ / SN;                                              \
    nt_ = ns_ * SN + q_ % SN;                                              \
  }
  constexpr int nk = K / 64;
  const int lrow = tid >> 3, lc = tid & 7;
  const int toff = lrow * K + lc * 8;
  const int loff = tile_off(lrow, lc);
  const int aoff = tile_off(wr * 64 + fr, fq);
  const int boff = tile_off(wc * 64 + fr, fq);
  u32x4 ra0_0, ra1_0, ra2_0, ra3_0, rb0_0, rb1_0, rb2_0, rb3_0;
  u32x4 ra0_1, ra1_1, ra2_1, ra3_1, rb0_1, rb1_1, rb2_1, rb3_1;
#define GLD(dst, ptr) dst = *(const u32x4*)(ptr)
#define G_LOAD(S, ko)                          \
  GLD(ra0_##S, pa + 0 * 32 * K + (ko));        \
  GLD(ra1_##S, pa + 1 * 32 * K + (ko));        \
  GLD(ra2_##S, pa + 2 * 32 * K + (ko));        \
  GLD(ra3_##S, pa + 3 * 32 * K + (ko));        \
  GLD(rb0_##S, pb + 0 * 32 * K + (ko));        \
  GLD(rb1_##S, pb + 1 * 32 * K + (ko));        \
  GLD(rb2_##S, pb + 2 * 32 * K + (ko));        \
  GLD(rb3_##S, pb + 3 * 32 * K + (ko));
#define VMWAIT(N, S)
#define L_STORE(S, base)                                                \
  *(u32x4*)((base) + loff + 0 * 4096) = ra0_##S;                          \
  *(u32x4*)((base) + loff + 1 * 4096) = ra1_##S;                          \
  *(u32x4*)((base) + loff + 2 * 4096) = ra2_##S;                          \
  *(u32x4*)((base) + loff + 3 * 4096) = ra3_##S;                          \
  *(u32x4*)((base) + 16384 + loff + 0 * 4096) = rb0_##S;                  \
  *(u32x4*)((base) + 16384 + loff + 1 * 4096) = rb1_##S;                  \
  *(u32x4*)((base) + 16384 + loff + 2 * 4096) = rb2_##S;                  \
  *(u32x4*)((base) + 16384 + loff + 3 * 4096) = rb3_##S;
#define MMA_TILE(As_, Bs_)                                                                        \
  __builtin_amdgcn_s_setprio(1);                                                                  \
  _Pragma("unroll") for (int ks = 0; ks < 2; ++ks) {                                              \
    bf16x8 af[4], bfr[4];                                                                         \
    _Pragma("unroll") for (int mi = 0; mi < 4; ++mi) af[mi] = *(const bf16x8*)((As_) + (aoff ^ (ks << 6)) + mi * 2048);  \
    _Pragma("unroll") for (int ni = 0; ni < 4; ++ni) bfr[ni] = *(const bf16x8*)((Bs_) + (boff ^ (ks << 6)) + ni * 2048); \
    _Pragma("unroll") for (int mi = 0; mi < 4; ++mi)                                              \
      _Pragma("unroll") for (int ni = 0; ni < 4; ++ni)                                            \
        acc[mi][ni] = __builtin_amdgcn_mfma_f32_16x16x32_bf16(af[mi], bfr[ni], acc[mi][ni], 0, 0, 0); \
  }                                                                                               \
  __builtin_amdgcn_s_setprio(0);
  int mt, nt;
  TILE_MN(0, mt, nt)
  const u16* pa = A + (size_t)mt * 128 * K + toff;
  const u16* pb = Bt + (size_t)nt * 128 * K + toff;
  G_LOAD(0, 0)
#pragma unroll 1
  for (int ti = 0; ti < ntile; ++ti) {
  const int brow = mt * 128, bcol = nt * 128;
  f32x4 acc[4][4];
#pragma unroll
  for (int i = 0; i < 4; ++i)
#pragma unroll
    for (int j = 0; j < 4; ++j) acc[i][j] = f32x4{0.f, 0.f, 0.f, 0.f};
  L_STORE(0, smem)
  if constexpr (EPI != 1) {
  G_LOAD(1, 64)
  __syncthreads();
#pragma unroll
  for (int kt = 0; kt < nk; kt += 2) {
    if (kt + 2 < nk) { G_LOAD(0, (kt + 2) * 64) }
    __builtin_amdgcn_sched_barrier(0);
    MMA_TILE(smem, smem + 16384)
    __builtin_amdgcn_sched_barrier(0);
    L_STORE(1, smem + 32768)
    __syncthreads();
    if (kt + 3 < nk) { G_LOAD(1, (kt + 3) * 64) }
    __builtin_amdgcn_sched_barrier(0);
    MMA_TILE(smem + 32768, smem + 32768 + 16384)
    __builtin_amdgcn_sched_barrier(0);
    if (kt + 2 < nk) { L_STORE(0, smem) }
    __syncthreads();
  }
  } else {
  __syncthreads();
#pragma unroll 1
  for (int kt = 0; kt < nk; ++kt) {
    const int cur = kt & 1;
    if (kt + 1 < nk) { G_LOAD(0, (kt + 1) * 64) }
    __builtin_amdgcn_sched_barrier(0);
    MMA_TILE(smem + cur * 32768, smem + cur * 32768 + 16384)
    __builtin_amdgcn_sched_barrier(0);
    if (kt + 1 < nk) { L_STORE(0, smem + (cur ^ 1) * 32768) }
    __syncthreads();
  }
  }
  int mt2 = mt, nt2 = nt;
  if (ti + 1 < ntile) {
    TILE_MN(ti + 1, mt2, nt2)
    pa = A + (size_t)mt2 * 128 * K + toff;
    pb = Bt + (size_t)nt2 * 128 * K + toff;
    if constexpr (EPI != 1) { G_LOAD(0, 0) }
  }
  __builtin_amdgcn_sched_barrier(0);
  const int r0 = brow + wr * 64;
  char* stg = smem + wid * 16384;
  if constexpr (EPI == 0 || EPI == 3) {
    const int OW = (EPI == 0) ? 1024 : FH;
    u16* outp = p.big();
    const int jch0 = (bcol + wc * 64) >> 1;
#pragma unroll
    for (int pp = 0; pp < 2; ++pp) {
      float b0 = 0.f, b1 = 0.f;
      if (bias) { b0 = bias[jch0 + pp * 16 + fr]; b1 = bias[1024 + jch0 + pp * 16 + fr]; }
#pragma unroll
      for (int mi = 0; mi < 4; ++mi)
#pragma unroll
        for (int j = 0; j < 4; ++j) {
          float a = acc[mi][2 * pp][j] + b0, g = acc[mi][2 * pp + 1][j] + b1;
          float sg = sigmoidf_(EPI == 0 ? g : a);
          float v = (EPI == 0) ? a * sg : a * sg * g;
          *(u16*)(stg + (mi * 16 + fq * 4 + j) * 80 + (pp * 16 + fr) * 2) = f2bf(v);
        }
    }
    __syncthreads();
#pragma unroll
    for (int it = 0; it < 4; ++it) {
      const int row = it * 16 + (lane >> 2), ch = lane & 3;
      u32x4 val = *(const u32x4*)(stg + row * 80 + ch * 16);
      *(u32x4*)(outp + (size_t)(r0 + row) * OW + jch0 + ch * 8) = val;
    }
    __syncthreads();
  } else if constexpr (EPI == 2) {
    float* sf = (float*)stg;
#pragma unroll
    for (int mi = 0; mi < 4; ++mi)
#pragma unroll
      for (int ni = 0; ni < 4; ++ni)
#pragma unroll
        for (int j = 0; j < 4; ++j) sf[(mi * 16 + fq * 4 + j) * 64 + ((ni ^ fq) << 4) + fr] = acc[mi][ni][j];
    __syncthreads();
    {
      const int r = brow < TL ? brow / SEQ : 8;
      const int c = lane & 15, rsub = lane >> 4;
      const int col0 = bcol + wc * 64 + c * 4;
      const float4 g4 = *(const float4*)(p.modv() + ((size_t)layer * 9 + r) * 6144 + gidx * 1024 + col0);
      float4 b4 = make_float4(0.f, 0.f, 0.f, 0.f);
      if (bias) b4 = *(const float4*)(bias + col0);
      float* hrow = p.h() + (size_t)(r0 + rsub) * 1024 + col0;
      const float* srow = sf + rsub * 64 + (c & 3) * 4;
#pragma unroll 1
      for (int it4 = 0; it4 < 4; ++it4) {
#pragma unroll
        for (int u = 0; u < 4; ++u) {
          const int grp = (c >> 2) ^ u;
          const float4 a4 = *(const float4*)(srow + u * 256 + grp * 16);
          float4* hp = (float4*)(hrow + u * 4096);
          float4 hv = *hp;
          hv.x += g4.x * (a4.x + b4.x); hv.y += g4.y * (a4.y + b4.y); hv.z += g4.z * (a4.z + b4.z); hv.w += g4.w * (a4.w + b4.w);
          *hp = hv;
        }
        hrow += 16 * 1024;
        srow += 16 * 64;
      }
    }
    __syncthreads();
  } else {
    const int region = nt >> 3, hd = nt & 7;
    const bool lat = brow < TL;
    const int b = lat ? brow / SEQ : (brow - TL) / CTX;
    const int kb = lat ? 256 + (r0 - b * SEQ) : (r0 - TL - b * CTX);
    const size_t bh = (size_t)(b * 8 + hd);
    u16* qb = p.big(); u16* kbuf = p.big() + (size_t)T * 1024; u16* vt = p.big() + (size_t)T * 2048;
    if (region < 2) {
      u16* dst = (region == 0 ? qb : kbuf) + ((bh * 2 + wc) * KEYS + kb) * 64;
      const float qs = region == 0 ? 0.125f * 1.44269504088896f : 1.f;
#pragma unroll
      for (int mi = 0; mi < 4; ++mi)
#pragma unroll
        for (int j = 0; j < 4; ++j) {
          int rl = mi * 16 + fq * 4 + j;
          float x0 = acc[mi][0][j], x1 = acc[mi][1][j], x2 = acc[mi][2][j], x3 = acc[mi][3][j];
          if (lat) {
            int t = kb - 256 + rl;
            float2 cr = p.rope()[(t >> 6) * 16 + fr], cc = p.rope()[(t & 63) * 16 + fr];
            float y0 = x0 * cr.x - x1 * cr.y, y1 = x1 * cr.x + x0 * cr.y;
            float y2 = x2 * cc.x - x3 * cc.y, y3 = x3 * cc.x + x2 * cc.y;
            x0 = y0; x1 = y1; x2 = y2; x3 = y3;
          }
          char* sp = stg + rl * 144 + fr * 2;
          *(u16*)(sp) = f2bf(x0 * qs); *(u16*)(sp + 32) = f2bf(x1 * qs); *(u16*)(sp + 64) = f2bf(x2 * qs); *(u16*)(sp + 96) = f2bf(x3 * qs);
          if (j == 3) asm volatile("" ::: "memory");
        }
      __syncthreads();
#pragma unroll
      for (int it = 0; it < 8; ++it) {
        const int row = it * 8 + (lane >> 3), ch = lane & 7;
        u32x4 val = *(const u32x4*)(stg + row * 144 + ch * 16);
        *(u32x4*)(dst + (size_t)row * 64 + ch * 8) = val;
      }
      __syncthreads();
    } else {
#pragma unroll
      for (int ni = 0; ni < 4; ++ni) {
        const int e = ni * 16 + fr;
#pragma unroll
        for (int mi = 0; mi < 4; ++mi) {
          int slot = (mi >> 1) * 32 + fq * 8 + (mi & 1) * 4;
          *(uint2*)(stg + e * 144 + slot * 2) = make_uint2(pack2(acc[mi][ni][0], acc[mi][ni][1]), pack2(acc[mi][ni][2], acc[mi][ni][3]));
        }
      }
      __syncthreads();
      u16* dp = vt + (bh * 128 + wc * 64) * KEYS + kb;
#pragma unroll
      for (int it = 0; it < 8; ++it) {
        const int row = it * 8 + (lane >> 3), ch = lane & 7;
        u32x4 val = *(const u32x4*)(stg + row * 144 + ch * 16);
        *(u32x4*)(dp + (size_t)row * KEYS + ch * 8) = val;
      }
      __syncthreads();
    }
  }
  if constexpr (EPI == 1) { if (ti + 1 < ntile) { G_LOAD(0, 0) } }
  mt = mt2; nt = nt2;
  }
#undef GLD
#undef VMWAIT
#undef G_LOAD
#undef L_STORE
#undef MMA_TILE
#undef TILE_MN
}

__device__ void gemm_phase(const Params& p, const u16* A, const u16* Bt, int K, int Mt, int Nt, int epi, int layer, int gidx,
                           const float* bias, char* smem) {
  if (K != 1024) gemm_run<FH, 2>(p, A, Bt, Mt, Nt, layer, gidx, bias, smem);
  else if (epi == 0) gemm_run<1024, 0>(p, A, Bt, Mt, Nt, layer, gidx, bias, smem);
  else if (epi == 1) gemm_run<1024, 1>(p, A, Bt, Mt, Nt, layer, gidx, bias, smem);
  else if (epi == 2) gemm_run<1024, 2>(p, A, Bt, Mt, Nt, layer, gidx, bias, smem);
  else gemm_run<1024, 3>(p, A, Bt, Mt, Nt, layer, gidx, bias, smem);
}

__device__ void conv_phase(const Params& p, int j, int M, char* smem) {
  const int tid = otid(), wid = tid >> 6, lane = tid & 63;
  float* cbuf = (float*)smem;
  const u16* U = p.big();
  for (int item = blockIdx.x; item < M / 8; item += gridDim.x) {
    const int t0 = item * 8;
    int s0, s1;
    if (t0 < TL) { s0 = (t0 / SEQ) * SEQ; s1 = s0 + SEQ; } else { s0 = TL + ((t0 - TL) / CTX) * CTX; s1 = s0 + CTX; }
#pragma unroll 1
    for (int g = 0; g < 2; ++g) {
      const int c = g * 512 + tid * 2;
      float acc[8][2];
      float w[31][2];
#pragma unroll
      for (int k = 0; k < 31; ++k) { float2 wv = *(const float2*)(p.dw_w() + ((size_t)j * 31 + k) * 1024 + c); w[k][0] = wv.x; w[k][1] = wv.y; }
      float2 bv = *(const float2*)(p.dw_b() + j * 1024 + c);
#pragma unroll
      for (int o = 0; o < 8; ++o) { acc[o][0] = bv.x; acc[o][1] = bv.y; }
#pragma unroll
      for (int ti = 0; ti < 38; ++ti) {
        int tin = t0 - 15 + ti;
        bool valid = tin >= s0 && tin < s1;
        int tc = min(max(tin, s0), s1 - 1);
        unsigned raw = *(const unsigned*)(U + (size_t)tc * 1024 + c);
        if (!valid) raw = 0u;
        float x0 = bf2f(raw & 0xffffu), x1 = bf2f(raw >> 16);
#pragma unroll
        for (int o = 0; o < 8; ++o) {
          const int k = ti - o;
          if (k >= 0 && k < 31) { acc[o][0] += x0 * w[k][0]; acc[o][1] += x1 * w[k][1]; }
        }
      }
#pragma unroll
      for (int o = 0; o < 8; ++o) *(float2*)(cbuf + o * 1024 + c) = make_float2(acc[o][0], acc[o][1]);
    }
    __syncthreads();
#pragma unroll
    for (int tt = 0; tt < 2; ++tt) {
      const int o = wid * 2 + tt;
      float4 v[4];
      float sm = 0.f;
#pragma unroll
      for (int i = 0; i < 4; ++i) { v[i] = *(const float4*)(cbuf + o * 1024 + (lane + 64 * i) * 4); sm += v[i].x + v[i].y + v[i].z + v[i].w; }
#pragma unroll
      for (int sh = 32; sh >= 1; sh >>= 1) sm += __shfl_xor(sm, sh);
      const float mean = sm * (1.f / 1024.f);
      float sq = 0.f;
#pragma unroll
      for (int i = 0; i < 4; ++i) {
        v[i].x -= mean; v[i].y -= mean; v[i].z -= mean; v[i].w -= mean;
        sq += v[i].x * v[i].x + v[i].y * v[i].y + v[i].z * v[i].z + v[i].w * v[i].w;
      }
#pragma unroll
      for (int sh = 32; sh >= 1; sh >>= 1) sq += __shfl_xor(sq, sh);
      const float rstd = rsqrtf(sq * (1.f / 1024.f) + EPS);
      uint2* op = (uint2*)(p.vbuf() + (size_t)(t0 + o) * 1024);
#pragma unroll
      for (int i = 0; i < 4; ++i) {
        int c4 = lane + 64 * i;
        float4 lg = ((const float4*)(p.ln_g() + j * 1024))[c4], lb = ((const float4*)(p.ln_b() + j * 1024))[c4];
        float y0 = v[i].x * rstd * lg.x + lb.x, y1 = v[i].y * rstd * lg.y + lb.y;
        float y2 = v[i].z * rstd * lg.z + lb.z, y3 = v[i].w * rstd * lg.w + lb.w;
        y0 *= sigmoidf_(y0); y1 *= sigmoidf_(y1); y2 *= sigmoidf_(y2); y3 *= sigmoidf_(y3);
        op[c4] = make_uint2(pack2(y0, y1), pack2(y2, y3));
      }
    }
    __syncthreads();
  }
}

__device__ void attn_item(const Params& p, int b, int hd, int q0, int nkeys, int out_row0, float lam, float oscale,
                          const float* __restrict__ subg, char* smem) {
  const int tid = otid(), wid = tid >> 6, lane = tid & 63, fr = lane & 15, fq = lane >> 4;
  const int comp = wid & 1, qg = wid >> 1;
  const size_t bh = (size_t)(b * 8 + hd);
  const u16* qb = p.big(); const u16* kbuf = p.big() + (size_t)T * 1024; const u16* vtb = p.big() + (size_t)T * 2048;
  const u16* Qp = qb + ((bh * 2 + comp) * KEYS + q0 + qg * 32) * 64;
  bf16x8 qf[2][2];
#pragma unroll
  for (int qs = 0; qs < 2; ++qs)
#pragma unroll
    for (int ks = 0; ks < 2; ++ks) qf[qs][ks] = *(const bf16x8*)(Qp + (qs * 16 + fr) * 64 + ks * 32 + fq * 8);
  const u16* K1p = kbuf + (bh * 2 + 0) * KEYS * 64;
  const u16* K2p = kbuf + (bh * 2 + 1) * KEYS * 64;
  const u16* Vp = vtb + bh * 128 * KEYS;
  const int lrow = tid >> 3, lc = tid & 7;
  u32x4 rg0, rg1, rg2, rg3, rg4, rg5, rg6, rg7;
#define ATT_GLOAD(kt_)                                                                         \
  {                                                                                            \
    const int key0 = (kt_) * 64;                                                               \
    rg0 = *(const u32x4*)(K1p + (size_t)(key0 + lrow) * 64 + lc * 8);                          \
    rg1 = *(const u32x4*)(K1p + (size_t)(key0 + lrow + 32) * 64 + lc * 8);                     \
    rg2 = *(const u32x4*)(K2p + (size_t)(key0 + lrow) * 64 + lc * 8);                          \
    rg3 = *(const u32x4*)(K2p + (size_t)(key0 + lrow + 32) * 64 + lc * 8);                     \
    rg4 = *(const u32x4*)(Vp + (size_t)(lrow) * KEYS + key0 + lc * 8);                         \
    rg5 = *(const u32x4*)(Vp + (size_t)(lrow + 32) * KEYS + key0 + lc * 8);                    \
    rg6 = *(const u32x4*)(Vp + (size_t)(lrow + 64) * KEYS + key0 + lc * 8);                    \
    rg7 = *(const u32x4*)(Vp + (size_t)(lrow + 96) * KEYS + key0 + lc * 8);                    \
  }
#define ATT_LSTORE(buf_)                                                                       \
  {                                                                                            \
    char* bs_ = smem + (buf_) * 32768 + tile_off(lrow, lc);                                    \
    *(u32x4*)(bs_) = rg0;                                                                      \
    *(u32x4*)(bs_ + 4096) = rg1;                                                               \
    *(u32x4*)(bs_ + 8192) = rg2;                                                               \
    *(u32x4*)(bs_ + 8192 + 4096) = rg3;                                                        \
    *(u32x4*)(bs_ + 16384) = rg4;                                                              \
    *(u32x4*)(bs_ + 16384 + 4096) = rg5;                                                       \
    *(u32x4*)(bs_ + 16384 + 8192) = rg6;                                                       \
    *(u32x4*)(bs_ + 16384 + 12288) = rg7;                                                      \
  }
  f32x4 O[8][2];
#pragma unroll
  for (int e = 0; e < 8; ++e) { O[e][0] = f32x4{0.f, 0.f, 0.f, 0.f}; O[e][1] = f32x4{0.f, 0.f, 0.f, 0.f}; }
  float m[2] = {-1e30f, -1e30f}, l[2] = {0.f, 0.f};
  const int ntile = nkeys >> 6;
  ATT_GLOAD(0);
  ATT_LSTORE(0);
  __syncthreads();
  for (int kt = 0; kt < ntile; ++kt) {
    const int cur = kt & 1;
    if (kt + 1 < ntile) ATT_GLOAD(kt + 1);
    const char* base = smem + cur * 32768;
    const char* Kc = base + comp * 8192;
    const char* Vt = base + 16384;
    f32x4 S[4][2];
#pragma unroll
    for (int i = 0; i < 4; ++i) { S[i][0] = f32x4{0.f, 0.f, 0.f, 0.f}; S[i][1] = f32x4{0.f, 0.f, 0.f, 0.f}; }
    __builtin_amdgcn_s_setprio(1);
#pragma unroll
    for (int ks = 0; ks < 2; ++ks)
#pragma unroll
      for (int ksub = 0; ksub < 4; ++ksub) {
        bf16x8 kf = *(const bf16x8*)(Kc + tile_off(ksub * 16 + fr, ks * 4 + fq));
#pragma unroll
        for (int qs = 0; qs < 2; ++qs) S[ksub][qs] = __builtin_amdgcn_mfma_f32_16x16x32_bf16(kf, qf[qs][ks], S[ksub][qs], 0, 0, 0);
      }
    __builtin_amdgcn_s_setprio(0);
#pragma unroll
    for (int qs = 0; qs < 2; ++qs) {
      float mx = -1e30f;
#pragma unroll
      for (int ksub = 0; ksub < 4; ++ksub)
#pragma unroll
        for (int j = 0; j < 4; ++j) mx = fmaxf(mx, S[ksub][qs][j]);
      mx = fmaxf(mx, __shfl_xor(mx, 16));
      mx = fmaxf(mx, __shfl_xor(mx, 32));
      float mn = fmaxf(m[qs], mx);
      float alpha = fexp2(m[qs] - mn);
      m[qs] = mn;
      float rs = 0.f;
#pragma unroll
      for (int ksub = 0; ksub < 4; ++ksub)
#pragma unroll
        for (int j = 0; j < 4; ++j) { float pv = fexp2(S[ksub][qs][j] - mn); S[ksub][qs][j] = pv; rs += pv; }
      l[qs] = l[qs] * alpha + rs;
      if (__builtin_amdgcn_ballot_w64(alpha != 1.f) != 0) {
#pragma unroll
        for (int e = 0; e < 8; ++e) O[e][qs] *= alpha;
      }
    }
    bf16x8 pf[2][2];
#pragma unroll
    for (int qs = 0; qs < 2; ++qs)
#pragma unroll
      for (int s = 0; s < 2; ++s) {
        unsigned u0 = pack2(S[2 * s][qs][0], S[2 * s][qs][1]), u1 = pack2(S[2 * s][qs][2], S[2 * s][qs][3]);
        unsigned u2 = pack2(S[2 * s + 1][qs][0], S[2 * s + 1][qs][1]), u3 = pack2(S[2 * s + 1][qs][2], S[2 * s + 1][qs][3]);
        uint4 uu = make_uint4(u0, u1, u2, u3);
        pf[qs][s] = *(bf16x8*)&uu;
      }
    __builtin_amdgcn_s_setprio(1);
#pragma unroll
    for (int s = 0; s < 2; ++s)
#pragma unroll
      for (int e = 0; e < 8; ++e) {
        bf16x8 vf = *(const bf16x8*)(Vt + tile_off(e * 16 + fr, s * 4 + fq));
#pragma unroll
        for (int qs = 0; qs < 2; ++qs) O[e][qs] = __builtin_amdgcn_mfma_f32_16x16x32_bf16(vf, pf[qs][s], O[e][qs], 0, 0, 0);
      }
    __builtin_amdgcn_s_setprio(0);
    if (kt + 1 < ntile) ATT_LSTORE(cur ^ 1);
    __syncthreads();
  }
#undef ATT_GLOAD
#undef ATT_LSTORE
#pragma unroll
  for (int qs = 0; qs < 2; ++qs) {
    float ls = l[qs];
    ls += __shfl_xor(ls, 16);
    ls += __shfl_xor(ls, 32);
    float inv = (comp ? lam : 1.f) / ls;
#pragma unroll
    for (int e = 0; e < 8; ++e) O[e][qs] *= inv;
  }
  float* ex = (float*)smem;
  if (comp == 1) {
#pragma unroll
    for (int e = 0; e < 8; ++e)
#pragma unroll
      for (int qs = 0; qs < 2; ++qs) *(f32x4*)(ex + ((((qg * 8 + e) * 2 + qs) * 64 + lane) << 2)) = O[e][qs];
  }
  __syncthreads();
  if (comp == 0) {
#pragma unroll
    for (int qs = 0; qs < 2; ++qs) {
      float ssq = 0.f;
#pragma unroll
      for (int e = 0; e < 8; ++e) {
        f32x4 o2 = *(const f32x4*)(ex + ((((qg * 8 + e) * 2 + qs) * 64 + lane) << 2));
        O[e][qs] -= o2;
#pragma unroll
        for (int j = 0; j < 4; ++j) ssq += O[e][qs][j] * O[e][qs][j];
      }
      ssq += __shfl_xor(ssq, 16);
      ssq += __shfl_xor(ssq, 32);
      float rstd = rsqrtf(ssq * (1.f / 128.f) + EPS) * oscale;
      u16* op = p.vbuf() + (size_t)(out_row0 + qg * 32 + qs * 16 + fr) * 1024 + hd * 128 + fq * 4;
#pragma unroll
      for (int e = 0; e < 8; ++e) {
        float4 sg = *(const float4*)(subg + e * 16 + fq * 4);
        *(uint2*)(op + e * 16) = make_uint2(pack2(O[e][qs][0] * rstd * sg.x, O[e][qs][1] * rstd * sg.y),
                                            pack2(O[e][qs][2] * rstd * sg.z, O[e][qs][3] * rstd * sg.w));
      }
    }
  }
  __syncthreads();
}

__device__ void attn_phase(const Params& p, int layer, bool with_ctx, char* smem) {
  const int ja = layer >> 1;
  const float* lv = p.lam() + ja * 256;
  float d01 = 0.f, d23 = 0.f;
  for (int i = 0; i < 64; ++i) { d01 += lv[i] * lv[64 + i]; d23 += lv[128 + i] * lv[192 + i]; }
  const float lam_init = 0.8f - 0.6f * expf(-0.3f * (float)layer);
  const float lam = expf(d01) - expf(d23) + lam_init;
  const float* subg = p.subln() + ja * 128;
  {
    const int xcd = blockIdx.x & 7, rank = blockIdx.x >> 3, rpx = gridDim.x >> 3;
    for (int r = 0; r < 4; ++r)
      for (int q = rank; q < 64; q += rpx) {
        const int bh = r * 16 + xcd * 2 + (q >> 5), qt = q & 31;
        const int b = bh >> 3, hd = bh & 7;
        attn_item(p, b, hd, 256 + qt * 64, KEYS, b * SEQ + qt * 64, lam, 1.f - lam_init, subg, smem);
      }
  }
  if (with_ctx) {
    for (int it = blockIdx.x; it < 256; it += gridDim.x) {
      const int qt = it & 3, hd = (it >> 2) & 7, b = it >> 5;
      attn_item(p, b, hd, qt * 64, CTX, TL + b * CTX + qt * 64, lam, 1.f - lam_init, subg, smem);
    }
  }
}

__device__ void run_phase(const Params& p, int ph_in, char* smem) {
  const int ph = ph_in & 0xffff; const bool noepi = (ph_in >> 16) != 0;
  if (ph == 0) { prologue_phase(p, smem); return; }
  if (ph == NPH - 1) { final_phase(p); return; }
  const int layer = (ph - 1) / 7, sub = (ph - 1) % 7;
  const bool last = layer == DEPTH - 1;
  const int M = last ? TL : T;
  const bool is_conv = (layer & 1) == 0;
  const int j = layer >> 1;
  if (sub == 0 || sub == 4) { norm_phase(p, layer, sub == 4 ? 1 : 0, sub == 0 ? T : M); return; }
  if (sub == 2) {
    if (is_conv) conv_phase(p, j, T, smem);
    else attn_phase(p, layer, !last, smem);
    return;
  }
  const u16 *A, *Bt; int K = 1024, Nt, epi, gidx = 0, mtiles = M / 128; const float* bias = nullptr;
  if (sub == 1) {
    A = p.nbuf(); mtiles = T / 128;
    if (is_conv) { Bt = p.w_pw1() + (size_t)j * 2048 * 1024; Nt = 16; epi = 0; bias = p.pw1_b() + j * 2048; }
    else { Bt = p.w_qkv() + (size_t)j * 3072 * 1024; Nt = 24; epi = 1; }
  } else if (sub == 3) {
    A = p.vbuf(); Nt = 8; epi = 2; gidx = 2;
    if (is_conv) { Bt = p.w_pw2() + (size_t)j * 1024 * 1024; bias = p.pw2_b() + j * 1024; }
    else Bt = p.w_o() + (size_t)j * 1024 * 1024;
  } else if (sub == 5) {
    A = p.nbuf(); Bt = p.w_fin() + (size_t)layer * 5632 * 1024; Nt = 44; epi = 3;
  } else {
    A = p.big(); Bt = p.w_fout() + (size_t)layer * 1024 * FH; K = FH; Nt = 8; epi = 2; gidx = 5;
  }
  gemm_phase(p, A, Bt, K, mtiles, Nt, epi, layer, gidx, bias, smem);
}

__device__ __forceinline__ unsigned xcc_id() { return (unsigned)__builtin_amdgcn_s_getreg((3 << 11) | 20) & 0xFu; }
__device__ __forceinline__ void grid_barrier(unsigned* bar, unsigned xcc, unsigned k, unsigned nloc, unsigned nx) {
  __syncthreads();
  if (threadIdx.x == 0) {
    unsigned a = __hip_atomic_fetch_add(&bar[1024 + xcc * 64], 1u, __ATOMIC_RELAXED, __HIP_MEMORY_SCOPE_AGENT) + 1u;
    if (a == k * nloc) {
      __builtin_amdgcn_fence(__ATOMIC_RELEASE, "agent");
      asm volatile("s_waitcnt vmcnt(0)" ::: "memory");
      __hip_atomic_fetch_add(&bar[2048], 1u, __ATOMIC_RELAXED, __HIP_MEMORY_SCOPE_AGENT);
    }
    while (__hip_atomic_load(&bar[2048], __ATOMIC_RELAXED, __HIP_MEMORY_SCOPE_AGENT) < k * nx) __builtin_amdgcn_s_sleep(2);
    __builtin_amdgcn_fence(__ATOMIC_ACQUIRE, "agent");
    asm volatile("s_waitcnt vmcnt(0)" ::: "memory");
  }
  __syncthreads();
}

__global__ void __launch_bounds__(256, 2) mega(Params p, int ph_begin, int ph_end, int use_sync) {
  __shared__ __attribute__((aligned(16))) char smem[65536];
  __shared__ unsigned s_cnt[2];
  cg::grid_group grid = cg::this_grid();
  unsigned* bar = (unsigned*)(p.ws + WS_NEED);
  const unsigned xcc = xcc_id();
  if (use_sync && threadIdx.x == 0) __hip_atomic_fetch_add(&bar[xcc * 64], 1u, __ATOMIC_RELAXED, __HIP_MEMORY_SCOPE_AGENT);
  unsigned k = 0, nloc = 1, nx = 1;
  for (int ph = ph_begin; ph < ph_end; ++ph) {
    run_phase(p, ph, smem);
#ifdef DUP_MASK
    if (ph > ph_begin) {
      const int sub = (ph >= 1 && ph < NPH - 1) ? (ph - 1) % 7 : -1, layer = (ph - 1) / 7;
      bool dup = false;
      if ((DUP_MASK & 1) && sub == 2 && (layer & 1)) dup = true;
      if ((DUP_MASK & 2) && (sub == 1 || sub == 5)) dup = true;
      if ((DUP_MASK & 4) && sub == 2 && !(layer & 1)) dup = true;
      if ((DUP_MASK & 8) && (sub == 0 || sub == 4)) dup = true;
      if (dup) { ++k; grid_barrier(bar, xcc, k, nloc, nx); run_phase(p, ph | DUP_FLAG, smem); }
    }
#endif
    if (use_sync && ph + 1 < ph_end) {
      if (ph == ph_begin) {
        grid.sync();
        if (threadIdx.x == 0) {
          unsigned cnt = 0;
          for (int j = 0; j < 16; ++j) cnt += __hip_atomic_load(&bar[j * 64], __ATOMIC_RELAXED, __HIP_MEMORY_SCOPE_AGENT) ? 1u : 0u;
          s_cnt[0] = __hip_atomic_load(&bar[xcc * 64], __ATOMIC_RELAXED, __HIP_MEMORY_SCOPE_AGENT);
          s_cnt[1] = cnt;
        }
        __syncthreads();
        nloc = __builtin_amdgcn_readfirstlane(s_cnt[0]); nx = __builtin_amdgcn_readfirstlane(s_cnt[1]);
      } else {
        ++k;
        grid_barrier(bar, xcc, k, nloc, nx);
      }
    }
  }
}

extern "C" void kernel_launch(void* const* d_in, const int* in_sizes, int n_in, void* d_out, int out_size, void* d_ws,
                              size_t ws_size, hipStream_t stream) {
  Params p{};
  for (int i = 0; i < 22; ++i) p.in[i] = (const float*)d_in[i];
  p.outp = (float*)d_out;
  p.ws = (char*)d_ws;
  if (WS_NEED + 16384 > ws_size || n_in < 22) return;
  static int grid_blocks = 0;
  if (!grid_blocks) {
    int dev = 0, cus = 0, per_cu = 0;
    hipGetDevice(&dev);
    hipDeviceGetAttribute(&cus, hipDeviceAttributeMultiprocessorCount, dev);
    hipOccupancyMaxActiveBlocksPerMultiprocessor(&per_cu, mega, 256, 0);
    if (per_cu > 2) per_cu = 2;
    if (per_cu < 1) per_cu = 1;
    grid_blocks = cus * per_cu;
  }
#if MULTI_LAUNCH
  for (int ph = 0; ph < NPH; ++ph) mega<<<grid_blocks, 256, 0, stream>>>(p, ph, ph + 1, 0);
#else
  hipMemsetAsync((char*)d_ws + WS_NEED, 0, 16384, stream);
  int b = 0, e = NPH, s = 1;
  void* args[] = {&p, &b, &e, &s};
  hipError_t err = hipLaunchCooperativeKernel((void*)mega, dim3(grid_blocks), dim3(256), args, 0, stream);
  if (err != hipSuccess) fprintf(stderr, "cooperative launch failed: %s (grid %d)\n", hipGetErrorString(err), grid_blocks);
#endif
}
```

```cpp
#include <hip/hip_runtime.h>
#include <hip/hip_cooperative_groups.h>
#include <cstdio>
namespace cg = cooperative_groups;

#ifndef DUP_FLAG
#define DUP_FLAG 0
#endif
#ifndef MULTI_LAUNCH
#define MULTI_LAUNCH 0
#endif

typedef unsigned short u16;
using bf16x8 = __attribute__((ext_vector_type(8))) short;
using f32x4 = __attribute__((ext_vector_type(4))) float;
using u32x4 = __attribute__((ext_vector_type(4))) unsigned;

constexpr int D = 1024, NB = 8, SEQ = 2048, CTX = 256, DEPTH = 4;
constexpr int TL = NB * SEQ;
constexpr int TCX = NB * CTX;
constexpr int T = TL + TCX;
constexpr int FH = 2816;
constexpr int KEYS = CTX + SEQ;
constexpr int NPH = 2 + 7 * DEPTH;
constexpr float EPS = 1e-6f;

constexpr size_t al256(size_t x) { return (x + 255) & ~(size_t)255; }
constexpr size_t OFF_WPW1 = 0;
constexpr size_t OFF_WPW2 = OFF_WPW1 + al256((size_t)2 * 2048 * 1024 * 2);
constexpr size_t OFF_WQKV = OFF_WPW2 + al256((size_t)2 * 1024 * 1024 * 2);
constexpr size_t OFF_WO = OFF_WQKV + al256((size_t)2 * 3072 * 1024 * 2);
constexpr size_t OFF_WFIN = OFF_WO + al256((size_t)2 * 1024 * 1024 * 2);
constexpr size_t OFF_WFOUT = OFF_WFIN + al256((size_t)4 * 5632 * 1024 * 2);
constexpr size_t OFF_H = OFF_WFOUT + al256((size_t)4 * 1024 * FH * 2);
constexpr size_t OFF_NBUF = OFF_H + al256((size_t)T * 1024 * 4);
constexpr size_t OFF_BIG = OFF_NBUF + al256((size_t)T * 1024 * 2);
constexpr size_t OFF_VBUF = OFF_BIG + al256((size_t)T * 3072 * 2);
constexpr size_t OFF_MODV = OFF_VBUF + al256((size_t)T * 1024 * 2);
constexpr size_t OFF_ROPE = OFF_MODV + al256((size_t)4 * 9 * 6144 * 4);
constexpr size_t WS_NEED = OFF_ROPE + al256((size_t)1024 * 8);

struct Params {
  const float* in[22];
  float* outp;
  char* ws;
  __device__ __forceinline__ const float* x() const { return in[0]; }
  __device__ __forceinline__ const float* c() const { return in[1]; }
  __device__ __forceinline__ const float* ctx() const { return in[2]; }
  __device__ __forceinline__ const float* c_ctx() const { return in[3]; }
  __device__ __forceinline__ const float* mod_w() const { return in[4]; }
  __device__ __forceinline__ const float* mod_b() const { return in[5]; }
  __device__ __forceinline__ const float* norm_g() const { return in[6]; }
  __device__ __forceinline__ const float* pw1_w() const { return in[7]; }
  __device__ __forceinline__ const float* pw1_b() const { return in[8]; }
  __device__ __forceinline__ const float* dw_w() const { return in[9]; }
  __device__ __forceinline__ const float* dw_b() const { return in[10]; }
  __device__ __forceinline__ const float* ln_g() const { return in[11]; }
  __device__ __forceinline__ const float* ln_b() const { return in[12]; }
  __device__ __forceinline__ const float* pw2_w() const { return in[13]; }
  __device__ __forceinline__ const float* pw2_b() const { return in[14]; }
  __device__ __forceinline__ const float* wqkv() const { return in[15]; }
  __device__ __forceinline__ const float* lam() const { return in[16]; }
  __device__ __forceinline__ const float* subln() const { return in[17]; }
  __device__ __forceinline__ const float* wo() const { return in[18]; }
  __device__ __forceinline__ const float* ffn_in() const { return in[19]; }
  __device__ __forceinline__ const float* ffn_out() const { return in[20]; }
  __device__ __forceinline__ const float* final_g() const { return in[21]; }
  __device__ __forceinline__ float* out() const { return outp; }
  __device__ __forceinline__ u16* w_pw1() const { return (u16*)(ws + OFF_WPW1); }
  __device__ __forceinline__ u16* w_pw2() const { return (u16*)(ws + OFF_WPW2); }
  __device__ __forceinline__ u16* w_qkv() const { return (u16*)(ws + OFF_WQKV); }
  __device__ __forceinline__ u16* w_o() const { return (u16*)(ws + OFF_WO); }
  __device__ __forceinline__ u16* w_fin() const { return (u16*)(ws + OFF_WFIN); }
  __device__ __forceinline__ u16* w_fout() const { return (u16*)(ws + OFF_WFOUT); }
  __device__ __forceinline__ float* h() const { return (float*)(ws + OFF_H); }
  __device__ __forceinline__ u16* nbuf() const { return (u16*)(ws + OFF_NBUF); }
  __device__ __forceinline__ u16* big() const { return (u16*)(ws + OFF_BIG); }
  __device__ __forceinline__ u16* vbuf() const { return (u16*)(ws + OFF_VBUF); }
  __device__ __forceinline__ float* modv() const { return (float*)(ws + OFF_MODV); }
  __device__ __forceinline__ float2* rope() const { return (float2*)(ws + OFF_ROPE); }
};

typedef __bf16 bf2v __attribute__((ext_vector_type(2)));
typedef float f2v __attribute__((ext_vector_type(2)));
__device__ __forceinline__ unsigned pack2(float a, float b) {
  f2v v = {a, b};
  bf2v r = __builtin_convertvector(v, bf2v);
  return *(unsigned*)&r;
}
__device__ __forceinline__ u16 f2bf(float f) { return (u16)(pack2(f, 0.f) & 0xffffu); }
__device__ __forceinline__ float bf2f(unsigned v) { return __uint_as_float(v << 16); }
__device__ __forceinline__ int tile_off(int row, int chunk) { return row * 128 + (((chunk ^ row) & 7) << 4); }
__device__ __forceinline__ float fexp2(float x) { return __builtin_amdgcn_exp2f(x); }
__device__ __forceinline__ float sigmoidf_(float x) { return __builtin_amdgcn_rcpf(1.f + __expf(-x)); }

__device__ __forceinline__ int otid() { int t = threadIdx.x; asm volatile("" : "+v"(t)); return t; }

struct WDesc { const float* sp; u16* dp; int N, K; };
__device__ __forceinline__ WDesc wconv_decode(const Params& p, int item, int tid) {
  int K, N, half = 0, tpl, ntN, base;
  const float* src; u16* dst;
  if (item < 1024)      { base = 0;    K = 1024; N = 2048; half = 1024; tpl = 512;  ntN = 32; src = p.pw1_w();  dst = p.w_pw1(); }
  else if (item < 1536) { base = 1024; K = 1024; N = 1024;              tpl = 256;  ntN = 16; src = p.pw2_w();  dst = p.w_pw2(); }
  else if (item < 3072) { base = 1536; K = 1024; N = 3072;              tpl = 768;  ntN = 48; src = p.wqkv();   dst = p.w_qkv(); }
  else if (item < 3584) { base = 3072; K = 1024; N = 1024;              tpl = 256;  ntN = 16; src = p.wo();     dst = p.w_o(); }
  else if (item < 9216) { base = 3584; K = 1024; N = 5632; half = 2816; tpl = 1408; ntN = 88; src = p.ffn_in(); dst = p.w_fin(); }
  else                  { base = 9216; K = 2816; N = 1024;              tpl = 704;  ntN = 16; src = p.ffn_out(); dst = p.w_fout(); }
  const int it = item - base;
  const int l = it / tpl, rem = it % tpl, kt = rem / ntN, nt = rem % ntN;
  src += (size_t)l * K * N; dst += (size_t)l * K * N;
  const int nl = tid & 63, kk0 = tid >> 6;
  const int np = nt * 64 + nl;
  int sc = np;
  if (half) { int blk = np >> 5, w = np & 31; sc = blk * 16 + (w & 15) + ((w >> 4) ? half : 0); }
  WDesc d;
  d.sp = src + (size_t)(kt * 64 + kk0) * N + sc;
  d.dp = dst + (size_t)(nt * 64 + (tid >> 2)) * K + kt * 64 + (tid & 3) * 16;
  d.N = N; d.K = K;
  return d;
}

__device__ void wconv_loop(const Params& p, char* smem) {
  float* tl = (float*)smem;
  const int tid = otid();
  const int nl = tid & 63, kk0 = tid >> 6, nl2 = tid >> 2, kq = tid & 3;
  int item = blockIdx.x;
  if (item >= 12032) return;
  float v[16];
  WDesc d = wconv_decode(p, item, tid);
#pragma unroll
  for (int i = 0; i < 16; ++i) v[i] = d.sp[(size_t)(4 * i) * d.N];
  for (; item < 12032; item += gridDim.x) {
#pragma unroll
    for (int i = 0; i < 16; ++i) tl[(kk0 + 4 * i) * 65 + nl] = v[i];
    u16* dp = d.dp;
    const int nxt = item + gridDim.x;
    if (nxt < 12032) {
      d = wconv_decode(p, nxt, tid);
#pragma unroll
      for (int i = 0; i < 16; ++i) v[i] = d.sp[(size_t)(4 * i) * d.N];
    }
    __syncthreads();
    unsigned pk[8];
#pragma unroll
    for (int e = 0; e < 8; ++e) pk[e] = pack2(tl[(kq * 16 + 2 * e) * 65 + nl2], tl[(kq * 16 + 2 * e + 1) * 65 + nl2]);
    ((uint4*)dp)[0] = make_uint4(pk[0], pk[1], pk[2], pk[3]);
    ((uint4*)dp)[1] = make_uint4(pk[4], pk[5], pk[6], pk[7]);
    __syncthreads();
  }
}

__device__ void prologue_phase(const Params& p, char* smem) {
  const int tid = otid(), wid = tid >> 6, lane = tid & 63;
  if (blockIdx.x < 384) {
    float* s = (float*)smem;
    float* red = (float*)(smem + 36864);
    for (int idx = tid; idx < 9 * 1024; idx += 256) {
      int r = idx >> 10, k = idx & 1023;
      float cv = r < 8 ? p.c()[r * 1024 + k] : p.c_ctx()[k];
      s[idx] = cv * sigmoidf_(cv);
    }
    __syncthreads();
    for (int item = blockIdx.x; item < 384; item += gridDim.x) {
      int i = item / 96, cgp = item % 96;
      float a[9];
#pragma unroll
      for (int r = 0; r < 9; ++r) a[r] = 0.f;
      const float* wp = p.mod_w() + ((size_t)i * 1024 + wid * 256) * 6144 + cgp * 64 + lane;
#pragma unroll 4
      for (int k4 = 0; k4 < 256; k4 += 4) {
        float w0 = wp[(size_t)(k4 + 0) * 6144], w1 = wp[(size_t)(k4 + 1) * 6144];
        float w2 = wp[(size_t)(k4 + 2) * 6144], w3 = wp[(size_t)(k4 + 3) * 6144];
#pragma unroll
        for (int r = 0; r < 9; ++r) {
          float4 sv = *(const float4*)&s[r * 1024 + wid * 256 + k4];
          a[r] += sv.x * w0 + sv.y * w1 + sv.z * w2 + sv.w * w3;
        }
      }
#pragma unroll
      for (int r = 0; r < 9; ++r) red[(wid * 9 + r) * 64 + lane] = a[r];
      __syncthreads();
      for (int idx = tid; idx < 9 * 64; idx += 256) {
        int r = idx >> 6, l = idx & 63;
        float v = red[(0 * 9 + r) * 64 + l] + red[(1 * 9 + r) * 64 + l] + red[(2 * 9 + r) * 64 + l] + red[(3 * 9 + r) * 64 + l];
        v += p.mod_b()[i * 6144 + cgp * 64 + l];
        p.modv()[((size_t)i * 9 + r) * 6144 + cgp * 64 + l] = v;
      }
      __syncthreads();
    }
  }
  if (blockIdx.x == gridDim.x - 1) {
    for (int idx = tid; idx < 1024; idx += 256) {
      int pos = idx >> 4, f = idx & 15;
      float inv = powf(10000.f, -(float)f / 16.f);
      float ang = (float)pos * inv;
      p.rope()[idx] = make_float2(cosf(ang), sinf(ang));
    }
  }
  wconv_loop(p, smem);
  {
    const float4* x4 = (const float4*)p.x(); const float4* c4 = (const float4*)p.ctx(); float4* h4 = (float4*)p.h();
    for (int idx = blockIdx.x * 256 + tid; idx < T * 256; idx += gridDim.x * 256)
      h4[idx] = idx < TL * 256 ? x4[idx] : c4[idx - TL * 256];
  }
}

__device__ void norm_phase(const Params& p, int layer, int which, int M) {
  const int tid = otid(), wid = tid >> 6, lane = tid & 63;
  const float* g = p.norm_g() + (layer * 2 + which) * 1024;
  const int stride = gridDim.x * 4;
  for (int row = blockIdx.x * 4 + wid; row < M; row += 2 * stride) {
    const int rowB = row + stride;
    const bool hasB = rowB < M;
    const int rB = hasB ? rowB : row;
    const float4* hpA = (const float4*)(p.h() + (size_t)row * 1024);
    const float4* hpB = (const float4*)(p.h() + (size_t)rB * 1024);
    float4 va[4], vb[4];
#pragma unroll
    for (int i = 0; i < 4; ++i) { va[i] = hpA[lane + 64 * i]; vb[i] = hpB[lane + 64 * i]; }
    float sa = 0.f, sb = 0.f;
#pragma unroll
    for (int i = 0; i < 4; ++i) {
      sa += va[i].x * va[i].x + va[i].y * va[i].y + va[i].z * va[i].z + va[i].w * va[i].w;
      sb += vb[i].x * vb[i].x + vb[i].y * vb[i].y + vb[i].z * vb[i].z + vb[i].w * vb[i].w;
    }
#pragma unroll
    for (int o = 32; o >= 1; o >>= 1) { sa += __shfl_xor(sa, o); sb += __shfl_xor(sb, o); }
    const float rstdA = rsqrtf(sa * (1.f / 1024.f) + EPS), rstdB = rsqrtf(sb * (1.f / 1024.f) + EPS);
    const int ra = row < TL ? row / SEQ : 8, rb = rB < TL ? rB / SEQ : 8;
    const float* mva = p.modv() + ((size_t)layer * 9 + ra) * 6144;
    const float* mvb = p.modv() + ((size_t)layer * 9 + rb) * 6144;
    const int so = (which ? 3 : 0) * 1024, co = (which ? 4 : 1) * 1024;
    uint2* opA = (uint2*)(p.nbuf() + (size_t)row * 1024);
    uint2* opB = (uint2*)(p.nbuf() + (size_t)rB * 1024);
#pragma unroll
    for (int i = 0; i < 4; ++i) {
      const int c4 = lane + 64 * i;
      const float4 gg = ((const float4*)g)[c4];
      {
        const float4 s4 = ((const float4*)(mva + co))[c4], h4 = ((const float4*)(mva + so))[c4];
        float y0 = va[i].x * rstdA * gg.x * (1.f + s4.x) + h4.x, y1 = va[i].y * rstdA * gg.y * (1.f + s4.y) + h4.y;
        float y2 = va[i].z * rstdA * gg.z * (1.f + s4.z) + h4.z, y3 = va[i].w * rstdA * gg.w * (1.f + s4.w) + h4.w;
        opA[c4] = make_uint2(pack2(y0, y1), pack2(y2, y3));
      }
      if (hasB) {
        const float4 s4 = ((const float4*)(mvb + co))[c4], h4 = ((const float4*)(mvb + so))[c4];
        float y0 = vb[i].x * rstdB * gg.x * (1.f + s4.x) + h4.x, y1 = vb[i].y * rstdB * gg.y * (1.f + s4.y) + h4.y;
        float y2 = vb[i].z * rstdB * gg.z * (1.f + s4.z) + h4.z, y3 = vb[i].w * rstdB * gg.w * (1.f + s4.w) + h4.w;
        opB[c4] = make_uint2(pack2(y0, y1), pack2(y2, y3));
      }
    }
  }
}

__device__ void final_phase(const Params& p) {
  const int tid = otid(), wid = tid >> 6, lane = tid & 63;
  for (int row = blockIdx.x * 4 + wid; row < TL; row += gridDim.x * 4) {
    const float4* hp = (const float4*)(p.h() + (size_t)row * 1024);
    float4 v[4];
    float ss = 0.f;
#pragma unroll
    for (int i = 0; i < 4; ++i) { v[i] = hp[lane + 64 * i]; ss += v[i].x * v[i].x + v[i].y * v[i].y + v[i].z * v[i].z + v[i].w * v[i].w; }
#pragma unroll
    for (int o = 32; o >= 1; o >>= 1) ss += __shfl_xor(ss, o);
    float rstd = rsqrtf(ss * (1.f / 1024.f) + EPS);
    float4* op = (float4*)(p.out() + (size_t)row * 1024);
#pragma unroll
    for (int i = 0; i < 4; ++i) {
      int c4 = lane + 64 * i;
      float4 gg = ((const float4*)p.final_g())[c4];
      float4 ov = make_float4(v[i].x * rstd * gg.x, v[i].y * rstd * gg.y, v[i].z * rstd * gg.z, v[i].w * rstd * gg.w);
      op[c4] = ov;
    }
  }
}

template <int K, int EPI>
__device__ __forceinline__ void gemm_run(const Params& p, const u16* __restrict__ A, const u16* __restrict__ Bt,
                          int Mt, int Nt, int layer, int gidx, const float* __restrict__ bias, char* smem) {
  const int tid = otid(), wid = tid >> 6, lane = tid & 63, wr = wid >> 1, wc = wid & 1, fr = lane & 15, fq = lane >> 4;
  const int xcd = blockIdx.x & 7, rank = blockIdx.x >> 3, rpx = gridDim.x >> 3;
  const int SN = (Nt & 7) == 0 ? 8 : 4, SM = 64 / SN;
  const int nsn = Nt / SN, total_s = (Mt / SM) * nsn;
  const int cq = rank < 64 ? (64 - rank + rpx - 1) / rpx : 0;
  const int nsx = xcd < total_s ? (total_s - xcd + 7) / 8 : 0;
  const int ntile = cq * nsx;
  if (ntile == 0) return;
#define TILE_MN(i_, mt_, nt_)                                              \
  {                                                                        \
    const int si_ = (i_) / cq, qi_ = (i_) - si_ * cq;                      \
    const int sidx_ = xcd + 8 * si_, q_ = rank + rpx * qi_;                \
    const int ms_ = sidx_ / nsn, ns_ = sidx_ - ms_ * nsn;                  \
    mt_ = ms_ * SM + q_ / SN;                                              \
    nt_ = ns_ * SN + q_ % SN;                                              \
  }
  constexpr int nk = K / 64;
  const int lrow = tid >> 3, lc = tid & 7;
  const int toff = lrow * K + lc * 8;
  const int loff = tile_off(lrow, lc);
  const int aoff = tile_off(wr * 64 + fr, fq);
  const int boff = tile_off(wc * 64 + fr, fq);
  u32x4 ra0_0, ra1_0, ra2_0, ra3_0, rb0_0, rb1_0, rb2_0, rb3_0;
#define GLD(dst, ptr) dst = *(const u32x4*)(ptr)
#define G_LOAD(S, ko)                          \
  GLD(ra0_##S, pa + 0 * 32 * K + (ko));        \
  GLD(ra1_##S, pa + 1 * 32 * K + (ko));        \
  GLD(ra2_##S, pa + 2 * 32 * K + (ko));        \
  GLD(ra3_##S, pa + 3 * 32 * K + (ko));        \
  GLD(rb0_##S, pb + 0 * 32 * K + (ko));        \
  GLD(rb1_##S, pb + 1 * 32 * K + (ko));        \
  GLD(rb2_##S, pb + 2 * 32 * K + (ko));        \
  GLD(rb3_##S, pb + 3 * 32 * K + (ko));
#define VMWAIT(N, S)
#define L_STORE(S, base)                                                \
  *(u32x4*)((base) + loff + 0 * 4096) = ra0_##S;                          \
  *(u32x4*)((base) + loff + 1 * 4096) = ra1_##S;                          \
  *(u32x4*)((base) + loff + 2 * 4096) = ra2_##S;                          \
  *(u32x4*)((base) + loff + 3 * 4096) = ra3_##S;                          \
  *(u32x4*)((base) + 16384 + loff + 0 * 4096) = rb0_##S;                  \
  *(u32x4*)((base) + 16384 + loff + 1 * 4096) = rb1_##S;                  \
  *(u32x4*)((base) + 16384 + loff + 2 * 4096) = rb2_##S;                  \
  *(u32x4*)((base) + 16384 + loff + 3 * 4096) = rb3_##S;
#define DMA1(sbase, m0v) asm volatile("s_mov_b32 m0, %2\n\ts_nop 0\n\tglobal_load_lds_dwordx4 %0, %1" ::"v"(dvoff), "s"(sbase), "s"(m0v) : "memory", "m0")
#define DMA_LOAD(sb, ko)                                   \
  DMA1(Au + 0 * 32 * K + (ko), (sb) + 0 * 4096);           \
  DMA1(Au + 1 * 32 * K + (ko), (sb) + 1 * 4096);           \
  DMA1(Au + 2 * 32 * K + (ko), (sb) + 2 * 4096);           \
  DMA1(Au + 3 * 32 * K + (ko), (sb) + 3 * 4096);           \
  DMA1(Bu + 0 * 32 * K + (ko), (sb) + 16384 + 0 * 4096);   \
  DMA1(Bu + 1 * 32 * K + (ko), (sb) + 16384 + 1 * 4096);   \
  DMA1(Bu + 2 * 32 * K + (ko), (sb) + 16384 + 2 * 4096);   \
  DMA1(Bu + 3 * 32 * K + (ko), (sb) + 16384 + 3 * 4096);
#define MMA_TILE(As_, Bs_)                                                                        \
  __builtin_amdgcn_s_setprio(1);                                                                  \
  _Pragma("unroll") for (int ks = 0; ks < 2; ++ks) {                                              \
    bf16x8 af[4], bfr[4];                                                                         \
    _Pragma("unroll") for (int mi = 0; mi < 4; ++mi) af[mi] = *(const bf16x8*)((As_) + (aoff ^ (ks << 6)) + mi * 2048);  \
    _Pragma("unroll") for (int ni = 0; ni < 4; ++ni) bfr[ni] = *(const bf16x8*)((Bs_) + (boff ^ (ks << 6)) + ni * 2048); \
    _Pragma("unroll") for (int mi = 0; mi < 4; ++mi)                                              \
      _Pragma("unroll") for (int ni = 0; ni < 4; ++ni)                                            \
        acc[mi][ni] = __builtin_amdgcn_mfma_f32_16x16x32_bf16(af[mi], bfr[ni], acc[mi][ni], 0, 0, 0); \
  }                                                                                               \
  __builtin_amdgcn_s_setprio(0);
  int mt, nt;
  TILE_MN(0, mt, nt)
  const u16* pa = A + (size_t)mt * 128 * K + toff;
  const u16* pb = Bt + (size_t)nt * 128 * K + toff;
  G_LOAD(0, 0)
#pragma unroll 1
  for (int ti = 0; ti < ntile; ++ti) {
  const int brow = mt * 128, bcol = nt * 128;
  f32x4 acc[4][4];
#pragma unroll
  for (int i = 0; i < 4; ++i)
#pragma unroll
    for (int j = 0; j < 4; ++j) acc[i][j] = f32x4{0.f, 0.f, 0.f, 0.f};
  L_STORE(0, smem)
  __syncthreads();
  {
    const unsigned dvoff = (unsigned)(lrow * K + ((lc ^ lrow) & 7) * 8) * 2u;
    const u16* Au = A + (size_t)mt * 128 * K;
    const u16* Bu = Bt + (size_t)nt * 128 * K;
    const unsigned sm0 = __builtin_amdgcn_readfirstlane((unsigned)(size_t)smem) + __builtin_amdgcn_readfirstlane(wid) * 1024u;
#pragma unroll 2
    for (int kt = 0; kt < nk; ++kt) {
      const int cur = kt & 1;
      if (kt + 1 < nk) {
        const unsigned sb = sm0 + (unsigned)(cur ^ 1) * 32768u;
        DMA_LOAD(sb, (kt + 1) * 64)
      }
      __builtin_amdgcn_sched_barrier(0);
      MMA_TILE(smem + cur * 32768, smem + cur * 32768 + 16384)
      __builtin_amdgcn_sched_barrier(0);
      asm volatile("s_waitcnt vmcnt(0)" ::: "memory");
      __syncthreads();
    }
  }
  int mt2 = mt, nt2 = nt;
  if (ti + 1 < ntile) {
    TILE_MN(ti + 1, mt2, nt2)
    pa = A + (size_t)mt2 * 128 * K + toff;
    pb = Bt + (size_t)nt2 * 128 * K + toff;
    if constexpr (EPI != 1) { G_LOAD(0, 0) }
  }
  __builtin_amdgcn_sched_barrier(0);
  const int r0 = brow + wr * 64;
  char* stg = smem + wid * 16384;
  if constexpr (EPI == 0 || EPI == 3) {
    const int OW = (EPI == 0) ? 1024 : FH;
    u16* outp = p.big();
    const int jch0 = (bcol + wc * 64) >> 1;
#pragma unroll
    for (int pp = 0; pp < 2; ++pp) {
      float b0 = 0.f, b1 = 0.f;
      if (bias) { b0 = bias[jch0 + pp * 16 + fr]; b1 = bias[1024 + jch0 + pp * 16 + fr]; }
#pragma unroll
      for (int mi = 0; mi < 4; ++mi)
#pragma unroll
        for (int j = 0; j < 4; ++j) {
          float a = acc[mi][2 * pp][j] + b0, g = acc[mi][2 * pp + 1][j] + b1;
          float sg = sigmoidf_(EPI == 0 ? g : a);
          float v = (EPI == 0) ? a * sg : a * sg * g;
          *(u16*)(stg + (mi * 16 + fq * 4 + j) * 80 + (pp * 16 + fr) * 2) = f2bf(v);
        }
    }
    __syncthreads();
#pragma unroll
    for (int it = 0; it < 4; ++it) {
      const int row = it * 16 + (lane >> 2), ch = lane & 3;
      u32x4 val = *(const u32x4*)(stg + row * 80 + ch * 16);
      *(u32x4*)(outp + (size_t)(r0 + row) * OW + jch0 + ch * 8) = val;
    }
    __syncthreads();
  } else if constexpr (EPI == 2) {
    float* sf = (float*)stg;
#pragma unroll
    for (int mi = 0; mi < 4; ++mi)
#pragma unroll
      for (int ni = 0; ni < 4; ++ni)
#pragma unroll
        for (int j = 0; j < 4; ++j) sf[(mi * 16 + fq * 4 + j) * 64 + ((ni ^ fq) << 4) + fr] = acc[mi][ni][j];
    __syncthreads();
    {
      const int r = brow < TL ? brow / SEQ : 8;
      const int c = lane & 15, rsub = lane >> 4;
      const int col0 = bcol + wc * 64 + c * 4;
      const float4 g4 = *(const float4*)(p.modv() + ((size_t)layer * 9 + r) * 6144 + gidx * 1024 + col0);
      float4 b4 = make_float4(0.f, 0.f, 0.f, 0.f);
      if (bias) b4 = *(const float4*)(bias + col0);
      float* hrow = p.h() + (size_t)(r0 + rsub) * 1024 + col0;
      const float* srow = sf + rsub * 64 + (c & 3) * 4;
#pragma unroll 1
      for (int it4 = 0; it4 < 4; ++it4) {
#pragma unroll
        for (int u = 0; u < 4; ++u) {
          const int grp = (c >> 2) ^ u;
          const float4 a4 = *(const float4*)(srow + u * 256 + grp * 16);
          float4* hp = (float4*)(hrow + u * 4096);
          float4 hv = *hp;
          hv.x += g4.x * (a4.x + b4.x); hv.y += g4.y * (a4.y + b4.y); hv.z += g4.z * (a4.z + b4.z); hv.w += g4.w * (a4.w + b4.w);
          *hp = hv;
        }
        hrow += 16 * 1024;
        srow += 16 * 64;
      }
    }
    __syncthreads();
  } else {
    const int region = nt >> 3, hd = nt & 7;
    const bool lat = brow < TL;
    const int b = lat ? brow / SEQ : (brow - TL) / CTX;
    const int kb = lat ? 256 + (r0 - b * SEQ) : (r0 - TL - b * CTX);
    const size_t bh = (size_t)(b * 8 + hd);
    u16* qb = p.big(); u16* kbuf = p.big() + (size_t)T * 1024; u16* vt = p.big() + (size_t)T * 2048;
    if (region < 2) {
      u16* dst = (region == 0 ? qb : kbuf) + ((bh * 2 + wc) * KEYS + kb) * 64;
      const float qs = region == 0 ? 0.125f * 1.44269504088896f : 1.f;
#pragma unroll
      for (int mi = 0; mi < 4; ++mi)
#pragma unroll
        for (int j = 0; j < 4; ++j) {
          int rl = mi * 16 + fq * 4 + j;
          float x0 = acc[mi][0][j], x1 = acc[mi][1][j], x2 = acc[mi][2][j], x3 = acc[mi][3][j];
          if (lat) {
            int t = kb - 256 + rl;
            float2 cr = p.rope()[(t >> 6) * 16 + fr], cc = p.rope()[(t & 63) * 16 + fr];
            float y0 = x0 * cr.x - x1 * cr.y, y1 = x1 * cr.x + x0 * cr.y;
            float y2 = x2 * cc.x - x3 * cc.y, y3 = x3 * cc.x + x2 * cc.y;
            x0 = y0; x1 = y1; x2 = y2; x3 = y3;
          }
          char* sp = stg + rl * 144 + fr * 2;
          *(u16*)(sp) = f2bf(x0 * qs); *(u16*)(sp + 32) = f2bf(x1 * qs); *(u16*)(sp + 64) = f2bf(x2 * qs); *(u16*)(sp + 96) = f2bf(x3 * qs);
          if (j == 3) asm volatile("" ::: "memory");
        }
      __syncthreads();
#pragma unroll
      for (int it = 0; it < 8; ++it) {
        const int row = it * 8 + (lane >> 3), ch = lane & 7;
        u32x4 val = *(const u32x4*)(stg + row * 144 + ch * 16);
        *(u32x4*)(dst + (size_t)row * 64 + ch * 8) = val;
      }
      __syncthreads();
    } else {
#pragma unroll
      for (int ni = 0; ni < 4; ++ni) {
        const int e = ni * 16 + fr;
#pragma unroll
        for (int mi = 0; mi < 4; ++mi) {
          int slot = (mi >> 1) * 32 + fq * 8 + (mi & 1) * 4;
          *(uint2*)(stg + e * 144 + slot * 2) = make_uint2(pack2(acc[mi][ni][0], acc[mi][ni][1]), pack2(acc[mi][ni][2], acc[mi][ni][3]));
        }
      }
      __syncthreads();
      u16* dp = vt + (bh * 128 + wc * 64) * KEYS + kb;
#pragma unroll
      for (int it = 0; it < 8; ++it) {
        const int row = it * 8 + (lane >> 3), ch = lane & 7;
        u32x4 val = *(const u32x4*)(stg + row * 144 + ch * 16);
        *(u32x4*)(dp + (size_t)row * KEYS + ch * 8) = val;
      }
      __syncthreads();
    }
  }
  if constexpr (EPI == 1) { if (ti + 1 < ntile) { G_LOAD(0, 0) } }
  mt = mt2; nt = nt2;
  }
#undef GLD
#undef VMWAIT
#undef G_LOAD
#undef L_STORE
#undef MMA_TILE
#undef DMA1
#undef DMA_LOAD
#undef TILE_MN
}

__device__ void gemm_phase(const Params& p, const u16* A, const u16* Bt, int K, int Mt, int Nt, int epi, int layer, int gidx,
                           const float* bias, char* smem) {
  if (K != 1024) gemm_run<FH, 2>(p, A, Bt, Mt, Nt, layer, gidx, bias, smem);
  else if (epi == 0) gemm_run<1024, 0>(p, A, Bt, Mt, Nt, layer, gidx, bias, smem);
  else if (epi == 1) gemm_run<1024, 1>(p, A, Bt, Mt, Nt, layer, gidx, bias, smem);
  else if (epi == 2) gemm_run<1024, 2>(p, A, Bt, Mt, Nt, layer, gidx, bias, smem);
  else gemm_run<1024, 3>(p, A, Bt, Mt, Nt, layer, gidx, bias, smem);
}

__device__ void conv_phase(const Params& p, int j, int M, char* smem) {
  const int tid = otid(), wid = tid >> 6, lane = tid & 63;
  float* cbuf = (float*)smem;
  const u16* U = p.big();
  for (int item = blockIdx.x; item < M / 8; item += gridDim.x) {
    const int t0 = item * 8;
    int s0, s1;
    if (t0 < TL) { s0 = (t0 / SEQ) * SEQ; s1 = s0 + SEQ; } else { s0 = TL + ((t0 - TL) / CTX) * CTX; s1 = s0 + CTX; }
#pragma unroll 1
    for (int g = 0; g < 2; ++g) {
      const int c = g * 512 + tid * 2;
      float acc[8][2];
      float w[31][2];
#pragma unroll
      for (int k = 0; k < 31; ++k) { float2 wv = *(const float2*)(p.dw_w() + ((size_t)j * 31 + k) * 1024 + c); w[k][0] = wv.x; w[k][1] = wv.y; }
      float2 bv = *(const float2*)(p.dw_b() + j * 1024 + c);
#pragma unroll
      for (int o = 0; o < 8; ++o) { acc[o][0] = bv.x; acc[o][1] = bv.y; }
#pragma unroll
      for (int ti = 0; ti < 38; ++ti) {
        int tin = t0 - 15 + ti;
        bool valid = tin >= s0 && tin < s1;
        int tc = min(max(tin, s0), s1 - 1);
        unsigned raw = *(const unsigned*)(U + (size_t)tc * 1024 + c);
        if (!valid) raw = 0u;
        float x0 = bf2f(raw & 0xffffu), x1 = bf2f(raw >> 16);
#pragma unroll
        for (int o = 0; o < 8; ++o) {
          const int k = ti - o;
          if (k >= 0 && k < 31) { acc[o][0] += x0 * w[k][0]; acc[o][1] += x1 * w[k][1]; }
        }
      }
#pragma unroll
      for (int o = 0; o < 8; ++o) *(float2*)(cbuf + o * 1024 + c) = make_float2(acc[o][0], acc[o][1]);
    }
    __syncthreads();
#pragma unroll
    for (int tt = 0; tt < 2; ++tt) {
      const int o = wid * 2 + tt;
      float4 v[4];
      float sm = 0.f;
#pragma unroll
      for (int i = 0; i < 4; ++i) { v[i] = *(const float4*)(cbuf + o * 1024 + (lane + 64 * i) * 4); sm += v[i].x + v[i].y + v[i].z + v[i].w; }
#pragma unroll
      for (int sh = 32; sh >= 1; sh >>= 1) sm += __shfl_xor(sm, sh);
      const float mean = sm * (1.f / 1024.f);
      float sq = 0.f;
#pragma unroll
      for (int i = 0; i < 4; ++i) {
        v[i].x -= mean; v[i].y -= mean; v[i].z -= mean; v[i].w -= mean;
        sq += v[i].x * v[i].x + v[i].y * v[i].y + v[i].z * v[i].z + v[i].w * v[i].w;
      }
#pragma unroll
      for (int sh = 32; sh >= 1; sh >>= 1) sq += __shfl_xor(sq, sh);
      const float rstd = rsqrtf(sq * (1.f / 1024.f) + EPS);
      uint2* op = (uint2*)(p.vbuf() + (size_t)(t0 + o) * 1024);
#pragma unroll
      for (int i = 0; i < 4; ++i) {
        int c4 = lane + 64 * i;
        float4 lg = ((const float4*)(p.ln_g() + j * 1024))[c4], lb = ((const float4*)(p.ln_b() + j * 1024))[c4];
        float y0 = v[i].x * rstd * lg.x + lb.x, y1 = v[i].y * rstd * lg.y + lb.y;
        float y2 = v[i].z * rstd * lg.z + lb.z, y3 = v[i].w * rstd * lg.w + lb.w;
        y0 *= sigmoidf_(y0); y1 *= sigmoidf_(y1); y2 *= sigmoidf_(y2); y3 *= sigmoidf_(y3);
        op[c4] = make_uint2(pack2(y0, y1), pack2(y2, y3));
      }
    }
    __syncthreads();
  }
}

__device__ void attn_item(const Params& p, int b, int hd, int q0, int nkeys, int out_row0, float lam, float oscale,
                          const float* __restrict__ subg, char* smem) {
  const int tid = otid(), wid = tid >> 6, lane = tid & 63, fr = lane & 15, fq = lane >> 4;
  const int comp = wid & 1, qg = wid >> 1;
  const size_t bh = (size_t)(b * 8 + hd);
  const u16* qb = p.big(); const u16* kbuf = p.big() + (size_t)T * 1024; const u16* vtb = p.big() + (size_t)T * 2048;
  const u16* Qp = qb + ((bh * 2 + comp) * KEYS + q0 + qg * 32) * 64;
  bf16x8 qf[2][2];
#pragma unroll
  for (int qs = 0; qs < 2; ++qs)
#pragma unroll
    for (int ks = 0; ks < 2; ++ks) qf[qs][ks] = *(const bf16x8*)(Qp + (qs * 16 + fr) * 64 + ks * 32 + fq * 8);
  const u16* K1p = kbuf + (bh * 2 + 0) * KEYS * 64;
  const u16* K2p = kbuf + (bh * 2 + 1) * KEYS * 64;
  const u16* Vp = vtb + bh * 128 * KEYS;
  const int lrow = tid >> 3, lc = tid & 7;
  u32x4 rg0, rg1, rg2, rg3, rg4, rg5, rg6, rg7;
#define ATT_GLOAD(kt_)                                                                         \
  {                                                                                            \
    const int key0 = (kt_) * 64;                                                               \
    rg0 = *(const u32x4*)(K1p + (size_t)(key0 + lrow) * 64 + lc * 8);                          \
    rg1 = *(const u32x4*)(K1p + (size_t)(key0 + lrow + 32) * 64 + lc * 8);                     \
    rg2 = *(const u32x4*)(K2p + (size_t)(key0 + lrow) * 64 + lc * 8);                          \
    rg3 = *(const u32x4*)(K2p + (size_t)(key0 + lrow + 32) * 64 + lc * 8);                     \
    rg4 = *(const u32x4*)(Vp + (size_t)(lrow) * KEYS + key0 + lc * 8);                         \
    rg5 = *(const u32x4*)(Vp + (size_t)(lrow + 32) * KEYS + key0 + lc * 8);                    \
    rg6 = *(const u32x4*)(Vp + (size_t)(lrow + 64) * KEYS + key0 + lc * 8);                    \
    rg7 = *(const u32x4*)(Vp + (size_t)(lrow + 96) * KEYS + key0 + lc * 8);                    \
  }
#define ATT_LSTORE(buf_)                                                                       \
  {                                                                                            \
    char* bs_ = smem + (buf_) * 32768 + tile_off(lrow, lc);                                    \
    *(u32x4*)(bs_) = rg0;                                                                      \
    *(u32x4*)(bs_ + 4096) = rg1;                                                               \
    *(u32x4*)(bs_ + 8192) = rg2;                                                               \
    *(u32x4*)(bs_ + 8192 + 4096) = rg3;                                                        \
    *(u32x4*)(bs_ + 16384) = rg4;                                                              \
    *(u32x4*)(bs_ + 16384 + 4096) = rg5;                                                       \
    *(u32x4*)(bs_ + 16384 + 8192) = rg6;                                                       \
    *(u32x4*)(bs_ + 16384 + 12288) = rg7;                                                      \
  }
  f32x4 O[8][2];
#pragma unroll
  for (int e = 0; e < 8; ++e) { O[e][0] = f32x4{0.f, 0.f, 0.f, 0.f}; O[e][1] = f32x4{0.f, 0.f, 0.f, 0.f}; }
  float m[2] = {-1e30f, -1e30f}, l[2] = {0.f, 0.f};
  const int ntile = nkeys >> 6;
  ATT_GLOAD(0);
  ATT_LSTORE(0);
  __syncthreads();
  for (int kt = 0; kt < ntile; ++kt) {
    const int cur = kt & 1;
    if (kt + 1 < ntile) ATT_GLOAD(kt + 1);
    const char* base = smem + cur * 32768;
    const char* Kc = base + comp * 8192;
    const char* Vt = base + 16384;
    f32x4 S[4][2];
#pragma unroll
    for (int i = 0; i < 4; ++i) { S[i][0] = f32x4{0.f, 0.f, 0.f, 0.f}; S[i][1] = f32x4{0.f, 0.f, 0.f, 0.f}; }
    __builtin_amdgcn_s_setprio(1);
#pragma unroll
    for (int ks = 0; ks < 2; ++ks)
#pragma unroll
      for (int ksub = 0; ksub < 4; ++ksub) {
        bf16x8 kf = *(const bf16x8*)(Kc + tile_off(ksub * 16 + fr, ks * 4 + fq));
#pragma unroll
        for (int qs = 0; qs < 2; ++qs) S[ksub][qs] = __builtin_amdgcn_mfma_f32_16x16x32_bf16(kf, qf[qs][ks], S[ksub][qs], 0, 0, 0);
      }
    __builtin_amdgcn_s_setprio(0);
#pragma unroll
    for (int qs = 0; qs < 2; ++qs) {
      float mx = -1e30f;
#pragma unroll
      for (int ksub = 0; ksub < 4; ++ksub)
#pragma unroll
        for (int j = 0; j < 4; ++j) mx = fmaxf(mx, S[ksub][qs][j]);
      mx = fmaxf(mx, __shfl_xor(mx, 16));
      mx = fmaxf(mx, __shfl_xor(mx, 32));
      float mn = fmaxf(m[qs], mx);
      float alpha = fexp2(m[qs] - mn);
      m[qs] = mn;
      float rs = 0.f;
#pragma unroll
      for (int ksub = 0; ksub < 4; ++ksub)
#pragma unroll
        for (int j = 0; j < 4; ++j) { float pv = fexp2(S[ksub][qs][j] - mn); S[ksub][qs][j] = pv; rs += pv; }
      l[qs] = l[qs] * alpha + rs;
      if (__builtin_amdgcn_ballot_w64(alpha != 1.f) != 0) {
#pragma unroll
        for (int e = 0; e < 8; ++e) O[e][qs] *= alpha;
      }
    }
    bf16x8 pf[2][2];
#pragma unroll
    for (int qs = 0; qs < 2; ++qs)
#pragma unroll
      for (int s = 0; s < 2; ++s) {
        unsigned u0 = pack2(S[2 * s][qs][0], S[2 * s][qs][1]), u1 = pack2(S[2 * s][qs][2], S[2 * s][qs][3]);
        unsigned u2 = pack2(S[2 * s + 1][qs][0], S[2 * s + 1][qs][1]), u3 = pack2(S[2 * s + 1][qs][2], S[2 * s + 1][qs][3]);
        uint4 uu = make_uint4(u0, u1, u2, u3);
        pf[qs][s] = *(bf16x8*)&uu;
      }
    __builtin_amdgcn_s_setprio(1);
#pragma unroll
    for (int s = 0; s < 2; ++s)
#pragma unroll
      for (int e = 0; e < 8; ++e) {
        bf16x8 vf = *(const bf16x8*)(Vt + tile_off(e * 16 + fr, s * 4 + fq));
#pragma unroll
        for (int qs = 0; qs < 2; ++qs) O[e][qs] = __builtin_amdgcn_mfma_f32_16x16x32_bf16(vf, pf[qs][s], O[e][qs], 0, 0, 0);
      }
    __builtin_amdgcn_s_setprio(0);
    if (kt + 1 < ntile) ATT_LSTORE(cur ^ 1);
    __syncthreads();
  }
#undef ATT_GLOAD
#undef ATT_LSTORE
#pragma unroll
  for (int qs = 0; qs < 2; ++qs) {
    float ls = l[qs];
    ls += __shfl_xor(ls, 16);
    ls += __shfl_xor(ls, 32);
    float inv = (comp ? lam : 1.f) / ls;
#pragma unroll
    for (int e = 0; e < 8; ++e) O[e][qs] *= inv;
  }
  float* ex = (float*)smem;
  if (comp == 1) {
#pragma unroll
    for (int e = 0; e < 8; ++e)
#pragma unroll
      for (int qs = 0; qs < 2; ++qs) *(f32x4*)(ex + ((((qg * 8 + e) * 2 + qs) * 64 + lane) << 2)) = O[e][qs];
  }
  __syncthreads();
  if (comp == 0) {
#pragma unroll
    for (int qs = 0; qs < 2; ++qs) {
      float ssq = 0.f;
#pragma unroll
      for (int e = 0; e < 8; ++e) {
        f32x4 o2 = *(const f32x4*)(ex + ((((qg * 8 + e) * 2 + qs) * 64 + lane) << 2));
        O[e][qs] -= o2;
#pragma unroll
        for (int j = 0; j < 4; ++j) ssq += O[e][qs][j] * O[e][qs][j];
      }
      ssq += __shfl_xor(ssq, 16);
      ssq += __shfl_xor(ssq, 32);
      float rstd = rsqrtf(ssq * (1.f / 128.f) + EPS) * oscale;
      u16* op = p.vbuf() + (size_t)(out_row0 + qg * 32 + qs * 16 + fr) * 1024 + hd * 128 + fq * 4;
#pragma unroll
      for (int e = 0; e < 8; ++e) {
        float4 sg = *(const float4*)(subg + e * 16 + fq * 4);
        *(uint2*)(op + e * 16) = make_uint2(pack2(O[e][qs][0] * rstd * sg.x, O[e][qs][1] * rstd * sg.y),
                                            pack2(O[e][qs][2] * rstd * sg.z, O[e][qs][3] * rstd * sg.w));
      }
    }
  }
  __syncthreads();
}

__device__ void attn_phase(const Params& p, int layer, bool with_ctx, char* smem) {
  const int ja = layer >> 1;
  const float* lv = p.lam() + ja * 256;
  float d01 = 0.f, d23 = 0.f;
  for (int i = 0; i < 64; ++i) { d01 += lv[i] * lv[64 + i]; d23 += lv[128 + i] * lv[192 + i]; }
  const float lam_init = 0.8f - 0.6f * expf(-0.3f * (float)layer);
  const float lam = expf(d01) - expf(d23) + lam_init;
  const float* subg = p.subln() + ja * 128;
  {
    const int xcd = blockIdx.x & 7, rank = blockIdx.x >> 3, rpx = gridDim.x >> 3;
    for (int r = 0; r < 4; ++r)
      for (int q = rank; q < 64; q += rpx) {
        const int bh = r * 16 + xcd * 2 + (q >> 5), qt = q & 31;
        const int b = bh >> 3, hd = bh & 7;
        attn_item(p, b, hd, 256 + qt * 64, KEYS, b * SEQ + qt * 64, lam, 1.f - lam_init, subg, smem);
      }
  }
  if (with_ctx) {
    for (int it = blockIdx.x; it < 256; it += gridDim.x) {
      const int qt = it & 3, hd = (it >> 2) & 7, b = it >> 5;
      attn_item(p, b, hd, qt * 64, CTX, TL + b * CTX + qt * 64, lam, 1.f - lam_init, subg, smem);
    }
  }
}

__device__ void run_phase(const Params& p, int ph_in, char* smem) {
  const int ph = ph_in & 0xffff; const bool noepi = (ph_in >> 16) != 0;
  if (ph == 0) { prologue_phase(p, smem); return; }
  if (ph == NPH - 1) { final_phase(p); return; }
  const int layer = (ph - 1) / 7, sub = (ph - 1) % 7;
  const bool last = layer == DEPTH - 1;
  const int M = last ? TL : T;
  const bool is_conv = (layer & 1) == 0;
  const int j = layer >> 1;
  if (sub == 0 || sub == 4) { norm_phase(p, layer, sub == 4 ? 1 : 0, sub == 0 ? T : M); return; }
  if (sub == 2) {
    if (is_conv) conv_phase(p, j, T, smem);
    else attn_phase(p, layer, !last, smem);
    return;
  }
  const u16 *A, *Bt; int K = 1024, Nt, epi, gidx = 0, mtiles = M / 128; const float* bias = nullptr;
  if (sub == 1) {
    A = p.nbuf(); mtiles = T / 128;
    if (is_conv) { Bt = p.w_pw1() + (size_t)j * 2048 * 1024; Nt = 16; epi = 0; bias = p.pw1_b() + j * 2048; }
    else { Bt = p.w_qkv() + (size_t)j * 3072 * 1024; Nt = 24; epi = 1; }
  } else if (sub == 3) {
    A = p.vbuf(); Nt = 8; epi = 2; gidx = 2;
    if (is_conv) { Bt = p.w_pw2() + (size_t)j * 1024 * 1024; bias = p.pw2_b() + j * 1024; }
    else Bt = p.w_o() + (size_t)j * 1024 * 1024;
  } else if (sub == 5) {
    A = p.nbuf(); Bt = p.w_fin() + (size_t)layer * 5632 * 1024; Nt = 44; epi = 3;
  } else {
    A = p.big(); Bt = p.w_fout() + (size_t)layer * 1024 * FH; K = FH; Nt = 8; epi = 2; gidx = 5;
  }
  gemm_phase(p, A, Bt, K, mtiles, Nt, epi, layer, gidx, bias, smem);
}

__device__ __forceinline__ unsigned xcc_id() { return (unsigned)__builtin_amdgcn_s_getreg((3 << 11) | 20) & 0xFu; }
__device__ __forceinline__ void grid_barrier(unsigned* bar, unsigned xcc, unsigned k, unsigned nloc, unsigned nx) {
  __syncthreads();
  if (threadIdx.x == 0) {
    unsigned a = __hip_atomic_fetch_add(&bar[1024 + xcc * 64], 1u, __ATOMIC_RELAXED, __HIP_MEMORY_SCOPE_AGENT) + 1u;
    if (a == k * nloc) {
      __builtin_amdgcn_fence(__ATOMIC_RELEASE, "agent");
      asm volatile("s_waitcnt vmcnt(0)" ::: "memory");
      __hip_atomic_fetch_add(&bar[2048], 1u, __ATOMIC_RELAXED, __HIP_MEMORY_SCOPE_AGENT);
    }
    while (__hip_atomic_load(&bar[2048], __ATOMIC_RELAXED, __HIP_MEMORY_SCOPE_AGENT) < k * nx) __builtin_amdgcn_s_sleep(2);
    __builtin_amdgcn_fence(__ATOMIC_ACQUIRE, "agent");
    asm volatile("s_waitcnt vmcnt(0)" ::: "memory");
  }
  __syncthreads();
}

__global__ void __launch_bounds__(256, 2) mega(Params p, int ph_begin, int ph_end, int use_sync) {
  __shared__ __attribute__((aligned(16))) char smem[65536];
  __shared__ unsigned s_cnt[2];
  cg::grid_group grid = cg::this_grid();
  unsigned* bar = (unsigned*)(p.ws + WS_NEED);
  const unsigned xcc = xcc_id();
  if (use_sync && threadIdx.x == 0) __hip_atomic_fetch_add(&bar[xcc * 64], 1u, __ATOMIC_RELAXED, __HIP_MEMORY_SCOPE_AGENT);
  unsigned k = 0, nloc = 1, nx = 1;
  for (int ph = ph_begin; ph < ph_end; ++ph) {
    run_phase(p, ph, smem);
#ifdef DUP_MASK
    if (ph > ph_begin) {
      const int sub = (ph >= 1 && ph < NPH - 1) ? (ph - 1) % 7 : -1, layer = (ph - 1) / 7;
      bool dup = false;
      if ((DUP_MASK & 1) && sub == 2 && (layer & 1)) dup = true;
      if ((DUP_MASK & 2) && (sub == 1 || sub == 5)) dup = true;
      if ((DUP_MASK & 4) && sub == 2 && !(layer & 1)) dup = true;
      if ((DUP_MASK & 8) && (sub == 0 || sub == 4)) dup = true;
      if (dup) { ++k; grid_barrier(bar, xcc, k, nloc, nx); run_phase(p, ph | DUP_FLAG, smem); }
    }
#endif
    if (use_sync && ph + 1 < ph_end) {
      if (ph == ph_begin) {
        grid.sync();
        if (threadIdx.x == 0) {
          unsigned cnt = 0;
          for (int j = 0; j < 16; ++j) cnt += __hip_atomic_load(&bar[j * 64], __ATOMIC_RELAXED, __HIP_MEMORY_SCOPE_AGENT) ? 1u : 0u;
          s_cnt[0] = __hip_atomic_load(&bar[xcc * 64], __ATOMIC_RELAXED, __HIP_MEMORY_SCOPE_AGENT);
          s_cnt[1] = cnt;
        }
        __syncthreads();
        nloc = __builtin_amdgcn_readfirstlane(s_cnt[0]); nx = __builtin_amdgcn_readfirstlane(s_cnt[1]);
      } else {
        ++k;
        grid_barrier(bar, xcc, k, nloc, nx);
      }
    }
  }
}

extern "C" void kernel_launch(void* const* d_in, const int* in_sizes, int n_in, void* d_out, int out_size, void* d_ws,
                              size_t ws_size, hipStream_t stream) {
  Params p{};
  for (int i = 0; i < 22; ++i) p.in[i] = (const float*)d_in[i];
  p.outp = (float*)d_out;
  p.ws = (char*)d_ws;
  if (WS_NEED + 16384 > ws_size || n_in < 22) return;
  static int grid_blocks = 0;
  if (!grid_blocks) {
    int dev = 0, cus = 0, per_cu = 0;
    hipGetDevice(&dev);
    hipDeviceGetAttribute(&cus, hipDeviceAttributeMultiprocessorCount, dev);
    hipOccupancyMaxActiveBlocksPerMultiprocessor(&per_cu, mega, 256, 0);
    if (per_cu > 2) per_cu = 2;
    if (per_cu < 1) per_cu = 1;
    grid_blocks = cus * per_cu;
  }
#if MULTI_LAUNCH
  for (int ph = 0; ph < NPH; ++ph) mega<<<grid_blocks, 256, 0, stream>>>(p, ph, ph + 1, 0);
#else
  hipMemsetAsync((char*)d_ws + WS_NEED, 0, 16384, stream);
  int b = 0, e = NPH, s = 1;
  void* args[] = {&p, &b, &e, &s};
  hipError_t err = hipLaunchCooperativeKernel((void*)mega, dim3(grid_blocks), dim3(256), args, 0, stream);
  if (err != hipSuccess) fprintf(stderr, "cooperative launch failed: %s (grid %d)\n", hipGetErrorString(err), grid_blocks);
#endif
}
```

```cpp
#include <hip/hip_runtime.h>
#include <hip/hip_cooperative_groups.h>
#include <cstdio>
namespace cg = cooperative_groups;

#ifndef DUP_FLAG
#define DUP_FLAG 0
#endif
#ifndef MULTI_LAUNCH
#define MULTI_LAUNCH 0
#endif

typedef unsigned short u16;
using bf16x8 = __attribute__((ext_vector_type(8))) short;
using f32x4 = __attribute__((ext_vector_type(4))) float;
using u32x4 = __attribute__((ext_vector_type(4))) unsigned;

constexpr int D = 1024, NB = 8, SEQ = 2048, CTX = 256, DEPTH = 4;
constexpr int TL = NB * SEQ;
constexpr int TCX = NB * CTX;
constexpr int T = TL + TCX;
constexpr int FH = 2816;
constexpr int KEYS = CTX + SEQ;
constexpr int NPH = 2 + 7 * DEPTH;
constexpr float EPS = 1e-6f;

constexpr size_t al256(size_t x) { return (x + 255) & ~(size_t)255; }
constexpr size_t OFF_WPW1 = 0;
constexpr size_t OFF_WPW2 = OFF_WPW1 + al256((size_t)2 * 2048 * 1024 * 2);
constexpr size_t OFF_WQKV = OFF_WPW2 + al256((size_t)2 * 1024 * 1024 * 2);
constexpr size_t OFF_WO = OFF_WQKV + al256((size_t)2 * 3072 * 1024 * 2);
constexpr size_t OFF_WFIN = OFF_WO + al256((size_t)2 * 1024 * 1024 * 2);
constexpr size_t OFF_WFOUT = OFF_WFIN + al256((size_t)4 * 5632 * 1024 * 2);
constexpr size_t OFF_H = OFF_WFOUT + al256((size_t)4 * 1024 * FH * 2);
constexpr size_t OFF_NBUF = OFF_H + al256((size_t)T * 1024 * 4);
constexpr size_t OFF_BIG = OFF_NBUF + al256((size_t)T * 1024 * 2);
constexpr size_t OFF_VBUF = OFF_BIG + al256((size_t)T * 3072 * 2);
constexpr size_t OFF_MODV = OFF_VBUF + al256((size_t)T * 1024 * 2);
constexpr size_t OFF_ROPE = OFF_MODV + al256((size_t)4 * 9 * 6144 * 4);
constexpr size_t WS_NEED = OFF_ROPE + al256((size_t)1024 * 8);

struct Params {
  const float* in[22];
  float* outp;
  char* ws;
  __device__ __forceinline__ const float* x() const { return in[0]; }
  __device__ __forceinline__ const float* c() const { return in[1]; }
  __device__ __forceinline__ const float* ctx() const { return in[2]; }
  __device__ __forceinline__ const float* c_ctx() const { return in[3]; }
  __device__ __forceinline__ const float* mod_w() const { return in[4]; }
  __device__ __forceinline__ const float* mod_b() const { return in[5]; }
  __device__ __forceinline__ const float* norm_g() const { return in[6]; }
  __device__ __forceinline__ const float* pw1_w() const { return in[7]; }
  __device__ __forceinline__ const float* pw1_b() const { return in[8]; }
  __device__ __forceinline__ const float* dw_w() const { return in[9]; }
  __device__ __forceinline__ const float* dw_b() const { return in[10]; }
  __device__ __forceinline__ const float* ln_g() const { return in[11]; }
  __device__ __forceinline__ const float* ln_b() const { return in[12]; }
  __device__ __forceinline__ const float* pw2_w() const { return in[13]; }
  __device__ __forceinline__ const float* pw2_b() const { return in[14]; }
  __device__ __forceinline__ const float* wqkv() const { return in[15]; }
  __device__ __forceinline__ const float* lam() const { return in[16]; }
  __device__ __forceinline__ const float* subln() const { return in[17]; }
  __device__ __forceinline__ const float* wo() const { return in[18]; }
  __device__ __forceinline__ const float* ffn_in() const { return in[19]; }
  __device__ __forceinline__ const float* ffn_out() const { return in[20]; }
  __device__ __forceinline__ const float* final_g() const { return in[21]; }
  __device__ __forceinline__ float* out() const { return outp; }
  __device__ __forceinline__ u16* w_pw1() const { return (u16*)(ws + OFF_WPW1); }
  __device__ __forceinline__ u16* w_pw2() const { return (u16*)(ws + OFF_WPW2); }
  __device__ __forceinline__ u16* w_qkv() const { return (u16*)(ws + OFF_WQKV); }
  __device__ __forceinline__ u16* w_o() const { return (u16*)(ws + OFF_WO); }
  __device__ __forceinline__ u16* w_fin() const { return (u16*)(ws + OFF_WFIN); }
  __device__ __forceinline__ u16* w_fout() const { return (u16*)(ws + OFF_WFOUT); }
  __device__ __forceinline__ float* h() const { return (float*)(ws + OFF_H); }
  __device__ __forceinline__ u16* nbuf() const { return (u16*)(ws + OFF_NBUF); }
  __device__ __forceinline__ u16* big() const { return (u16*)(ws + OFF_BIG); }
  __device__ __forceinline__ u16* vbuf() const { return (u16*)(ws + OFF_VBUF); }
  __device__ __forceinline__ float* modv() const { return (float*)(ws + OFF_MODV); }
  __device__ __forceinline__ float2* rope() const { return (float2*)(ws + OFF_ROPE); }
};

typedef __bf16 bf2v __attribute__((ext_vector_type(2)));
typedef float f2v __attribute__((ext_vector_type(2)));
__device__ __forceinline__ unsigned pack2(float a, float b) {
  f2v v = {a, b};
  bf2v r = __builtin_convertvector(v, bf2v);
  return *(unsigned*)&r;
}
__device__ __forceinline__ u16 f2bf(float f) { return (u16)(pack2(f, 0.f) & 0xffffu); }
__device__ __forceinline__ float bf2f(unsigned v) { return __uint_as_float(v << 16); }
__device__ __forceinline__ int tile_off(int row, int chunk) { return row * 128 + (((chunk ^ row) & 7) << 4); }
__device__ __forceinline__ float fexp2(float x) { return __builtin_amdgcn_exp2f(x); }
__device__ __forceinline__ float sigmoidf_(float x) { return __builtin_amdgcn_rcpf(1.f + __expf(-x)); }

__device__ __forceinline__ int otid() { int t = threadIdx.x; asm volatile("" : "+v"(t)); return t; }

struct WDesc { const float* sp; u16* dp; int N, K; };
__device__ __forceinline__ WDesc wconv_decode(const Params& p, int item, int tid) {
  int K, N, half = 0, tpl, ntN, base;
  const float* src; u16* dst;
  if (item < 1024)      { base = 0;    K = 1024; N = 2048; half = 1024; tpl = 512;  ntN = 32; src = p.pw1_w();  dst = p.w_pw1(); }
  else if (item < 1536) { base = 1024; K = 1024; N = 1024;              tpl = 256;  ntN = 16; src = p.pw2_w();  dst = p.w_pw2(); }
  else if (item < 3072) { base = 1536; K = 1024; N = 3072;              tpl = 768;  ntN = 48; src = p.wqkv();   dst = p.w_qkv(); }
  else if (item < 3584) { base = 3072; K = 1024; N = 1024;              tpl = 256;  ntN = 16; src = p.wo();     dst = p.w_o(); }
  else if (item < 9216) { base = 3584; K = 1024; N = 5632; half = 2816; tpl = 1408; ntN = 88; src = p.ffn_in(); dst = p.w_fin(); }
  else                  { base = 9216; K = 2816; N = 1024;              tpl = 704;  ntN = 16; src = p.ffn_out(); dst = p.w_fout(); }
  const int it = item - base;
  const int l = it / tpl, rem = it % tpl, kt = rem / ntN, nt = rem % ntN;
  src += (size_t)l * K * N; dst += (size_t)l * K * N;
  const int nl = tid & 63, kk0 = tid >> 6;
  const int np = nt * 64 + nl;
  int sc = np;
  if (half) { int blk = np >> 5, w = np & 31; sc = blk * 16 + (w & 15) + ((w >> 4) ? half : 0); }
  WDesc d;
  d.sp = src + (size_t)(kt * 64 + kk0) * N + sc;
  d.dp = dst + (size_t)(nt * 64 + (tid >> 2)) * K + kt * 64 + (tid & 3) * 16;
  d.N = N; d.K = K;
  return d;
}

__device__ void wconv_loop(const Params& p, char* smem) {
  float* tl = (float*)smem;
  const int tid = otid();
  const int nl = tid & 63, kk0 = tid >> 6, nl2 = tid >> 2, kq = tid & 3;
  int item = blockIdx.x;
  if (item >= 12032) return;
  float v[16];
  WDesc d = wconv_decode(p, item, tid);
#pragma unroll
  for (int i = 0; i < 16; ++i) v[i] = d.sp[(size_t)(4 * i) * d.N];
  for (; item < 12032; item += gridDim.x) {
#pragma unroll
    for (int i = 0; i < 16; ++i) tl[(kk0 + 4 * i) * 65 + nl] = v[i];
    u16* dp = d.dp;
    const int nxt = item + gridDim.x;
    if (nxt < 12032) {
      d = wconv_decode(p, nxt, tid);
#pragma unroll
      for (int i = 0; i < 16; ++i) v[i] = d.sp[(size_t)(4 * i) * d.N];
    }
    __syncthreads();
    unsigned pk[8];
#pragma unroll
    for (int e = 0; e < 8; ++e) pk[e] = pack2(tl[(kq * 16 + 2 * e) * 65 + nl2], tl[(kq * 16 + 2 * e + 1) * 65 + nl2]);
    ((uint4*)dp)[0] = make_uint4(pk[0], pk[1], pk[2], pk[3]);
    ((uint4*)dp)[1] = make_uint4(pk[4], pk[5], pk[6], pk[7]);
    __syncthreads();
  }
}

__device__ void prologue_phase(const Params& p, char* smem) {
  const int tid = otid(), wid = tid >> 6, lane = tid & 63;
  if (blockIdx.x < 384) {
    float* s = (float*)smem;
    float* red = (float*)(smem + 36864);
    for (int idx = tid; idx < 9 * 1024; idx += 256) {
      int r = idx >> 10, k = idx & 1023;
      float cv = r < 8 ? p.c()[r * 1024 + k] : p.c_ctx()[k];
      s[idx] = cv * sigmoidf_(cv);
    }
    __syncthreads();
    for (int item = blockIdx.x; item < 384; item += gridDim.x) {
      int i = item / 96, cgp = item % 96;
      float a[9];
#pragma unroll
      for (int r = 0; r < 9; ++r) a[r] = 0.f;
      const float* wp = p.mod_w() + ((size_t)i * 1024 + wid * 256) * 6144 + cgp * 64 + lane;
#pragma unroll 4
      for (int k4 = 0; k4 < 256; k4 += 4) {
        float w0 = wp[(size_t)(k4 + 0) * 6144], w1 = wp[(size_t)(k4 + 1) * 6144];
        float w2 = wp[(size_t)(k4 + 2) * 6144], w3 = wp[(size_t)(k4 + 3) * 6144];
#pragma unroll
        for (int r = 0; r < 9; ++r) {
          float4 sv = *(const float4*)&s[r * 1024 + wid * 256 + k4];
          a[r] += sv.x * w0 + sv.y * w1 + sv.z * w2 + sv.w * w3;
        }
      }
#pragma unroll
      for (int r = 0; r < 9; ++r) red[(wid * 9 + r) * 64 + lane] = a[r];
      __syncthreads();
      for (int idx = tid; idx < 9 * 64; idx += 256) {
        int r = idx >> 6, l = idx & 63;
        float v = red[(0 * 9 + r) * 64 + l] + red[(1 * 9 + r) * 64 + l] + red[(2 * 9 + r) * 64 + l] + red[(3 * 9 + r) * 64 + l];
        v += p.mod_b()[i * 6144 + cgp * 64 + l];
        p.modv()[((size_t)i * 9 + r) * 6144 + cgp * 64 + l] = v;
      }
      __syncthreads();
    }
  }
  if (blockIdx.x == gridDim.x - 1) {
    for (int idx = tid; idx < 1024; idx += 256) {
      int pos = idx >> 4, f = idx & 15;
      float inv = powf(10000.f, -(float)f / 16.f);
      float ang = (float)pos * inv;
      p.rope()[idx] = make_float2(cosf(ang), sinf(ang));
    }
  }
  wconv_loop(p, smem);
  {
    const float4* x4 = (const float4*)p.x(); const float4* c4 = (const float4*)p.ctx(); float4* h4 = (float4*)p.h();
    for (int idx = blockIdx.x * 256 + tid; idx < T * 256; idx += gridDim.x * 256)
      h4[idx] = idx < TL * 256 ? x4[idx] : c4[idx - TL * 256];
  }
}

__device__ void norm_phase(const Params& p, int layer, int which, int M) {
  const int tid = otid(), wid = tid >> 6, lane = tid & 63;
  const float* g = p.norm_g() + (layer * 2 + which) * 1024;
  const int stride = gridDim.x * 4;
  for (int row = blockIdx.x * 4 + wid; row < M; row += 2 * stride) {
    const int rowB = row + stride;
    const bool hasB = rowB < M;
    const int rB = hasB ? rowB : row;
    const float4* hpA = (const float4*)(p.h() + (size_t)row * 1024);
    const float4* hpB = (const float4*)(p.h() + (size_t)rB * 1024);
    float4 va[4], vb[4];
#pragma unroll
    for (int i = 0; i < 4; ++i) { va[i] = hpA[lane + 64 * i]; vb[i] = hpB[lane + 64 * i]; }
    float sa = 0.f, sb = 0.f;
#pragma unroll
    for (int i = 0; i < 4; ++i) {
      sa += va[i].x * va[i].x + va[i].y * va[i].y + va[i].z * va[i].z + va[i].w * va[i].w;
      sb += vb[i].x * vb[i].x + vb[i].y * vb[i].y + vb[i].z * vb[i].z + vb[i].w * vb[i].w;
    }
#pragma unroll
    for (int o = 32; o >= 1; o >>= 1) { sa += __shfl_xor(sa, o); sb += __shfl_xor(sb, o); }
    const float rstdA = rsqrtf(sa * (1.f / 1024.f) + EPS), rstdB = rsqrtf(sb * (1.f / 1024.f) + EPS);
    const int ra = row < TL ? row / SEQ : 8, rb = rB < TL ? rB / SEQ : 8;
    const float* mva = p.modv() + ((size_t)layer * 9 + ra) * 6144;
    const float* mvb = p.modv() + ((size_t)layer * 9 + rb) * 6144;
    const int so = (which ? 3 : 0) * 1024, co = (which ? 4 : 1) * 1024;
    uint2* opA = (uint2*)(p.nbuf() + (size_t)row * 1024);
    uint2* opB = (uint2*)(p.nbuf() + (size_t)rB * 1024);
#pragma unroll
    for (int i = 0; i < 4; ++i) {
      const int c4 = lane + 64 * i;
      const float4 gg = ((const float4*)g)[c4];
      {
        const float4 s4 = ((const float4*)(mva + co))[c4], h4 = ((const float4*)(mva + so))[c4];
        float y0 = va[i].x * rstdA * gg.x * (1.f + s4.x) + h4.x, y1 = va[i].y * rstdA * gg.y * (1.f + s4.y) + h4.y;
        float y2 = va[i].z * rstdA * gg.z * (1.f + s4.z) + h4.z, y3 = va[i].w * rstdA * gg.w * (1.f + s4.w) + h4.w;
        opA[c4] = make_uint2(pack2(y0, y1), pack2(y2, y3));
      }
      if (hasB) {
        const float4 s4 = ((const float4*)(mvb + co))[c4], h4 = ((const float4*)(mvb + so))[c4];
        float y0 = vb[i].x * rstdB * gg.x * (1.f + s4.x) + h4.x, y1 = vb[i].y * rstdB * gg.y * (1.f + s4.y) + h4.y;
        float y2 = vb[i].z * rstdB * gg.z * (1.f + s4.z) + h4.z, y3 = vb[i].w * rstdB * gg.w * (1.f + s4.w) + h4.w;
        opB[c4] = make_uint2(pack2(y0, y1), pack2(y2, y3));
      }
    }
  }
}

__device__ void final_phase(const Params& p) {
  const int tid = otid(), wid = tid >> 6, lane = tid & 63;
  for (int row = blockIdx.x * 4 + wid; row < TL; row += gridDim.x * 4) {
    const float4* hp = (const float4*)(p.h() + (size_t)row * 1024);
    float4 v[4];
    float ss = 0.f;
#pragma unroll
    for (int i = 0; i < 4; ++i) { v[i] = hp[lane + 64 * i]; ss += v[i].x * v[i].x + v[i].y * v[i].y + v[i].z * v[i].z + v[i].w * v[i].w; }
#pragma unroll
    for (int o = 32; o >= 1; o >>= 1) ss += __shfl_xor(ss, o);
    float rstd = rsqrtf(ss * (1.f / 1024.f) + EPS);
    float4* op = (float4*)(p.out() + (size_t)row * 1024);
#pragma unroll
    for (int i = 0; i < 4; ++i) {
      int c4 = lane + 64 * i;
      float4 gg = ((const float4*)p.final_g())[c4];
      float4 ov = make_float4(v[i].x * rstd * gg.x, v[i].y * rstd * gg.y, v[i].z * rstd * gg.z, v[i].w * rstd * gg.w);
      op[c4] = ov;
    }
  }
}

template <int K, int EPI>
__device__ __forceinline__ void gemm_run(const Params& p, const u16* __restrict__ A, const u16* __restrict__ Bt,
                          int Mt, int Nt, int layer, int gidx, const float* __restrict__ bias, char* smem) {
  const int tid = otid(), wid = tid >> 6, lane = tid & 63, wr = wid >> 1, wc = wid & 1, fr = lane & 15, fq = lane >> 4;
  const int xcd = blockIdx.x & 7, rank = blockIdx.x >> 3, rpx = gridDim.x >> 3;
  const int SN = (Nt & 7) == 0 ? 8 : 4, SM = 64 / SN;
  const int nsn = Nt / SN, total_s = (Mt / SM) * nsn;
  const int cq = rank < 64 ? (64 - rank + rpx - 1) / rpx : 0;
  const int nsx = xcd < total_s ? (total_s - xcd + 7) / 8 : 0;
  const int ntile = cq * nsx;
  if (ntile == 0) return;
#define TILE_MN(i_, mt_, nt_)                                              \
  {                                                                        \
    const int si_ = (i_) / cq, qi_ = (i_) - si_ * cq;                      \
    const int sidx_ = xcd + 8 * si_, q_ = rank + rpx * qi_;                \
    const int ms_ = sidx_ / nsn, ns_ = sidx_ - ms_ * nsn;                  \
    mt_ = ms_ * SM + q_ / SN;                                              \
    nt_ = ns_ * SN + q_ % SN;                                              \
  }
  constexpr int nk = K / 64;
  const int lrow = tid >> 3, lc = tid & 7;
  const int toff = lrow * K + lc * 8;
  const int loff = tile_off(lrow, lc);
  const int aoff = tile_off(wr * 64 + fr, fq);
  const int boff = tile_off(wc * 64 + fr, fq);
  u32x4 ra0_0, ra1_0, ra2_0, ra3_0, rb0_0, rb1_0, rb2_0, rb3_0;
#define GLD(dst, ptr) dst = *(const u32x4*)(ptr)
#define G_LOAD(S, ko)                          \
  GLD(ra0_##S, pa + 0 * 32 * K + (ko));        \
  GLD(ra1_##S, pa + 1 * 32 * K + (ko));        \
  GLD(ra2_##S, pa + 2 * 32 * K + (ko));        \
  GLD(ra3_##S, pa + 3 * 32 * K + (ko));        \
  GLD(rb0_##S, pb + 0 * 32 * K + (ko));        \
  GLD(rb1_##S, pb + 1 * 32 * K + (ko));        \
  GLD(rb2_##S, pb + 2 * 32 * K + (ko));        \
  GLD(rb3_##S, pb + 3 * 32 * K + (ko));
#define VMWAIT(N, S)
#define L_STORE(S, base)                                                \
  *(u32x4*)((base) + loff + 0 * 4096) = ra0_##S;                          \
  *(u32x4*)((base) + loff + 1 * 4096) = ra1_##S;                          \
  *(u32x4*)((base) + loff + 2 * 4096) = ra2_##S;                          \
  *(u32x4*)((base) + loff + 3 * 4096) = ra3_##S;                          \
  *(u32x4*)((base) + 16384 + loff + 0 * 4096) = rb0_##S;                  \
  *(u32x4*)((base) + 16384 + loff + 1 * 4096) = rb1_##S;                  \
  *(u32x4*)((base) + 16384 + loff + 2 * 4096) = rb2_##S;                  \
  *(u32x4*)((base) + 16384 + loff + 3 * 4096) = rb3_##S;
#define DMA1(sbase, m0v) asm volatile("s_mov_b32 m0, %2\n\ts_nop 0\n\tglobal_load_lds_dwordx4 %0, %1" ::"v"(dvoff), "s"(sbase), "s"(m0v) : "memory", "m0")
#define DMA_LOAD(sb, ko)                                   \
  DMA1(Au + 0 * 32 * K + (ko), (sb) + 0 * 4096);           \
  DMA1(Au + 1 * 32 * K + (ko), (sb) + 1 * 4096);           \
  DMA1(Au + 2 * 32 * K + (ko), (sb) + 2 * 4096);           \
  DMA1(Au + 3 * 32 * K + (ko), (sb) + 3 * 4096);           \
  DMA1(Bu + 0 * 32 * K + (ko), (sb) + 16384 + 0 * 4096);   \
  DMA1(Bu + 1 * 32 * K + (ko), (sb) + 16384 + 1 * 4096);   \
  DMA1(Bu + 2 * 32 * K + (ko), (sb) + 16384 + 2 * 4096);   \
  DMA1(Bu + 3 * 32 * K + (ko), (sb) + 16384 + 3 * 4096);
#define MMA_TILE(As_, Bs_)                                                                        \
  __builtin_amdgcn_s_setprio(1);                                                                  \
  _Pragma("unroll") for (int ks = 0; ks < 2; ++ks) {                                              \
    bf16x8 af[4], bfr[4];                                                                         \
    _Pragma("unroll") for (int mi = 0; mi < 4; ++mi) af[mi] = *(const bf16x8*)((As_) + (aoff ^ (ks << 6)) + mi * 2048);  \
    _Pragma("unroll") for (int ni = 0; ni < 4; ++ni) bfr[ni] = *(const bf16x8*)((Bs_) + (boff ^ (ks << 6)) + ni * 2048); \
    _Pragma("unroll") for (int mi = 0; mi < 4; ++mi)                                              \
      _Pragma("unroll") for (int ni = 0; ni < 4; ++ni)                                            \
        acc[mi][ni] = __builtin_amdgcn_mfma_f32_16x16x32_bf16(af[mi], bfr[ni], acc[mi][ni], 0, 0, 0); \
  }                                                                                               \
  __builtin_amdgcn_s_setprio(0);
  int mt, nt;
  TILE_MN(0, mt, nt)
  const u16* pa = A + (size_t)mt * 128 * K + toff;
  const u16* pb = Bt + (size_t)nt * 128 * K + toff;
  G_LOAD(0, 0)
#pragma unroll 1
  for (int ti = 0; ti < ntile; ++ti) {
  const int brow = mt * 128, bcol = nt * 128;
  f32x4 acc[4][4];
#pragma unroll
  for (int i = 0; i < 4; ++i)
#pragma unroll
    for (int j = 0; j < 4; ++j) acc[i][j] = f32x4{0.f, 0.f, 0.f, 0.f};
  L_STORE(0, smem)
  __syncthreads();
  {
    const unsigned dvoff = (unsigned)(lrow * K + ((lc ^ lrow) & 7) * 8) * 2u;
    const u16* Au = A + (size_t)mt * 128 * K;
    const u16* Bu = Bt + (size_t)nt * 128 * K;
    const unsigned sm0 = __builtin_amdgcn_readfirstlane((unsigned)(size_t)smem) + __builtin_amdgcn_readfirstlane(wid) * 1024u;
#pragma unroll 2
    for (int kt = 0; kt < nk; ++kt) {
      const int cur = kt & 1;
      if (kt + 1 < nk) {
        const unsigned sb = sm0 + (unsigned)(cur ^ 1) * 32768u;
        DMA_LOAD(sb, (kt + 1) * 64)
      }
      __builtin_amdgcn_sched_barrier(0);
      MMA_TILE(smem + cur * 32768, smem + cur * 32768 + 16384)
      __builtin_amdgcn_sched_barrier(0);
      asm volatile("s_waitcnt vmcnt(0)" ::: "memory");
      __syncthreads();
    }
  }
  int mt2 = mt, nt2 = nt;
  if (ti + 1 < ntile) {
    TILE_MN(ti + 1, mt2, nt2)
    pa = A + (size_t)mt2 * 128 * K + toff;
    pb = Bt + (size_t)nt2 * 128 * K + toff;
    if constexpr (EPI != 1) { G_LOAD(0, 0) }
  }
  __builtin_amdgcn_sched_barrier(0);
  const int r0 = brow + wr * 64;
  char* stg = smem + wid * 16384;
  if constexpr (EPI == 0 || EPI == 3) {
    const int OW = (EPI == 0) ? 1024 : FH;
    u16* outp = p.big();
    const int jch0 = (bcol + wc * 64) >> 1;
#pragma unroll
    for (int pp = 0; pp < 2; ++pp) {
      float b0 = 0.f, b1 = 0.f;
      if (bias) { b0 = bias[jch0 + pp * 16 + fr]; b1 = bias[1024 + jch0 + pp * 16 + fr]; }
#pragma unroll
      for (int mi = 0; mi < 4; ++mi)
#pragma unroll
        for (int j = 0; j < 4; ++j) {
          float a = acc[mi][2 * pp][j] + b0, g = acc[mi][2 * pp + 1][j] + b1;
          float sg = sigmoidf_(EPI == 0 ? g : a);
          float v = (EPI == 0) ? a * sg : a * sg * g;
          *(u16*)(stg + (mi * 16 + fq * 4 + j) * 80 + (pp * 16 + fr) * 2) = f2bf(v);
        }
    }
    __syncthreads();
#pragma unroll
    for (int it = 0; it < 4; ++it) {
      const int row = it * 16 + (lane >> 2), ch = lane & 3;
      u32x4 val = *(const u32x4*)(stg + row * 80 + ch * 16);
      *(u32x4*)(outp + (size_t)(r0 + row) * OW + jch0 + ch * 8) = val;
    }
    __syncthreads();
  } else if constexpr (EPI == 2) {
    float* sf = (float*)stg;
#pragma unroll
    for (int mi = 0; mi < 4; ++mi)
#pragma unroll
      for (int ni = 0; ni < 4; ++ni)
#pragma unroll
        for (int j = 0; j < 4; ++j) sf[(mi * 16 + fq * 4 + j) * 64 + ((ni ^ fq) << 4) + fr] = acc[mi][ni][j];
    __syncthreads();
    {
      const int r = brow < TL ? brow / SEQ : 8;
      const int c = lane & 15, rsub = lane >> 4;
      const int col0 = bcol + wc * 64 + c * 4;
      const float4 g4 = *(const float4*)(p.modv() + ((size_t)layer * 9 + r) * 6144 + gidx * 1024 + col0);
      float4 b4 = make_float4(0.f, 0.f, 0.f, 0.f);
      if (bias) b4 = *(const float4*)(bias + col0);
      float* hrow = p.h() + (size_t)(r0 + rsub) * 1024 + col0;
      const float* srow = sf + rsub * 64 + (c & 3) * 4;
#pragma unroll 1
      for (int it4 = 0; it4 < 4; ++it4) {
#pragma unroll
        for (int u = 0; u < 4; ++u) {
          const int grp = (c >> 2) ^ u;
          const float4 a4 = *(const float4*)(srow + u * 256 + grp * 16);
          float4* hp = (float4*)(hrow + u * 4096);
          float4 hv = *hp;
          hv.x += g4.x * (a4.x + b4.x); hv.y += g4.y * (a4.y + b4.y); hv.z += g4.z * (a4.z + b4.z); hv.w += g4.w * (a4.w + b4.w);
          *hp = hv;
        }
        hrow += 16 * 1024;
        srow += 16 * 64;
      }
    }
    __syncthreads();
  } else {
    const int region = nt >> 3, hd = nt & 7;
    const bool lat = brow < TL;
    const int b = lat ? brow / SEQ : (brow - TL) / CTX;
    const int kb = lat ? 256 + (r0 - b * SEQ) : (r0 - TL - b * CTX);
    const size_t bh = (size_t)(b * 8 + hd);
    u16* qb = p.big(); u16* kbuf = p.big() + (size_t)T * 1024; u16* vt = p.big() + (size_t)T * 2048;
    if (region < 2) {
      u16* dst = (region == 0 ? qb : kbuf) + ((bh * 2 + wc) * KEYS + kb) * 64;
      const float qs = region == 0 ? 0.125f * 1.44269504088896f : 1.f;
#pragma unroll
      for (int mi = 0; mi < 4; ++mi)
#pragma unroll
        for (int j = 0; j < 4; ++j) {
          int rl = mi * 16 + fq * 4 + j;
          float x0 = acc[mi][0][j], x1 = acc[mi][1][j], x2 = acc[mi][2][j], x3 = acc[mi][3][j];
          if (lat) {
            int t = kb - 256 + rl;
            float2 cr = p.rope()[(t >> 6) * 16 + fr], cc = p.rope()[(t & 63) * 16 + fr];
            float y0 = x0 * cr.x - x1 * cr.y, y1 = x1 * cr.x + x0 * cr.y;
            float y2 = x2 * cc.x - x3 * cc.y, y3 = x3 * cc.x + x2 * cc.y;
            x0 = y0; x1 = y1; x2 = y2; x3 = y3;
          }
          char* sp = stg + rl * 144 + fr * 2;
          *(u16*)(sp) = f2bf(x0 * qs); *(u16*)(sp + 32) = f2bf(x1 * qs); *(u16*)(sp + 64) = f2bf(x2 * qs); *(u16*)(sp + 96) = f2bf(x3 * qs);
          if (j == 3) asm volatile("" ::: "memory");
        }
      __syncthreads();
#pragma unroll
      for (int it = 0; it < 8; ++it) {
        const int row = it * 8 + (lane >> 3), ch = lane & 7;
        u32x4 val = *(const u32x4*)(stg + row * 144 + ch * 16);
        *(u32x4*)(dst + (size_t)row * 64 + ch * 8) = val;
      }
      __syncthreads();
    } else {
#pragma unroll
      for (int ni = 0; ni < 4; ++ni) {
        const int e = ni * 16 + fr;
#pragma unroll
        for (int mi = 0; mi < 4; ++mi) {
          int slot = (mi >> 1) * 32 + fq * 8 + (mi & 1) * 4;
          *(uint2*)(stg + e * 144 + slot * 2) = make_uint2(pack2(acc[mi][ni][0], acc[mi][ni][1]), pack2(acc[mi][ni][2], acc[mi][ni][3]));
        }
      }
      __syncthreads();
      u16* dp = vt + (bh * 128 + wc * 64) * KEYS + kb;
#pragma unroll
      for (int it = 0; it < 8; ++it) {
        const int row = it * 8 + (lane >> 3), ch = lane & 7;
        u32x4 val = *(const u32x4*)(stg + row * 144 + ch * 16);
        *(u32x4*)(dp + (size_t)row * KEYS + ch * 8) = val;
      }
      __syncthreads();
    }
  }
  if constexpr (EPI == 1) { if (ti + 1 < ntile) { G_LOAD(0, 0) } }
  mt = mt2; nt = nt2;
  }
#undef GLD
#undef VMWAIT
#undef G_LOAD
#undef L_STORE
#undef MMA_TILE
#undef DMA1
#undef DMA_LOAD
#undef TILE_MN
}

__device__ void gemm_phase(const Params& p, const u16* A, const u16* Bt, int K, int Mt, int Nt, int epi, int layer, int gidx,
                           const float* bias, char* smem) {
  if (K != 1024) gemm_run<FH, 2>(p, A, Bt, Mt, Nt, layer, gidx, bias, smem);
  else if (epi == 0) gemm_run<1024, 0>(p, A, Bt, Mt, Nt, layer, gidx, bias, smem);
  else if (epi == 1) gemm_run<1024, 1>(p, A, Bt, Mt, Nt, layer, gidx, bias, smem);
  else if (epi == 2) gemm_run<1024, 2>(p, A, Bt, Mt, Nt, layer, gidx, bias, smem);
  else gemm_run<1024, 3>(p, A, Bt, Mt, Nt, layer, gidx, bias, smem);
}

__device__ void conv_phase(const Params& p, int j, int M, char* smem) {
  const int tid = otid(), wid = tid >> 6, lane = tid & 63;
  float* cbuf = (float*)smem;
  const u16* U = p.big();
  for (int item = blockIdx.x; item < M / 8; item += gridDim.x) {
    const int t0 = item * 8;
    int s0, s1;
    if (t0 < TL) { s0 = (t0 / SEQ) * SEQ; s1 = s0 + SEQ; } else { s0 = TL + ((t0 - TL) / CTX) * CTX; s1 = s0 + CTX; }
#pragma unroll 1
    for (int g = 0; g < 2; ++g) {
      const int c = g * 512 + tid * 2;
      float acc[8][2];
      float w[31][2];
#pragma unroll
      for (int k = 0; k < 31; ++k) { float2 wv = *(const float2*)(p.dw_w() + ((size_t)j * 31 + k) * 1024 + c); w[k][0] = wv.x; w[k][1] = wv.y; }
      float2 bv = *(const float2*)(p.dw_b() + j * 1024 + c);
#pragma unroll
      for (int o = 0; o < 8; ++o) { acc[o][0] = bv.x; acc[o][1] = bv.y; }
#pragma unroll
      for (int ti = 0; ti < 38; ++ti) {
        int tin = t0 - 15 + ti;
        bool valid = tin >= s0 && tin < s1;
        int tc = min(max(tin, s0), s1 - 1);
        unsigned raw = *(const unsigned*)(U + (size_t)tc * 1024 + c);
        if (!valid) raw = 0u;
        float x0 = bf2f(raw & 0xffffu), x1 = bf2f(raw >> 16);
#pragma unroll
        for (int o = 0; o < 8; ++o) {
          const int k = ti - o;
          if (k >= 0 && k < 31) { acc[o][0] += x0 * w[k][0]; acc[o][1] += x1 * w[k][1]; }
        }
      }
#pragma unroll
      for (int o = 0; o < 8; ++o) *(float2*)(cbuf + o * 1024 + c) = make_float2(acc[o][0], acc[o][1]);
    }
    __syncthreads();
#pragma unroll
    for (int tt = 0; tt < 2; ++tt) {
      const int o = wid * 2 + tt;
      float4 v[4];
      float sm = 0.f;
#pragma unroll
      for (int i = 0; i < 4; ++i) { v[i] = *(const float4*)(cbuf + o * 1024 + (lane + 64 * i) * 4); sm += v[i].x + v[i].y + v[i].z + v[i].w; }
#pragma unroll
      for (int sh = 32; sh >= 1; sh >>= 1) sm += __shfl_xor(sm, sh);
      const float mean = sm * (1.f / 1024.f);
      float sq = 0.f;
#pragma unroll
      for (int i = 0; i < 4; ++i) {
        v[i].x -= mean; v[i].y -= mean; v[i].z -= mean; v[i].w -= mean;
        sq += v[i].x * v[i].x + v[i].y * v[i].y + v[i].z * v[i].z + v[i].w * v[i].w;
      }
#pragma unroll
      for (int sh = 32; sh >= 1; sh >>= 1) sq += __shfl_xor(sq, sh);
      const float rstd = rsqrtf(sq * (1.f / 1024.f) + EPS);
      uint2* op = (uint2*)(p.vbuf() + (size_t)(t0 + o) * 1024);
#pragma unroll
      for (int i = 0; i < 4; ++i) {
        int c4 = lane + 64 * i;
        float4 lg = ((const float4*)(p.ln_g() + j * 1024))[c4], lb = ((const float4*)(p.ln_b() + j * 1024))[c4];
        float y0 = v[i].x * rstd * lg.x + lb.x, y1 = v[i].y * rstd * lg.y + lb.y;
        float y2 = v[i].z * rstd * lg.z + lb.z, y3 = v[i].w * rstd * lg.w + lb.w;
        y0 *= sigmoidf_(y0); y1 *= sigmoidf_(y1); y2 *= sigmoidf_(y2); y3 *= sigmoidf_(y3);
        op[c4] = make_uint2(pack2(y0, y1), pack2(y2, y3));
      }
    }
    __syncthreads();
  }
}

__device__ void attn_item(const Params& p, int b, int hd, int q0, int nkeys, int out_row0, float lam, float oscale,
                          const float* __restrict__ subg, char* smem) {
  const int tid = otid(), wid = tid >> 6, lane = tid & 63, fr = lane & 15, fq = lane >> 4;
  const int comp = wid & 1, qg = wid >> 1;
  const size_t bh = (size_t)(b * 8 + hd);
  const u16* qb = p.big(); const u16* kbuf = p.big() + (size_t)T * 1024; const u16* vtb = p.big() + (size_t)T * 2048;
  const u16* Qp = qb + ((bh * 2 + comp) * KEYS + q0 + qg * 32) * 64;
  bf16x8 qf[2][2];
#pragma unroll
  for (int qs = 0; qs < 2; ++qs)
#pragma unroll
    for (int ks = 0; ks < 2; ++ks) qf[qs][ks] = *(const bf16x8*)(Qp + (qs * 16 + fr) * 64 + ks * 32 + fq * 8);
  const u16* K1p = kbuf + (bh * 2 + 0) * KEYS * 64;
  const u16* K2p = kbuf + (bh * 2 + 1) * KEYS * 64;
  const u16* Vp = vtb + bh * 128 * KEYS;
  const int lrow = tid >> 3, lc = tid & 7;
  const unsigned swz8 = (unsigned)(((lc ^ lrow) & 7) * 8);
  const unsigned dvk = (unsigned)(lrow * 64) * 2u + swz8 * 2u;
  const unsigned dvv = (unsigned)(lrow * KEYS) * 2u + swz8 * 2u;
  const unsigned sm0 = __builtin_amdgcn_readfirstlane((unsigned)(size_t)smem) + __builtin_amdgcn_readfirstlane(wid) * 1024u;
#define ADMA(voff, sbase, m0v) asm volatile("s_mov_b32 m0, %2\n\ts_nop 0\n\tglobal_load_lds_dwordx4 %0, %1" ::"v"(voff), "s"(sbase), "s"(m0v) : "memory", "m0")
#define ATT_DMA(kt_, buf_)                                                                     \
  {                                                                                            \
    const int key0 = (kt_) * 64;                                                               \
    const unsigned sb_ = sm0 + (unsigned)(buf_) * 32768u;                                      \
    ADMA(dvk, K1p + (size_t)(key0) * 64, sb_);                                                 \
    ADMA(dvk, K1p + (size_t)(key0 + 32) * 64, sb_ + 4096u);                                    \
    ADMA(dvk, K2p + (size_t)(key0) * 64, sb_ + 8192u);                                         \
    ADMA(dvk, K2p + (size_t)(key0 + 32) * 64, sb_ + 12288u);                                   \
    ADMA(dvv, Vp + key0, sb_ + 16384u);                                                        \
    ADMA(dvv, Vp + (size_t)32 * KEYS + key0, sb_ + 20480u);                                    \
    ADMA(dvv, Vp + (size_t)64 * KEYS + key0, sb_ + 24576u);                                    \
    ADMA(dvv, Vp + (size_t)96 * KEYS + key0, sb_ + 28672u);                                    \
  }
  f32x4 O[8][2];
#pragma unroll
  for (int e = 0; e < 8; ++e) { O[e][0] = f32x4{0.f, 0.f, 0.f, 0.f}; O[e][1] = f32x4{0.f, 0.f, 0.f, 0.f}; }
  float m[2] = {-1e30f, -1e30f}, l[2] = {0.f, 0.f};
  const int ntile = nkeys >> 6;
  ATT_DMA(0, 0)
  asm volatile("s_waitcnt vmcnt(0)" ::: "memory");
  __syncthreads();
  for (int kt = 0; kt < ntile; ++kt) {
    const int cur = kt & 1;
    if (kt + 1 < ntile) ATT_DMA(kt + 1, cur ^ 1)
    const char* base = smem + cur * 32768;
    const char* Kc = base + comp * 8192;
    const char* Vt = base + 16384;
    f32x4 S[4][2];
#pragma unroll
    for (int i = 0; i < 4; ++i) { S[i][0] = f32x4{0.f, 0.f, 0.f, 0.f}; S[i][1] = f32x4{0.f, 0.f, 0.f, 0.f}; }
    __builtin_amdgcn_s_setprio(1);
#pragma unroll
    for (int ks = 0; ks < 2; ++ks)
#pragma unroll
      for (int ksub = 0; ksub < 4; ++ksub) {
        bf16x8 kf = *(const bf16x8*)(Kc + tile_off(ksub * 16 + fr, ks * 4 + fq));
#pragma unroll
        for (int qs = 0; qs < 2; ++qs) S[ksub][qs] = __builtin_amdgcn_mfma_f32_16x16x32_bf16(kf, qf[qs][ks], S[ksub][qs], 0, 0, 0);
      }
    __builtin_amdgcn_s_setprio(0);
#pragma unroll
    for (int qs = 0; qs < 2; ++qs) {
      float mx = -1e30f;
#pragma unroll
      for (int ksub = 0; ksub < 4; ++ksub)
#pragma unroll
        for (int j = 0; j < 4; ++j) mx = fmaxf(mx, S[ksub][qs][j]);
      mx = fmaxf(mx, __shfl_xor(mx, 16));
      mx = fmaxf(mx, __shfl_xor(mx, 32));
      float mn = fmaxf(m[qs], mx);
      float alpha = fexp2(m[qs] - mn);
      m[qs] = mn;
      float rs = 0.f;
#pragma unroll
      for (int ksub = 0; ksub < 4; ++ksub)
#pragma unroll
        for (int j = 0; j < 4; ++j) { float pv = fexp2(S[ksub][qs][j] - mn); S[ksub][qs][j] = pv; rs += pv; }
      l[qs] = l[qs] * alpha + rs;
      if (__builtin_amdgcn_ballot_w64(alpha != 1.f) != 0) {
#pragma unroll
        for (int e = 0; e < 8; ++e) O[e][qs] *= alpha;
      }
    }
    bf16x8 pf[2][2];
#pragma unroll
    for (int qs = 0; qs < 2; ++qs)
#pragma unroll
      for (int s = 0; s < 2; ++s) {
        unsigned u0 = pack2(S[2 * s][qs][0], S[2 * s][qs][1]), u1 = pack2(S[2 * s][qs][2], S[2 * s][qs][3]);
        unsigned u2 = pack2(S[2 * s + 1][qs][0], S[2 * s + 1][qs][1]), u3 = pack2(S[2 * s + 1][qs][2], S[2 * s + 1][qs][3]);
        uint4 uu = make_uint4(u0, u1, u2, u3);
        pf[qs][s] = *(bf16x8*)&uu;
      }
    __builtin_amdgcn_s_setprio(1);
#pragma unroll
    for (int s = 0; s < 2; ++s)
#pragma unroll
      for (int e = 0; e < 8; ++e) {
        bf16x8 vf = *(const bf16x8*)(Vt + tile_off(e * 16 + fr, s * 4 + fq));
#pragma unroll
        for (int qs = 0; qs < 2; ++qs) O[e][qs] = __builtin_amdgcn_mfma_f32_16x16x32_bf16(vf, pf[qs][s], O[e][qs], 0, 0, 0);
      }
    __builtin_amdgcn_s_setprio(0);
    asm volatile("s_waitcnt vmcnt(0)" ::: "memory");
    __syncthreads();
  }
#undef ATT_DMA
#undef ADMA
#pragma unroll
  for (int qs = 0; qs < 2; ++qs) {
    float ls = l[qs];
    ls += __shfl_xor(ls, 16);
    ls += __shfl_xor(ls, 32);
    float inv = (comp ? lam : 1.f) / ls;
#pragma unroll
    for (int e = 0; e < 8; ++e) O[e][qs] *= inv;
  }
  float* ex = (float*)smem;
  if (comp == 1) {
#pragma unroll
    for (int e = 0; e < 8; ++e)
#pragma unroll
      for (int qs = 0; qs < 2; ++qs) *(f32x4*)(ex + ((((qg * 8 + e) * 2 + qs) * 64 + lane) << 2)) = O[e][qs];
  }
  __syncthreads();
  if (comp == 0) {
#pragma unroll
    for (int qs = 0; qs < 2; ++qs) {
      float ssq = 0.f;
#pragma unroll
      for (int e = 0; e < 8; ++e) {
        f32x4 o2 = *(const f32x4*)(ex + ((((qg * 8 + e) * 2 + qs) * 64 + lane) << 2));
        O[e][qs] -= o2;
#pragma unroll
        for (int j = 0; j < 4; ++j) ssq += O[e][qs][j] * O[e][qs][j];
      }
      ssq += __shfl_xor(ssq, 16);
      ssq += __shfl_xor(ssq, 32);
      float rstd = rsqrtf(ssq * (1.f / 128.f) + EPS) * oscale;
      u16* op = p.vbuf() + (size_t)(out_row0 + qg * 32 + qs * 16 + fr) * 1024 + hd * 128 + fq * 4;
#pragma unroll
      for (int e = 0; e < 8; ++e) {
        float4 sg = *(const float4*)(subg + e * 16 + fq * 4);
        *(uint2*)(op + e * 16) = make_uint2(pack2(O[e][qs][0] * rstd * sg.x, O[e][qs][1] * rstd * sg.y),
                                            pack2(O[e][qs][2] * rstd * sg.z, O[e][qs][3] * rstd * sg.w));
      }
    }
  }
  __syncthreads();
}

__device__ void attn_phase(const Params& p, int layer, bool with_ctx, char* smem) {
  const int ja = layer >> 1;
  const float* lv = p.lam() + ja * 256;
  float d01 = 0.f, d23 = 0.f;
  for (int i = 0; i < 64; ++i) { d01 += lv[i] * lv[64 + i]; d23 += lv[128 + i] * lv[192 + i]; }
  const float lam_init = 0.8f - 0.6f * expf(-0.3f * (float)layer);
  const float lam = expf(d01) - expf(d23) + lam_init;
  const float* subg = p.subln() + ja * 128;
  {
    const int xcd = blockIdx.x & 7, rank = blockIdx.x >> 3, rpx = gridDim.x >> 3;
    for (int r = 0; r < 4; ++r)
      for (int q = rank; q < 64; q += rpx) {
        const int bh = r * 16 + xcd * 2 + (q >> 5), qt = q & 31;
        const int b = bh >> 3, hd = bh & 7;
        attn_item(p, b, hd, 256 + qt * 64, KEYS, b * SEQ + qt * 64, lam, 1.f - lam_init, subg, smem);
      }
  }
  if (with_ctx) {
    for (int it = blockIdx.x; it < 256; it += gridDim.x) {
      const int qt = it & 3, hd = (it >> 2) & 7, b = it >> 5;
      attn_item(p, b, hd, qt * 64, CTX, TL + b * CTX + qt * 64, lam, 1.f - lam_init, subg, smem);
    }
  }
}

__device__ void run_phase(const Params& p, int ph_in, char* smem) {
  const int ph = ph_in & 0xffff; const bool noepi = (ph_in >> 16) != 0;
  if (ph == 0) { prologue_phase(p, smem); return; }
  if (ph == NPH - 1) { final_phase(p); return; }
  const int layer = (ph - 1) / 7, sub = (ph - 1) % 7;
  const bool last = layer == DEPTH - 1;
  const int M = last ? TL : T;
  const bool is_conv = (layer & 1) == 0;
  const int j = layer >> 1;
  if (sub == 0 || sub == 4) { norm_phase(p, layer, sub == 4 ? 1 : 0, sub == 0 ? T : M); return; }
  if (sub == 2) {
    if (is_conv) conv_phase(p, j, T, smem);
    else attn_phase(p, layer, !last, smem);
    return;
  }
  const u16 *A, *Bt; int K = 1024, Nt, epi, gidx = 0, mtiles = M / 128; const float* bias = nullptr;
  if (sub == 1) {
    A = p.nbuf(); mtiles = T / 128;
    if (is_conv) { Bt = p.w_pw1() + (size_t)j * 2048 * 1024; Nt = 16; epi = 0; bias = p.pw1_b() + j * 2048; }
    else { Bt = p.w_qkv() + (size_t)j * 3072 * 1024; Nt = 24; epi = 1; }
  } else if (sub == 3) {
    A = p.vbuf(); Nt = 8; epi = 2; gidx = 2;
    if (is_conv) { Bt = p.w_pw2() + (size_t)j * 1024 * 1024; bias = p.pw2_b() + j * 1024; }
    else Bt = p.w_o() + (size_t)j * 1024 * 1024;
  } else if (sub == 5) {
    A = p.nbuf(); Bt = p.w_fin() + (size_t)layer * 5632 * 1024; Nt = 44; epi = 3;
  } else {
    A = p.big(); Bt = p.w_fout() + (size_t)layer * 1024 * FH; K = FH; Nt = 8; epi = 2; gidx = 5;
  }
  gemm_phase(p, A, Bt, K, mtiles, Nt, epi, layer, gidx, bias, smem);
}

__device__ __forceinline__ unsigned xcc_id() { return (unsigned)__builtin_amdgcn_s_getreg((3 << 11) | 20) & 0xFu; }
__device__ __forceinline__ void grid_barrier(unsigned* bar, unsigned xcc, unsigned k, unsigned nloc, unsigned nx) {
  __syncthreads();
  if (threadIdx.x == 0) {
    unsigned a = __hip_atomic_fetch_add(&bar[1024 + xcc * 64], 1u, __ATOMIC_RELAXED, __HIP_MEMORY_SCOPE_AGENT) + 1u;
    if (a == k * nloc) {
      __builtin_amdgcn_fence(__ATOMIC_RELEASE, "agent");
      asm volatile("s_waitcnt vmcnt(0)" ::: "memory");
      __hip_atomic_fetch_add(&bar[2048], 1u, __ATOMIC_RELAXED, __HIP_MEMORY_SCOPE_AGENT);
    }
    while (__hip_atomic_load(&bar[2048], __ATOMIC_RELAXED, __HIP_MEMORY_SCOPE_AGENT) < k * nx) __builtin_amdgcn_s_sleep(2);
    __builtin_amdgcn_fence(__ATOMIC_ACQUIRE, "agent");
    asm volatile("s_waitcnt vmcnt(0)" ::: "memory");
  }
  __syncthreads();
}

__global__ void __launch_bounds__(256, 2) mega(Params p, int ph_begin, int ph_end, int use_sync) {
  __shared__ __attribute__((aligned(16))) char smem[65536];
  __shared__ unsigned s_cnt[2];
  cg::grid_group grid = cg::this_grid();
  unsigned* bar = (unsigned*)(p.ws + WS_NEED);
  const unsigned xcc = xcc_id();
  if (use_sync && threadIdx.x == 0) __hip_atomic_fetch_add(&bar[xcc * 64], 1u, __ATOMIC_RELAXED, __HIP_MEMORY_SCOPE_AGENT);
  unsigned k = 0, nloc = 1, nx = 1;
  for (int ph = ph_begin; ph < ph_end; ++ph) {
    run_phase(p, ph, smem);
#ifdef DUP_MASK
    if (ph > ph_begin) {
      const int sub = (ph >= 1 && ph < NPH - 1) ? (ph - 1) % 7 : -1, layer = (ph - 1) / 7;
      bool dup = false;
      if ((DUP_MASK & 1) && sub == 2 && (layer & 1)) dup = true;
      if ((DUP_MASK & 2) && (sub == 1 || sub == 5)) dup = true;
      if ((DUP_MASK & 4) && sub == 2 && !(layer & 1)) dup = true;
      if ((DUP_MASK & 8) && (sub == 0 || sub == 4)) dup = true;
      if (dup) { ++k; grid_barrier(bar, xcc, k, nloc, nx); run_phase(p, ph | DUP_FLAG, smem); }
    }
#endif
    if (use_sync && ph + 1 < ph_end) {
      if (ph == ph_begin) {
        grid.sync();
        if (threadIdx.x == 0) {
          unsigned cnt = 0;
          for (int j = 0; j < 16; ++j) cnt += __hip_atomic_load(&bar[j * 64], __ATOMIC_RELAXED, __HIP_MEMORY_SCOPE_AGENT) ? 1u : 0u;
          s_cnt[0] = __hip_atomic_load(&bar[xcc * 64], __ATOMIC_RELAXED, __HIP_MEMORY_SCOPE_AGENT);
          s_cnt[1] = cnt;
        }
        __syncthreads();
        nloc = __builtin_amdgcn_readfirstlane(s_cnt[0]); nx = __builtin_amdgcn_readfirstlane(s_cnt[1]);
      } else {
        ++k;
        grid_barrier(bar, xcc, k, nloc, nx);
      }
    }
  }
}

extern "C" void kernel_launch(void* const* d_in, const int* in_sizes, int n_in, void* d_out, int out_size, void* d_ws,
                              size_t ws_size, hipStream_t stream) {
  Params p{};
  for (int i = 0; i < 22; ++i) p.in[i] = (const float*)d_in[i];
  p.outp = (float*)d_out;
  p.ws = (char*)d_ws;
  if (WS_NEED + 16384 > ws_size || n_in < 22) return;
  static int grid_blocks = 0;
  if (!grid_blocks) {
    int dev = 0, cus = 0, per_cu = 0;
    hipGetDevice(&dev);
    hipDeviceGetAttribute(&cus, hipDeviceAttributeMultiprocessorCount, dev);
    hipOccupancyMaxActiveBlocksPerMultiprocessor(&per_cu, mega, 256, 0);
    if (per_cu > 2) per_cu = 2;
    if (per_cu < 1) per_cu = 1;
    grid_blocks = cus * per_cu;
  }
#if MULTI_LAUNCH
  for (int ph = 0; ph < NPH; ++ph) mega<<<grid_blocks, 256, 0, stream>>>(p, ph, ph + 1, 0);
#else
  hipMemsetAsync((char*)d_ws + WS_NEED, 0, 16384, stream);
  int b = 0, e = NPH, s = 1;
  void* args[] = {&p, &b, &e, &s};
  hipError_t err = hipLaunchCooperativeKernel((void*)mega, dim3(grid_blocks), dim3(256), args, 0, stream);
  if (err != hipSuccess) fprintf(stderr, "cooperative launch failed: %s (grid %d)\n", hipGetErrorString(err), grid_blocks);
#endif
}
```

```cpp
#include <hip/hip_runtime.h>
#include <hip/hip_cooperative_groups.h>
#include <cstdio>
namespace cg = cooperative_groups;

#ifndef DUP_FLAG
#define DUP_FLAG 0
#endif
#ifndef MULTI_LAUNCH
#define MULTI_LAUNCH 0
#endif

typedef unsigned short u16;
using bf16x8 = __attribute__((ext_vector_type(8))) short;
using f32x4 = __attribute__((ext_vector_type(4))) float;
using u32x4 = __attribute__((ext_vector_type(4))) unsigned;

constexpr int D = 1024, NB = 8, SEQ = 2048, CTX = 256, DEPTH = 4;
constexpr int TL = NB * SEQ;
constexpr int TCX = NB * CTX;
constexpr int T = TL + TCX;
constexpr int FH = 2816;
constexpr int KEYS = CTX + SEQ;
constexpr int NPH = 2 + 7 * DEPTH;
constexpr float EPS = 1e-6f;

constexpr size_t al256(size_t x) { return (x + 255) & ~(size_t)255; }
constexpr size_t OFF_WPW1 = 0;
constexpr size_t OFF_WPW2 = OFF_WPW1 + al256((size_t)2 * 2048 * 1024 * 2);
constexpr size_t OFF_WQKV = OFF_WPW2 + al256((size_t)2 * 1024 * 1024 * 2);
constexpr size_t OFF_WO = OFF_WQKV + al256((size_t)2 * 3072 * 1024 * 2);
constexpr size_t OFF_WFIN = OFF_WO + al256((size_t)2 * 1024 * 1024 * 2);
constexpr size_t OFF_WFOUT = OFF_WFIN + al256((size_t)4 * 5632 * 1024 * 2);
constexpr size_t OFF_H = OFF_WFOUT + al256((size_t)4 * 1024 * FH * 2);
constexpr size_t OFF_NBUF = OFF_H + al256((size_t)T * 1024 * 4);
constexpr size_t OFF_BIG = OFF_NBUF + al256((size_t)T * 1024 * 2);
constexpr size_t OFF_VBUF = OFF_BIG + al256((size_t)T * 3072 * 2);
constexpr size_t OFF_MODV = OFF_VBUF + al256((size_t)T * 1024 * 2);
constexpr size_t OFF_ROPE = OFF_MODV + al256((size_t)4 * 9 * 6144 * 4);
constexpr size_t WS_NEED = OFF_ROPE + al256((size_t)1024 * 8);

struct Params {
  const float* in[22];
  float* outp;
  char* ws;
  __device__ __forceinline__ const float* x() const { return in[0]; }
  __device__ __forceinline__ const float* c() const { return in[1]; }
  __device__ __forceinline__ const float* ctx() const { return in[2]; }
  __device__ __forceinline__ const float* c_ctx() const { return in[3]; }
  __device__ __forceinline__ const float* mod_w() const { return in[4]; }
  __device__ __forceinline__ const float* mod_b() const { return in[5]; }
  __device__ __forceinline__ const float* norm_g() const { return in[6]; }
  __device__ __forceinline__ const float* pw1_w() const { return in[7]; }
  __device__ __forceinline__ const float* pw1_b() const { return in[8]; }
  __device__ __forceinline__ const float* dw_w() const { return in[9]; }
  __device__ __forceinline__ const float* dw_b() const { return in[10]; }
  __device__ __forceinline__ const float* ln_g() const { return in[11]; }
  __device__ __forceinline__ const float* ln_b() const { return in[12]; }
  __device__ __forceinline__ const float* pw2_w() const { return in[13]; }
  __device__ __forceinline__ const float* pw2_b() const { return in[14]; }
  __device__ __forceinline__ const float* wqkv() const { return in[15]; }
  __device__ __forceinline__ const float* lam() const { return in[16]; }
  __device__ __forceinline__ const float* subln() const { return in[17]; }
  __device__ __forceinline__ const float* wo() const { return in[18]; }
  __device__ __forceinline__ const float* ffn_in() const { return in[19]; }
  __device__ __forceinline__ const float* ffn_out() const { return in[20]; }
  __device__ __forceinline__ const float* final_g() const { return in[21]; }
  __device__ __forceinline__ float* out() const { return outp; }
  __device__ __forceinline__ u16* w_pw1() const { return (u16*)(ws + OFF_WPW1); }
  __device__ __forceinline__ u16* w_pw2() const { return (u16*)(ws + OFF_WPW2); }
  __device__ __forceinline__ u16* w_qkv() const { return (u16*)(ws + OFF_WQKV); }
  __device__ __forceinline__ u16* w_o() const { return (u16*)(ws + OFF_WO); }
  __device__ __forceinline__ u16* w_fin() const { return (u16*)(ws + OFF_WFIN); }
  __device__ __forceinline__ u16* w_fout() const { return (u16*)(ws + OFF_WFOUT); }
  __device__ __forceinline__ float* h() const { return (float*)(ws + OFF_H); }
  __device__ __forceinline__ u16* nbuf() const { return (u16*)(ws + OFF_NBUF); }
  __device__ __forceinline__ u16* big() const { return (u16*)(ws + OFF_BIG); }
  __device__ __forceinline__ u16* vbuf() const { return (u16*)(ws + OFF_VBUF); }
  __device__ __forceinline__ float* modv() const { return (float*)(ws + OFF_MODV); }
  __device__ __forceinline__ float2* rope() const { return (float2*)(ws + OFF_ROPE); }
};

typedef __bf16 bf2v __attribute__((ext_vector_type(2)));
typedef float f2v __attribute__((ext_vector_type(2)));
__device__ __forceinline__ unsigned pack2(float a, float b) {
  f2v v = {a, b};
  bf2v r = __builtin_convertvector(v, bf2v);
  return *(unsigned*)&r;
}
__device__ __forceinline__ u16 f2bf(float f) { return (u16)(pack2(f, 0.f) & 0xffffu); }
__device__ __forceinline__ float bf2f(unsigned v) { return __uint_as_float(v << 16); }
__device__ __forceinline__ int tile_off(int row, int chunk) { return row * 128 + (((chunk ^ row) & 7) << 4); }
__device__ __forceinline__ float fexp2(float x) { return __builtin_amdgcn_exp2f(x); }
__device__ __forceinline__ float sigmoidf_(float x) { return __builtin_amdgcn_rcpf(1.f + __expf(-x)); }

__device__ __forceinline__ int otid() { int t = threadIdx.x; asm volatile("" : "+v"(t)); return t; }

struct WDesc { const float* sp; u16* dp; int N, K; };
__device__ __forceinline__ WDesc wconv_decode(const Params& p, int item, int tid) {
  int K, N, half = 0, tpl, ntN, base;
  const float* src; u16* dst;
  if (item < 1024)      { base = 0;    K = 1024; N = 2048; half = 1024; tpl = 512;  ntN = 32; src = p.pw1_w();  dst = p.w_pw1(); }
  else if (item < 1536) { base = 1024; K = 1024; N = 1024;              tpl = 256;  ntN = 16; src = p.pw2_w();  dst = p.w_pw2(); }
  else if (item < 3072) { base = 1536; K = 1024; N = 3072;              tpl = 768;  ntN = 48; src = p.wqkv();   dst = p.w_qkv(); }
  else if (item < 3584) { base = 3072; K = 1024; N = 1024;              tpl = 256;  ntN = 16; src = p.wo();     dst = p.w_o(); }
  else if (item < 9216) { base = 3584; K = 1024; N = 5632; half = 2816; tpl = 1408; ntN = 88; src = p.ffn_in(); dst = p.w_fin(); }
  else                  { base = 9216; K = 2816; N = 1024;              tpl = 704;  ntN = 16; src = p.ffn_out(); dst = p.w_fout(); }
  const int it = item - base;
  const int l = it / tpl, rem = it % tpl, kt = rem / ntN, nt = rem % ntN;
  src += (size_t)l * K * N; dst += (size_t)l * K * N;
  const int nl = tid & 63, kk0 = tid >> 6;
  const int np = nt * 64 + nl;
  int sc = np;
  if (half) { int blk = np >> 5, w = np & 31; sc = blk * 16 + (w & 15) + ((w >> 4) ? half : 0); }
  WDesc d;
  d.sp = src + (size_t)(kt * 64 + kk0) * N + sc;
  d.dp = dst + (size_t)(nt * 64 + (tid >> 2)) * K + kt * 64 + (tid & 3) * 16;
  d.N = N; d.K = K;
  return d;
}

__device__ void wconv_loop(const Params& p, char* smem) {
  float* tl = (float*)smem;
  const int tid = otid();
  const int nl = tid & 63, kk0 = tid >> 6, nl2 = tid >> 2, kq = tid & 3;
  int item = blockIdx.x;
  if (item >= 12032) return;
  float v[16];
  WDesc d = wconv_decode(p, item, tid);
#pragma unroll
  for (int i = 0; i < 16; ++i) v[i] = d.sp[(size_t)(4 * i) * d.N];
  for (; item < 12032; item += gridDim.x) {
#pragma unroll
    for (int i = 0; i < 16; ++i) tl[(kk0 + 4 * i) * 65 + nl] = v[i];
    u16* dp = d.dp;
    const int nxt = item + gridDim.x;
    if (nxt < 12032) {
      d = wconv_decode(p, nxt, tid);
#pragma unroll
      for (int i = 0; i < 16; ++i) v[i] = d.sp[(size_t)(4 * i) * d.N];
    }
    __syncthreads();
    unsigned pk[8];
#pragma unroll
    for (int e = 0; e < 8; ++e) pk[e] = pack2(tl[(kq * 16 + 2 * e) * 65 + nl2], tl[(kq * 16 + 2 * e + 1) * 65 + nl2]);
    ((uint4*)dp)[0] = make_uint4(pk[0], pk[1], pk[2], pk[3]);
    ((uint4*)dp)[1] = make_uint4(pk[4], pk[5], pk[6], pk[7]);
    __syncthreads();
  }
}

__device__ void prologue_phase(const Params& p, char* smem) {
  const int tid = otid(), wid = tid >> 6, lane = tid & 63;
  if (blockIdx.x < 384) {
    float* s = (float*)smem;
    float* red = (float*)(smem + 36864);
    for (int idx = tid; idx < 9 * 1024; idx += 256) {
      int r = idx >> 10, k = idx & 1023;
      float cv = r < 8 ? p.c()[r * 1024 + k] : p.c_ctx()[k];
      s[idx] = cv * sigmoidf_(cv);
    }
    __syncthreads();
    for (int item = blockIdx.x; item < 384; item += gridDim.x) {
      int i = item / 96, cgp = item % 96;
      float a[9];
#pragma unroll
      for (int r = 0; r < 9; ++r) a[r] = 0.f;
      const float* wp = p.mod_w() + ((size_t)i * 1024 + wid * 256) * 6144 + cgp * 64 + lane;
#pragma unroll 4
      for (int k4 = 0; k4 < 256; k4 += 4) {
        float w0 = wp[(size_t)(k4 + 0) * 6144], w1 = wp[(size_t)(k4 + 1) * 6144];
        float w2 = wp[(size_t)(k4 + 2) * 6144], w3 = wp[(size_t)(k4 + 3) * 6144];
#pragma unroll
        for (int r = 0; r < 9; ++r) {
          float4 sv = *(const float4*)&s[r * 1024 + wid * 256 + k4];
          a[r] += sv.x * w0 + sv.y * w1 + sv.z * w2 + sv.w * w3;
        }
      }
#pragma unroll
      for (int r = 0; r < 9; ++r) red[(wid * 9 + r) * 64 + lane] = a[r];
      __syncthreads();
      for (int idx = tid; idx < 9 * 64; idx += 256) {
        int r = idx >> 6, l = idx & 63;
        float v = red[(0 * 9 + r) * 64 + l] + red[(1 * 9 + r) * 64 + l] + red[(2 * 9 + r) * 64 + l] + red[(3 * 9 + r) * 64 + l];
        v += p.mod_b()[i * 6144 + cgp * 64 + l];
        p.modv()[((size_t)i * 9 + r) * 6144 + cgp * 64 + l] = v;
      }
      __syncthreads();
    }
  }
  if (blockIdx.x == gridDim.x - 1) {
    for (int idx = tid; idx < 1024; idx += 256) {
      int pos = idx >> 4, f = idx & 15;
      float inv = powf(10000.f, -(float)f / 16.f);
      float ang = (float)pos * inv;
      p.rope()[idx] = make_float2(cosf(ang), sinf(ang));
    }
  }
  wconv_loop(p, smem);
  {
    const float4* x4 = (const float4*)p.x(); const float4* c4 = (const float4*)p.ctx(); float4* h4 = (float4*)p.h();
    for (int idx = blockIdx.x * 256 + tid; idx < T * 256; idx += gridDim.x * 256)
      h4[idx] = idx < TL * 256 ? x4[idx] : c4[idx - TL * 256];
  }
}

__device__ void norm_phase(const Params& p, int layer, int which, int M) {
  const int tid = otid(), wid = tid >> 6, lane = tid & 63;
  const float* g = p.norm_g() + (layer * 2 + which) * 1024;
  const int stride = gridDim.x * 4;
  for (int row = blockIdx.x * 4 + wid; row < M; row += 2 * stride) {
    const int rowB = row + stride;
    const bool hasB = rowB < M;
    const int rB = hasB ? rowB : row;
    const float4* hpA = (const float4*)(p.h() + (size_t)row * 1024);
    const float4* hpB = (const float4*)(p.h() + (size_t)rB * 1024);
    float4 va[4], vb[4];
#pragma unroll
    for (int i = 0; i < 4; ++i) { va[i] = hpA[lane + 64 * i]; vb[i] = hpB[lane + 64 * i]; }
    float sa = 0.f, sb = 0.f;
#pragma unroll
    for (int i = 0; i < 4; ++i) {
      sa += va[i].x * va[i].x + va[i].y * va[i].y + va[i].z * va[i].z + va[i].w * va[i].w;
      sb += vb[i].x * vb[i].x + vb[i].y * vb[i].y + vb[i].z * vb[i].z + vb[i].w * vb[i].w;
    }
#pragma unroll
    for (int o = 32; o >= 1; o >>= 1) { sa += __shfl_xor(sa, o); sb += __shfl_xor(sb, o); }
    const float rstdA = rsqrtf(sa * (1.f / 1024.f) + EPS), rstdB = rsqrtf(sb * (1.f / 1024.f) + EPS);
    const int ra = row < TL ? row / SEQ : 8, rb = rB < TL ? rB / SEQ : 8;
    const float* mva = p.modv() + ((size_t)layer * 9 + ra) * 6144;
    const float* mvb = p.modv() + ((size_t)layer * 9 + rb) * 6144;
    const int so = (which ? 3 : 0) * 1024, co = (which ? 4 : 1) * 1024;
    uint2* opA = (uint2*)(p.nbuf() + (size_t)row * 1024);
    uint2* opB = (uint2*)(p.nbuf() + (size_t)rB * 1024);
#pragma unroll
    for (int i = 0; i < 4; ++i) {
      const int c4 = lane + 64 * i;
      const float4 gg = ((const float4*)g)[c4];
      {
        const float4 s4 = ((const float4*)(mva + co))[c4], h4 = ((const float4*)(mva + so))[c4];
        float y0 = va[i].x * rstdA * gg.x * (1.f + s4.x) + h4.x, y1 = va[i].y * rstdA * gg.y * (1.f + s4.y) + h4.y;
        float y2 = va[i].z * rstdA * gg.z * (1.f + s4.z) + h4.z, y3 = va[i].w * rstdA * gg.w * (1.f + s4.w) + h4.w;
        opA[c4] = make_uint2(pack2(y0, y1), pack2(y2, y3));
      }
      if (hasB) {
        const float4 s4 = ((const float4*)(mvb + co))[c4], h4 = ((const float4*)(mvb + so))[c4];
        float y0 = vb[i].x * rstdB * gg.x * (1.f + s4.x) + h4.x, y1 = vb[i].y * rstdB * gg.y * (1.f + s4.y) + h4.y;
        float y2 = vb[i].z * rstdB * gg.z * (1.f + s4.z) + h4.z, y3 = vb[i].w * rstdB * gg.w * (1.f + s4.w) + h4.w;
        opB[c4] = make_uint2(pack2(y0, y1), pack2(y2, y3));
      }
    }
  }
}

__device__ void final_phase(const Params& p) {
  const int tid = otid(), wid = tid >> 6, lane = tid & 63;
  for (int row = blockIdx.x * 4 + wid; row < TL; row += gridDim.x * 4) {
    const float4* hp = (const float4*)(p.h() + (size_t)row * 1024);
    float4 v[4];
    float ss = 0.f;
#pragma unroll
    for (int i = 0; i < 4; ++i) { v[i] = hp[lane + 64 * i]; ss += v[i].x * v[i].x + v[i].y * v[i].y + v[i].z * v[i].z + v[i].w * v[i].w; }
#pragma unroll
    for (int o = 32; o >= 1; o >>= 1) ss += __shfl_xor(ss, o);
    float rstd = rsqrtf(ss * (1.f / 1024.f) + EPS);
    float4* op = (float4*)(p.out() + (size_t)row * 1024);
#pragma unroll
    for (int i = 0; i < 4; ++i) {
      int c4 = lane + 64 * i;
      float4 gg = ((const float4*)p.final_g())[c4];
      float4 ov = make_float4(v[i].x * rstd * gg.x, v[i].y * rstd * gg.y, v[i].z * rstd * gg.z, v[i].w * rstd * gg.w);
      op[c4] = ov;
    }
  }
}

template <int K, int EPI>
__device__ __forceinline__ void gemm_run(const Params& p, const u16* __restrict__ A, const u16* __restrict__ Bt,
                          int Mt, int Nt, int layer, int gidx, const float* __restrict__ bias, char* smem) {
  const int tid = otid(), wid = tid >> 6, lane = tid & 63, wr = wid >> 1, wc = wid & 1, fr = lane & 15, fq = lane >> 4;
  const int xcd = blockIdx.x & 7, rank = blockIdx.x >> 3, rpx = gridDim.x >> 3;
  const int SN = (Nt & 7) == 0 ? 8 : 4, SM = 64 / SN;
  const int nsn = Nt / SN, total_s = (Mt / SM) * nsn;
  const int cq = rank < 64 ? (64 - rank + rpx - 1) / rpx : 0;
  const int nsx = xcd < total_s ? (total_s - xcd + 7) / 8 : 0;
  const int ntile = cq * nsx;
  if (ntile == 0) return;
#define TILE_MN(i_, mt_, nt_)                                              \
  {                                                                        \
    const int si_ = (i_) / cq, qi_ = (i_) - si_ * cq;                      \
    const int sidx_ = xcd + 8 * si_, q_ = rank + rpx * qi_;                \
    const int ms_ = sidx_ / nsn, ns_ = sidx_ - ms_ * nsn;                  \
    mt_ = ms_ * SM + q_ / SN;                                              \
    nt_ = ns_ * SN + q_ % SN;                                              \
  }
  constexpr int nk = K / 64;
  const int lrow = tid >> 3, lc = tid & 7;
  const int toff = lrow * K + lc * 8;
  const int loff = tile_off(lrow, lc);
  const int aoff = tile_off(wr * 64 + fr, fq);
  const int boff = tile_off(wc * 64 + fr, fq);
  u32x4 ra0_0, ra1_0, ra2_0, ra3_0, rb0_0, rb1_0, rb2_0, rb3_0;
#define GLD(dst, ptr) dst = *(const u32x4*)(ptr)
#define G_LOAD(S, ko)                          \
  GLD(ra0_##S, pa + 0 * 32 * K + (ko));        \
  GLD(ra1_##S, pa + 1 * 32 * K + (ko));        \
  GLD(ra2_##S, pa + 2 * 32 * K + (ko));        \
  GLD(ra3_##S, pa + 3 * 32 * K + (ko));        \
  GLD(rb0_##S, pb + 0 * 32 * K + (ko));        \
  GLD(rb1_##S, pb + 1 * 32 * K + (ko));        \
  GLD(rb2_##S, pb + 2 * 32 * K + (ko));        \
  GLD(rb3_##S, pb + 3 * 32 * K + (ko));
#define VMWAIT(N, S)
#define L_STORE(S, base)                                                \
  *(u32x4*)((base) + loff + 0 * 4096) = ra0_##S;                          \
  *(u32x4*)((base) + loff + 1 * 4096) = ra1_##S;                          \
  *(u32x4*)((base) + loff + 2 * 4096) = ra2_##S;                          \
  *(u32x4*)((base) + loff + 3 * 4096) = ra3_##S;                          \
  *(u32x4*)((base) + 16384 + loff + 0 * 4096) = rb0_##S;                  \
  *(u32x4*)((base) + 16384 + loff + 1 * 4096) = rb1_##S;                  \
  *(u32x4*)((base) + 16384 + loff + 2 * 4096) = rb2_##S;                  \
  *(u32x4*)((base) + 16384 + loff + 3 * 4096) = rb3_##S;
#define DMA1(sbase, m0v) asm volatile("s_mov_b32 m0, %2\n\ts_nop 0\n\tglobal_load_lds_dwordx4 %0, %1" ::"v"(dvoff), "s"(sbase), "s"(m0v) : "memory", "m0")
#define DMA_LOAD(sb, ko)                                   \
  DMA1(Au + 0 * 32 * K + (ko), (sb) + 0 * 4096);           \
  DMA1(Au + 1 * 32 * K + (ko), (sb) + 1 * 4096);           \
  DMA1(Au + 2 * 32 * K + (ko), (sb) + 2 * 4096);           \
  DMA1(Au + 3 * 32 * K + (ko), (sb) + 3 * 4096);           \
  DMA1(Bu + 0 * 32 * K + (ko), (sb) + 16384 + 0 * 4096);   \
  DMA1(Bu + 1 * 32 * K + (ko), (sb) + 16384 + 1 * 4096);   \
  DMA1(Bu + 2 * 32 * K + (ko), (sb) + 16384 + 2 * 4096);   \
  DMA1(Bu + 3 * 32 * K + (ko), (sb) + 16384 + 3 * 4096);
#define MMA_TILE_DB(As_, Bs_)                                                                        \
  {                                                                                               \
    bf16x8 a0[4], b0[4], a1[4], b1[4];                                                            \
    __builtin_amdgcn_s_setprio(1);                                                                \
    _Pragma("unroll") for (int mi = 0; mi < 4; ++mi) a0[mi] = *(const bf16x8*)((As_) + aoff + mi * 2048);        \
    _Pragma("unroll") for (int ni = 0; ni < 4; ++ni) b0[ni] = *(const bf16x8*)((Bs_) + boff + ni * 2048);        \
    _Pragma("unroll") for (int mi = 0; mi < 4; ++mi) a1[mi] = *(const bf16x8*)((As_) + (aoff ^ 64) + mi * 2048); \
    _Pragma("unroll") for (int ni = 0; ni < 4; ++ni) b1[ni] = *(const bf16x8*)((Bs_) + (boff ^ 64) + ni * 2048); \
    __builtin_amdgcn_sched_barrier(0);                                                            \
    _Pragma("unroll") for (int mi = 0; mi < 4; ++mi)                                              \
      _Pragma("unroll") for (int ni = 0; ni < 4; ++ni)                                            \
        acc[mi][ni] = __builtin_amdgcn_mfma_f32_16x16x32_bf16(a0[mi], b0[ni], acc[mi][ni], 0, 0, 0); \
    _Pragma("unroll") for (int mi = 0; mi < 4; ++mi)                                              \
      _Pragma("unroll") for (int ni = 0; ni < 4; ++ni)                                            \
        acc[mi][ni] = __builtin_amdgcn_mfma_f32_16x16x32_bf16(a1[mi], b1[ni], acc[mi][ni], 0, 0, 0); \
    __builtin_amdgcn_s_setprio(0);                                                                \
  }
#define MMA_TILE_N(As_, Bs_)                                                                      \
  __builtin_amdgcn_s_setprio(1);                                                                  \
  _Pragma("unroll") for (int ks = 0; ks < 2; ++ks) {                                              \
    bf16x8 af[4], bfr[4];                                                                         \
    _Pragma("unroll") for (int mi = 0; mi < 4; ++mi) af[mi] = *(const bf16x8*)((As_) + (aoff ^ (ks << 6)) + mi * 2048);  \
    _Pragma("unroll") for (int ni = 0; ni < 4; ++ni) bfr[ni] = *(const bf16x8*)((Bs_) + (boff ^ (ks << 6)) + ni * 2048); \
    _Pragma("unroll") for (int mi = 0; mi < 4; ++mi)                                              \
      _Pragma("unroll") for (int ni = 0; ni < 4; ++ni)                                            \
        acc[mi][ni] = __builtin_amdgcn_mfma_f32_16x16x32_bf16(af[mi], bfr[ni], acc[mi][ni], 0, 0, 0); \
  }                                                                                               \
  __builtin_amdgcn_s_setprio(0);
#define MMA_TILE(As_, Bs_)                         \
  if constexpr (EPI == 1) { MMA_TILE_N(As_, Bs_) } \
  else { MMA_TILE_DB(As_, Bs_) }
  int mt, nt;
  TILE_MN(0, mt, nt)
  const u16* pa = A + (size_t)mt * 128 * K + toff;
  const u16* pb = Bt + (size_t)nt * 128 * K + toff;
  G_LOAD(0, 0)
#pragma unroll 1
  for (int ti = 0; ti < ntile; ++ti) {
  const int brow = mt * 128, bcol = nt * 128;
  f32x4 acc[4][4];
#pragma unroll
  for (int i = 0; i < 4; ++i)
#pragma unroll
    for (int j = 0; j < 4; ++j) acc[i][j] = f32x4{0.f, 0.f, 0.f, 0.f};
  L_STORE(0, smem)
  __syncthreads();
  {
    const unsigned dvoff = (unsigned)(lrow * K + ((lc ^ lrow) & 7) * 8) * 2u;
    const u16* Au = A + (size_t)mt * 128 * K;
    const u16* Bu = Bt + (size_t)nt * 128 * K;
    const unsigned sm0 = __builtin_amdgcn_readfirstlane((unsigned)(size_t)smem) + __builtin_amdgcn_readfirstlane(wid) * 1024u;
#pragma unroll 2
    for (int kt = 0; kt < nk; ++kt) {
      const int cur = kt & 1;
      if (kt + 1 < nk) {
        const unsigned sb = sm0 + (unsigned)(cur ^ 1) * 32768u;
        DMA_LOAD(sb, (kt + 1) * 64)
      }
      __builtin_amdgcn_sched_barrier(0);
      MMA_TILE(smem + cur * 32768, smem + cur * 32768 + 16384)
      __builtin_amdgcn_sched_barrier(0);
      asm volatile("s_waitcnt vmcnt(0)" ::: "memory");
      __syncthreads();
    }
  }
  int mt2 = mt, nt2 = nt;
  if (ti + 1 < ntile) {
    TILE_MN(ti + 1, mt2, nt2)
    pa = A + (size_t)mt2 * 128 * K + toff;
    pb = Bt + (size_t)nt2 * 128 * K + toff;
    if constexpr (EPI != 1) { G_LOAD(0, 0) }
  }
  __builtin_amdgcn_sched_barrier(0);
  const int r0 = brow + wr * 64;
  char* stg = smem + wid * 16384;
  if constexpr (EPI == 0 || EPI == 3) {
    const int OW = (EPI == 0) ? 1024 : FH;
    u16* outp = p.big();
    const int jch0 = (bcol + wc * 64) >> 1;
#pragma unroll
    for (int pp = 0; pp < 2; ++pp) {
      float b0 = 0.f, b1 = 0.f;
      if (bias) { b0 = bias[jch0 + pp * 16 + fr]; b1 = bias[1024 + jch0 + pp * 16 + fr]; }
#pragma unroll
      for (int mi = 0; mi < 4; ++mi)
#pragma unroll
        for (int j = 0; j < 4; ++j) {
          float a = acc[mi][2 * pp][j] + b0, g = acc[mi][2 * pp + 1][j] + b1;
          float sg = sigmoidf_(EPI == 0 ? g : a);
          float v = (EPI == 0) ? a * sg : a * sg * g;
          *(u16*)(stg + (mi * 16 + fq * 4 + j) * 80 + (pp * 16 + fr) * 2) = f2bf(v);
        }
    }
    __syncthreads();
#pragma unroll
    for (int it = 0; it < 4; ++it) {
      const int row = it * 16 + (lane >> 2), ch = lane & 3;
      u32x4 val = *(const u32x4*)(stg + row * 80 + ch * 16);
      *(u32x4*)(outp + (size_t)(r0 + row) * OW + jch0 + ch * 8) = val;
    }
    __syncthreads();
  } else if constexpr (EPI == 2) {
    float* sf = (float*)stg;
#pragma unroll
    for (int mi = 0; mi < 4; ++mi)
#pragma unroll
      for (int ni = 0; ni < 4; ++ni)
#pragma unroll
        for (int j = 0; j < 4; ++j) sf[(mi * 16 + fq * 4 + j) * 64 + ((ni ^ fq) << 4) + fr] = acc[mi][ni][j];
    __syncthreads();
    {
      const int r = brow < TL ? brow / SEQ : 8;
      const int c = lane & 15, rsub = lane >> 4;
      const int col0 = bcol + wc * 64 + c * 4;
      const float4 g4 = *(const float4*)(p.modv() + ((size_t)layer * 9 + r) * 6144 + gidx * 1024 + col0);
      float4 b4 = make_float4(0.f, 0.f, 0.f, 0.f);
      if (bias) b4 = *(const float4*)(bias + col0);
      float* hrow = p.h() + (size_t)(r0 + rsub) * 1024 + col0;
      const float* srow = sf + rsub * 64 + (c & 3) * 4;
#pragma unroll 1
      for (int it4 = 0; it4 < 4; ++it4) {
#pragma unroll
        for (int u = 0; u < 4; ++u) {
          const int grp = (c >> 2) ^ u;
          const float4 a4 = *(const float4*)(srow + u * 256 + grp * 16);
          float4* hp = (float4*)(hrow + u * 4096);
          float4 hv = *hp;
          hv.x += g4.x * (a4.x + b4.x); hv.y += g4.y * (a4.y + b4.y); hv.z += g4.z * (a4.z + b4.z); hv.w += g4.w * (a4.w + b4.w);
          *hp = hv;
        }
        hrow += 16 * 1024;
        srow += 16 * 64;
      }
    }
    __syncthreads();
  } else {
    const int region = nt >> 3, hd = nt & 7;
    const bool lat = brow < TL;
    const int b = lat ? brow / SEQ : (brow - TL) / CTX;
    const int kb = lat ? 256 + (r0 - b * SEQ) : (r0 - TL - b * CTX);
    const size_t bh = (size_t)(b * 8 + hd);
    u16* qb = p.big(); u16* kbuf = p.big() + (size_t)T * 1024; u16* vt = p.big() + (size_t)T * 2048;
    if (region < 2) {
      u16* dst = (region == 0 ? qb : kbuf) + ((bh * 2 + wc) * KEYS + kb) * 64;
      const float qs = region == 0 ? 0.125f * 1.44269504088896f : 1.f;
#pragma unroll
      for (int mi = 0; mi < 4; ++mi)
#pragma unroll
        for (int j = 0; j < 4; ++j) {
          int rl = mi * 16 + fq * 4 + j;
          float x0 = acc[mi][0][j], x1 = acc[mi][1][j], x2 = acc[mi][2][j], x3 = acc[mi][3][j];
          if (lat) {
            int t = kb - 256 + rl;
            float2 cr = p.rope()[(t >> 6) * 16 + fr], cc = p.rope()[(t & 63) * 16 + fr];
            float y0 = x0 * cr.x - x1 * cr.y, y1 = x1 * cr.x + x0 * cr.y;
            float y2 = x2 * cc.x - x3 * cc.y, y3 = x3 * cc.x + x2 * cc.y;
            x0 = y0; x1 = y1; x2 = y2; x3 = y3;
          }
          char* sp = stg + rl * 144 + fr * 2;
          *(u16*)(sp) = f2bf(x0 * qs); *(u16*)(sp + 32) = f2bf(x1 * qs); *(u16*)(sp + 64) = f2bf(x2 * qs); *(u16*)(sp + 96) = f2bf(x3 * qs);
          if (j == 3) asm volatile("" ::: "memory");
        }
      __syncthreads();
#pragma unroll
      for (int it = 0; it < 8; ++it) {
        const int row = it * 8 + (lane >> 3), ch = lane & 7;
        u32x4 val = *(const u32x4*)(stg + row * 144 + ch * 16);
        *(u32x4*)(dst + (size_t)row * 64 + ch * 8) = val;
      }
      __syncthreads();
    } else {
#pragma unroll
      for (int ni = 0; ni < 4; ++ni) {
        const int e = ni * 16 + fr;
#pragma unroll
        for (int mi = 0; mi < 4; ++mi) {
          int slot = (mi >> 1) * 32 + fq * 8 + (mi & 1) * 4;
          *(uint2*)(stg + e * 144 + slot * 2) = make_uint2(pack2(acc[mi][ni][0], acc[mi][ni][1]), pack2(acc[mi][ni][2], acc[mi][ni][3]));
        }
      }
      __syncthreads();
      u16* dp = vt + (bh * 128 + wc * 64) * KEYS + kb;
#pragma unroll
      for (int it = 0; it < 8; ++it) {
        const int row = it * 8 + (lane >> 3), ch = lane & 7;
        u32x4 val = *(const u32x4*)(stg + row * 144 + ch * 16);
        *(u32x4*)(dp + (size_t)row * KEYS + ch * 8) = val;
      }
      __syncthreads();
    }
  }
  if constexpr (EPI == 1) { if (ti + 1 < ntile) { G_LOAD(0, 0) } }
  mt = mt2; nt = nt2;
  }
#undef GLD
#undef VMWAIT
#undef G_LOAD
#undef L_STORE
#undef MMA_TILE
#undef MMA_TILE_N
#undef MMA_TILE_DB
#undef DMA1
#undef DMA_LOAD
#undef TILE_MN
}

__device__ void gemm_phase(const Params& p, const u16* A, const u16* Bt, int K, int Mt, int Nt, int epi, int layer, int gidx,
                           const float* bias, char* smem) {
  if (K != 1024) gemm_run<FH, 2>(p, A, Bt, Mt, Nt, layer, gidx, bias, smem);
  else if (epi == 0) gemm_run<1024, 0>(p, A, Bt, Mt, Nt, layer, gidx, bias, smem);
  else if (epi == 1) gemm_run<1024, 1>(p, A, Bt, Mt, Nt, layer, gidx, bias, smem);
  else if (epi == 2) gemm_run<1024, 2>(p, A, Bt, Mt, Nt, layer, gidx, bias, smem);
  else gemm_run<1024, 3>(p, A, Bt, Mt, Nt, layer, gidx, bias, smem);
}

__device__ void conv_phase(const Params& p, int j, int M, char* smem) {
  const int tid = otid(), wid = tid >> 6, lane = tid & 63;
  float* cbuf = (float*)smem;
  const u16* U = p.big();
  for (int item = blockIdx.x; item < M / 8; item += gridDim.x) {
    const int t0 = item * 8;
    int s0, s1;
    if (t0 < TL) { s0 = (t0 / SEQ) * SEQ; s1 = s0 + SEQ; } else { s0 = TL + ((t0 - TL) / CTX) * CTX; s1 = s0 + CTX; }
#pragma unroll 1
    for (int g = 0; g < 2; ++g) {
      const int c = g * 512 + tid * 2;
      float acc[8][2];
      float w[31][2];
#pragma unroll
      for (int k = 0; k < 31; ++k) { float2 wv = *(const float2*)(p.dw_w() + ((size_t)j * 31 + k) * 1024 + c); w[k][0] = wv.x; w[k][1] = wv.y; }
      float2 bv = *(const float2*)(p.dw_b() + j * 1024 + c);
#pragma unroll
      for (int o = 0; o < 8; ++o) { acc[o][0] = bv.x; acc[o][1] = bv.y; }
#pragma unroll
      for (int ti = 0; ti < 38; ++ti) {
        int tin = t0 - 15 + ti;
        bool valid = tin >= s0 && tin < s1;
        int tc = min(max(tin, s0), s1 - 1);
        unsigned raw = *(const unsigned*)(U + (size_t)tc * 1024 + c);
        if (!valid) raw = 0u;
        float x0 = bf2f(raw & 0xffffu), x1 = bf2f(raw >> 16);
#pragma unroll
        for (int o = 0; o < 8; ++o) {
          const int k = ti - o;
          if (k >= 0 && k < 31) { acc[o][0] += x0 * w[k][0]; acc[o][1] += x1 * w[k][1]; }
        }
      }
#pragma unroll
      for (int o = 0; o < 8; ++o) *(float2*)(cbuf + o * 1024 + c) = make_float2(acc[o][0], acc[o][1]);
    }
    __syncthreads();
#pragma unroll
    for (int tt = 0; tt < 2; ++tt) {
      const int o = wid * 2 + tt;
      float4 v[4];
      float sm = 0.f;
#pragma unroll
      for (int i = 0; i < 4; ++i) { v[i] = *(const float4*)(cbuf + o * 1024 + (lane + 64 * i) * 4); sm += v[i].x + v[i].y + v[i].z + v[i].w; }
#pragma unroll
      for (int sh = 32; sh >= 1; sh >>= 1) sm += __shfl_xor(sm, sh);
      const float mean = sm * (1.f / 1024.f);
      float sq = 0.f;
#pragma unroll
      for (int i = 0; i < 4; ++i) {
        v[i].x -= mean; v[i].y -= mean; v[i].z -= mean; v[i].w -= mean;
        sq += v[i].x * v[i].x + v[i].y * v[i].y + v[i].z * v[i].z + v[i].w * v[i].w;
      }
#pragma unroll
      for (int sh = 32; sh >= 1; sh >>= 1) sq += __shfl_xor(sq, sh);
      const float rstd = rsqrtf(sq * (1.f / 1024.f) + EPS);
      uint2* op = (uint2*)(p.vbuf() + (size_t)(t0 + o) * 1024);
#pragma unroll
      for (int i = 0; i < 4; ++i) {
        int c4 = lane + 64 * i;
        float4 lg = ((const float4*)(p.ln_g() + j * 1024))[c4], lb = ((const float4*)(p.ln_b() + j * 1024))[c4];
        float y0 = v[i].x * rstd * lg.x + lb.x, y1 = v[i].y * rstd * lg.y + lb.y;
        float y2 = v[i].z * rstd * lg.z + lb.z, y3 = v[i].w * rstd * lg.w + lb.w;
        y0 *= sigmoidf_(y0); y1 *= sigmoidf_(y1); y2 *= sigmoidf_(y2); y3 *= sigmoidf_(y3);
        op[c4] = make_uint2(pack2(y0, y1), pack2(y2, y3));
      }
    }
    __syncthreads();
  }
}

__device__ void attn_item(const Params& p, int b, int hd, int q0, int nkeys, int out_row0, float lam, float oscale,
                          const float* __restrict__ subg, char* smem) {
  const int tid = otid(), wid = tid >> 6, lane = tid & 63, fr = lane & 15, fq = lane >> 4;
  const int comp = wid & 1, qg = wid >> 1;
  const size_t bh = (size_t)(b * 8 + hd);
  const u16* qb = p.big(); const u16* kbuf = p.big() + (size_t)T * 1024; const u16* vtb = p.big() + (size_t)T * 2048;
  const u16* Qp = qb + ((bh * 2 + comp) * KEYS + q0 + qg * 32) * 64;
  bf16x8 qf[2][2];
#pragma unroll
  for (int qs = 0; qs < 2; ++qs)
#pragma unroll
    for (int ks = 0; ks < 2; ++ks) qf[qs][ks] = *(const bf16x8*)(Qp + (qs * 16 + fr) * 64 + ks * 32 + fq * 8);
  const u16* K1p = kbuf + (bh * 2 + 0) * KEYS * 64;
  const u16* K2p = kbuf + (bh * 2 + 1) * KEYS * 64;
  const u16* Vp = vtb + bh * 128 * KEYS;
  const int lrow = tid >> 3, lc = tid & 7;
  const unsigned swz8 = (unsigned)(((lc ^ lrow) & 7) * 8);
  const unsigned dvk = (unsigned)(lrow * 64) * 2u + swz8 * 2u;
  const unsigned dvv = (unsigned)(lrow * KEYS) * 2u + swz8 * 2u;
  const unsigned sm0 = __builtin_amdgcn_readfirstlane((unsigned)(size_t)smem) + __builtin_amdgcn_readfirstlane(wid) * 1024u;
#define ADMA(voff, sbase, m0v) asm volatile("s_mov_b32 m0, %2\n\ts_nop 0\n\tglobal_load_lds_dwordx4 %0, %1" ::"v"(voff), "s"(sbase), "s"(m0v) : "memory", "m0")
#define ATT_DMA(kt_, buf_)                                                                     \
  {                                                                                            \
    const int key0 = (kt_) * 64;                                                               \
    const unsigned sb_ = sm0 + (unsigned)(buf_) * 32768u;                                      \
    ADMA(dvk, K1p + (size_t)(key0) * 64, sb_);                                                 \
    ADMA(dvk, K1p + (size_t)(key0 + 32) * 64, sb_ + 4096u);                                    \
    ADMA(dvk, K2p + (size_t)(key0) * 64, sb_ + 8192u);                                         \
    ADMA(dvk, K2p + (size_t)(key0 + 32) * 64, sb_ + 12288u);                                   \
    ADMA(dvv, Vp + key0, sb_ + 16384u);                                                        \
    ADMA(dvv, Vp + (size_t)32 * KEYS + key0, sb_ + 20480u);                                    \
    ADMA(dvv, Vp + (size_t)64 * KEYS + key0, sb_ + 24576u);                                    \
    ADMA(dvv, Vp + (size_t)96 * KEYS + key0, sb_ + 28672u);                                    \
  }
  f32x4 O[8][2];
#pragma unroll
  for (int e = 0; e < 8; ++e) { O[e][0] = f32x4{0.f, 0.f, 0.f, 0.f}; O[e][1] = f32x4{0.f, 0.f, 0.f, 0.f}; }
  float m[2] = {-1e30f, -1e30f}, l[2] = {0.f, 0.f};
  const int ntile = nkeys >> 6;
  ATT_DMA(0, 0)
  asm volatile("s_waitcnt vmcnt(0)" ::: "memory");
  __syncthreads();
  for (int kt = 0; kt < ntile; ++kt) {
    const int cur = kt & 1;
    if (kt + 1 < ntile) ATT_DMA(kt + 1, cur ^ 1)
    const char* base = smem + cur * 32768;
    const char* Kc = base + comp * 8192;
    const char* Vt = base + 16384;
    f32x4 S[4][2];
#pragma unroll
    for (int i = 0; i < 4; ++i) { S[i][0] = f32x4{0.f, 0.f, 0.f, 0.f}; S[i][1] = f32x4{0.f, 0.f, 0.f, 0.f}; }
    __builtin_amdgcn_s_setprio(1);
    {
      bf16x8 kf[2][4];
#pragma unroll
      for (int ks = 0; ks < 2; ++ks)
#pragma unroll
        for (int ksub = 0; ksub < 4; ++ksub) kf[ks][ksub] = *(const bf16x8*)(Kc + tile_off(ksub * 16 + fr, ks * 4 + fq));
      __builtin_amdgcn_sched_barrier(0);
#pragma unroll
      for (int ks = 0; ks < 2; ++ks)
#pragma unroll
        for (int ksub = 0; ksub < 4; ++ksub)
#pragma unroll
          for (int qs = 0; qs < 2; ++qs) S[ksub][qs] = __builtin_amdgcn_mfma_f32_16x16x32_bf16(kf[ks][ksub], qf[qs][ks], S[ksub][qs], 0, 0, 0);
    }
    __builtin_amdgcn_s_setprio(0);
#pragma unroll
    for (int qs = 0; qs < 2; ++qs) {
      float mx = -1e30f;
#pragma unroll
      for (int ksub = 0; ksub < 4; ++ksub)
#pragma unroll
        for (int j = 0; j < 4; ++j) mx = fmaxf(mx, S[ksub][qs][j]);
      mx = fmaxf(mx, __shfl_xor(mx, 16));
      mx = fmaxf(mx, __shfl_xor(mx, 32));
      float mn = fmaxf(m[qs], mx);
      float alpha = fexp2(m[qs] - mn);
      m[qs] = mn;
      float rs = 0.f;
#pragma unroll
      for (int ksub = 0; ksub < 4; ++ksub)
#pragma unroll
        for (int j = 0; j < 4; ++j) { float pv = fexp2(S[ksub][qs][j] - mn); S[ksub][qs][j] = pv; rs += pv; }
      l[qs] = l[qs] * alpha + rs;
      if (__builtin_amdgcn_ballot_w64(alpha != 1.f) != 0) {
#pragma unroll
        for (int e = 0; e < 8; ++e) O[e][qs] *= alpha;
      }
    }
    bf16x8 pf[2][2];
#pragma unroll
    for (int qs = 0; qs < 2; ++qs)
#pragma unroll
      for (int s = 0; s < 2; ++s) {
        unsigned u0 = pack2(S[2 * s][qs][0], S[2 * s][qs][1]), u1 = pack2(S[2 * s][qs][2], S[2 * s][qs][3]);
        unsigned u2 = pack2(S[2 * s + 1][qs][0], S[2 * s + 1][qs][1]), u3 = pack2(S[2 * s + 1][qs][2], S[2 * s + 1][qs][3]);
        uint4 uu = make_uint4(u0, u1, u2, u3);
        pf[qs][s] = *(bf16x8*)&uu;
      }
    __builtin_amdgcn_s_setprio(1);
#pragma unroll
    for (int s = 0; s < 2; ++s) {
      bf16x8 vf[8];
#pragma unroll
      for (int e = 0; e < 8; ++e) vf[e] = *(const bf16x8*)(Vt + tile_off(e * 16 + fr, s * 4 + fq));
      __builtin_amdgcn_sched_barrier(0);
#pragma unroll
      for (int e = 0; e < 8; ++e)
#pragma unroll
        for (int qs = 0; qs < 2; ++qs) O[e][qs] = __builtin_amdgcn_mfma_f32_16x16x32_bf16(vf[e], pf[qs][s], O[e][qs], 0, 0, 0);
    }
    __builtin_amdgcn_s_setprio(0);
    asm volatile("s_waitcnt vmcnt(0)" ::: "memory");
    __syncthreads();
  }
#undef ATT_DMA
#undef ADMA
#pragma unroll
  for (int qs = 0; qs < 2; ++qs) {
    float ls = l[qs];
    ls += __shfl_xor(ls, 16);
    ls += __shfl_xor(ls, 32);
    float inv = (comp ? lam : 1.f) / ls;
#pragma unroll
    for (int e = 0; e < 8; ++e) O[e][qs] *= inv;
  }
  float* ex = (float*)smem;
  if (comp == 1) {
#pragma unroll
    for (int e = 0; e < 8; ++e)
#pragma unroll
      for (int qs = 0; qs < 2; ++qs) *(f32x4*)(ex + ((((qg * 8 + e) * 2 + qs) * 64 + lane) << 2)) = O[e][qs];
  }
  __syncthreads();
  if (comp == 0) {
#pragma unroll
    for (int qs = 0; qs < 2; ++qs) {
      float ssq = 0.f;
#pragma unroll
      for (int e = 0; e < 8; ++e) {
        f32x4 o2 = *(const f32x4*)(ex + ((((qg * 8 + e) * 2 + qs) * 64 + lane) << 2));
        O[e][qs] -= o2;
#pragma unroll
        for (int j = 0; j < 4; ++j) ssq += O[e][qs][j] * O[e][qs][j];
      }
      ssq += __shfl_xor(ssq, 16);
      ssq += __shfl_xor(ssq, 32);
      float rstd = rsqrtf(ssq * (1.f / 128.f) + EPS) * oscale;
      u16* op = p.vbuf() + (size_t)(out_row0 + qg * 32 + qs * 16 + fr) * 1024 + hd * 128 + fq * 4;
#pragma unroll
      for (int e = 0; e < 8; ++e) {
        float4 sg = *(const float4*)(subg + e * 16 + fq * 4);
        *(uint2*)(op + e * 16) = make_uint2(pack2(O[e][qs][0] * rstd * sg.x, O[e][qs][1] * rstd * sg.y),
                                            pack2(O[e][qs][2] * rstd * sg.z, O[e][qs][3] * rstd * sg.w));
      }
    }
  }
  __syncthreads();
}

__device__ void attn_phase(const Params& p, int layer, bool with_ctx, char* smem) {
  const int ja = layer >> 1;
  const float* lv = p.lam() + ja * 256;
  float d01 = 0.f, d23 = 0.f;
  for (int i = 0; i < 64; ++i) { d01 += lv[i] * lv[64 + i]; d23 += lv[128 + i] * lv[192 + i]; }
  const float lam_init = 0.8f - 0.6f * expf(-0.3f * (float)layer);
  const float lam = expf(d01) - expf(d23) + lam_init;
  const float* subg = p.subln() + ja * 128;
  {
    const int xcd = blockIdx.x & 7, rank = blockIdx.x >> 3, rpx = gridDim.x >> 3;
    for (int r = 0; r < 4; ++r)
      for (int q = rank; q < 64; q += rpx) {
        const int bh = r * 16 + xcd * 2 + (q >> 5), qt = q & 31;
        const int b = bh >> 3, hd = bh & 7;
        attn_item(p, b, hd, 256 + qt * 64, KEYS, b * SEQ + qt * 64, lam, 1.f - lam_init, subg, smem);
      }
  }
  if (with_ctx) {
    for (int it = blockIdx.x; it < 256; it += gridDim.x) {
      const int qt = it & 3, hd = (it >> 2) & 7, b = it >> 5;
      attn_item(p, b, hd, qt * 64, CTX, TL + b * CTX + qt * 64, lam, 1.f - lam_init, subg, smem);
    }
  }
}

__device__ void run_phase(const Params& p, int ph_in, char* smem) {
  const int ph = ph_in & 0xffff; const bool noepi = (ph_in >> 16) != 0;
  if (ph == 0) { prologue_phase(p, smem); return; }
  if (ph == NPH - 1) { final_phase(p); return; }
  const int layer = (ph - 1) / 7, sub = (ph - 1) % 7;
  const bool last = layer == DEPTH - 1;
  const int M = last ? TL : T;
  const bool is_conv = (layer & 1) == 0;
  const int j = layer >> 1;
  if (sub == 0 || sub == 4) { norm_phase(p, layer, sub == 4 ? 1 : 0, sub == 0 ? T : M); return; }
  if (sub == 2) {
    if (is_conv) conv_phase(p, j, T, smem);
    else attn_phase(p, layer, !last, smem);
    return;
  }
  const u16 *A, *Bt; int K = 1024, Nt, epi, gidx = 0, mtiles = M / 128; const float* bias = nullptr;
  if (sub == 1) {
    A = p.nbuf(); mtiles = T / 128;
    if (is_conv) { Bt = p.w_pw1() + (size_t)j * 2048 * 1024; Nt = 16; epi = 0; bias = p.pw1_b() + j * 2048; }
    else { Bt = p.w_qkv() + (size_t)j * 3072 * 1024; Nt = 24; epi = 1; }
  } else if (sub == 3) {
    A = p.vbuf(); Nt = 8; epi = 2; gidx = 2;
    if (is_conv) { Bt = p.w_pw2() + (size_t)j * 1024 * 1024; bias = p.pw2_b() + j * 1024; }
    else Bt = p.w_o() + (size_t)j * 1024 * 1024;
  } else if (sub == 5) {
    A = p.nbuf(); Bt = p.w_fin() + (size_t)layer * 5632 * 1024; Nt = 44; epi = 3;
  } else {
    A = p.big(); Bt = p.w_fout() + (size_t)layer * 1024 * FH; K = FH; Nt = 8; epi = 2; gidx = 5;
  }
  gemm_phase(p, A, Bt, K, mtiles, Nt, epi, layer, gidx, bias, smem);
}

__device__ __forceinline__ unsigned xcc_id() { return (unsigned)__builtin_amdgcn_s_getreg((3 << 11) | 20) & 0xFu; }
__device__ __forceinline__ void grid_barrier(unsigned* bar, unsigned xcc, unsigned k, unsigned nloc, unsigned nx) {
  __syncthreads();
  if (threadIdx.x == 0) {
    unsigned a = __hip_atomic_fetch_add(&bar[1024 + xcc * 64], 1u, __ATOMIC_RELAXED, __HIP_MEMORY_SCOPE_AGENT) + 1u;
    if (a == k * nloc) {
      __builtin_amdgcn_fence(__ATOMIC_RELEASE, "agent");
      asm volatile("s_waitcnt vmcnt(0)" ::: "memory");
      __hip_atomic_fetch_add(&bar[2048], 1u, __ATOMIC_RELAXED, __HIP_MEMORY_SCOPE_AGENT);
    }
    while (__hip_atomic_load(&bar[2048], __ATOMIC_RELAXED, __HIP_MEMORY_SCOPE_AGENT) < k * nx) __builtin_amdgcn_s_sleep(2);
    __builtin_amdgcn_fence(__ATOMIC_ACQUIRE, "agent");
    asm volatile("s_waitcnt vmcnt(0)" ::: "memory");
  }
  __syncthreads();
}

__global__ void __launch_bounds__(256, 2) mega(Params p, int ph_begin, int ph_end, int use_sync) {
  __shared__ __attribute__((aligned(16))) char smem[65536];
  __shared__ unsigned s_cnt[2];
  cg::grid_group grid = cg::this_grid();
  unsigned* bar = (unsigned*)(p.ws + WS_NEED);
  const unsigned xcc = xcc_id();
  if (use_sync && threadIdx.x == 0) __hip_atomic_fetch_add(&bar[xcc * 64], 1u, __ATOMIC_RELAXED, __HIP_MEMORY_SCOPE_AGENT);
  unsigned k = 0, nloc = 1, nx = 1;
  for (int ph = ph_begin; ph < ph_end; ++ph) {
    run_phase(p, ph, smem);
#ifdef DUP_MASK
    if (ph > ph_begin) {
      const int sub = (ph >= 1 && ph < NPH - 1) ? (ph - 1) % 7 : -1, layer = (ph - 1) / 7;
      bool dup = false;
      if ((DUP_MASK & 1) && sub == 2 && (layer & 1)) dup = true;
      if ((DUP_MASK & 2) && (sub == 1 || sub == 5)) dup = true;
      if ((DUP_MASK & 4) && sub == 2 && !(layer & 1)) dup = true;
      if ((DUP_MASK & 8) && (sub == 0 || sub == 4)) dup = true;
      if (dup) { ++k; grid_barrier(bar, xcc, k, nloc, nx); run_phase(p, ph | DUP_FLAG, smem); }
    }
#endif
    if (use_sync && ph + 1 < ph_end) {
      if (ph == ph_begin) {
        grid.sync();
        if (threadIdx.x == 0) {
          unsigned cnt = 0;
          for (int j = 0; j < 16; ++j) cnt += __hip_atomic_load(&bar[j * 64], __ATOMIC_RELAXED, __HIP_MEMORY_SCOPE_AGENT) ? 1u : 0u;
          s_cnt[0] = __hip_atomic_load(&bar[xcc * 64], __ATOMIC_RELAXED, __HIP_MEMORY_SCOPE_AGENT);
          s_cnt[1] = cnt;
        }
        __syncthreads();
        nloc = __builtin_amdgcn_readfirstlane(s_cnt[0]); nx = __builtin_amdgcn_readfirstlane(s_cnt[1]);
      } else {
        ++k;
        grid_barrier(bar, xcc, k, nloc, nx);
      }
    }
  }
}

extern "C" void kernel_launch(void* const* d_in, const int* in_sizes, int n_in, void* d_out, int out_size, void* d_ws,
                              size_t ws_size, hipStream_t stream) {
  Params p{};
  for (int i = 0; i < 22; ++i) p.in[i] = (const float*)d_in[i];
  p.outp = (float*)d_out;
  p.ws = (char*)d_ws;
  if (WS_NEED + 16384 > ws_size || n_in < 22) return;
  static int grid_blocks = 0;
  if (!grid_blocks) {
    int dev = 0, cus = 0, per_cu = 0;
    hipGetDevice(&dev);
    hipDeviceGetAttribute(&cus, hipDeviceAttributeMultiprocessorCount, dev);
    hipOccupancyMaxActiveBlocksPerMultiprocessor(&per_cu, mega, 256, 0);
    if (per_cu > 2) per_cu = 2;
    if (per_cu < 1) per_cu = 1;
    grid_blocks = cus * per_cu;
  }
#if MULTI_LAUNCH
  for (int ph = 0; ph < NPH; ++ph) mega<<<grid_blocks, 256, 0, stream>>>(p, ph, ph + 1, 0);
#else
  hipMemsetAsync((char*)d_ws + WS_NEED, 0, 16384, stream);
  int b = 0, e = NPH, s = 1;
  void* args[] = {&p, &b, &e, &s};
  hipError_t err = hipLaunchCooperativeKernel((void*)mega, dim3(grid_blocks), dim3(256), args, 0, stream);
  if (err != hipSuccess) fprintf(stderr, "cooperative launch failed: %s (grid %d)\n", hipGetErrorString(err), grid_blocks);
#endif
}
```

```cpp
#include <hip/hip_runtime.h>
#include <hip/hip_cooperative_groups.h>
#include <cstdio>
namespace cg = cooperative_groups;

#ifndef DUP_FLAG
#define DUP_FLAG 0
#endif
#ifndef MULTI_LAUNCH
#define MULTI_LAUNCH 0
#endif

typedef unsigned short u16;
using bf16x8 = __attribute__((ext_vector_type(8))) short;
using f32x4 = __attribute__((ext_vector_type(4))) float;
using u32x4 = __attribute__((ext_vector_type(4))) unsigned;

constexpr int D = 1024, NB = 8, SEQ = 2048, CTX = 256, DEPTH = 4;
constexpr int TL = NB * SEQ;
constexpr int TCX = NB * CTX;
constexpr int T = TL + TCX;
constexpr int FH = 2816;
constexpr int KEYS = CTX + SEQ;
constexpr int NPH = 2 + 6 + 5 * (DEPTH - 1);
constexpr float EPS = 1e-6f;

constexpr size_t al256(size_t x) { return (x + 255) & ~(size_t)255; }
constexpr size_t OFF_WPW1 = 0;
constexpr size_t OFF_WPW2 = OFF_WPW1 + al256((size_t)2 * 2048 * 1024 * 2);
constexpr size_t OFF_WQKV = OFF_WPW2 + al256((size_t)2 * 1024 * 1024 * 2);
constexpr size_t OFF_WO = OFF_WQKV + al256((size_t)2 * 3072 * 1024 * 2);
constexpr size_t OFF_WFIN = OFF_WO + al256((size_t)2 * 1024 * 1024 * 2);
constexpr size_t OFF_WFOUT = OFF_WFIN + al256((size_t)4 * 5632 * 1024 * 2);
constexpr size_t OFF_H = OFF_WFOUT + al256((size_t)4 * 1024 * FH * 2);
constexpr size_t OFF_NBUF = OFF_H + al256((size_t)T * 1024 * 4);
constexpr size_t OFF_BIG = OFF_NBUF + al256((size_t)T * 1024 * 2);
constexpr size_t OFF_VBUF = OFF_BIG + al256((size_t)T * 3072 * 2);
constexpr size_t OFF_MODV = OFF_VBUF + al256((size_t)T * 1024 * 2);
constexpr size_t OFF_ROPE = OFF_MODV + al256((size_t)4 * 9 * 6144 * 4);
constexpr size_t OFF_ROWSS = OFF_ROPE + al256((size_t)1024 * 8);
constexpr size_t OFF_CVEC = OFF_ROWSS + al256((size_t)8 * T * 4);
constexpr size_t WS_NEED = OFF_CVEC + al256((size_t)8 * 9 * 5632 * 4);

struct Params {
  const float* in[22];
  float* outp;
  char* ws;
  __device__ __forceinline__ const float* x() const { return in[0]; }
  __device__ __forceinline__ const float* c() const { return in[1]; }
  __device__ __forceinline__ const float* ctx() const { return in[2]; }
  __device__ __forceinline__ const float* c_ctx() const { return in[3]; }
  __device__ __forceinline__ const float* mod_w() const { return in[4]; }
  __device__ __forceinline__ const float* mod_b() const { return in[5]; }
  __device__ __forceinline__ const float* norm_g() const { return in[6]; }
  __device__ __forceinline__ const float* pw1_w() const { return in[7]; }
  __device__ __forceinline__ const float* pw1_b() const { return in[8]; }
  __device__ __forceinline__ const float* dw_w() const { return in[9]; }
  __device__ __forceinline__ const float* dw_b() const { return in[10]; }
  __device__ __forceinline__ const float* ln_g() const { return in[11]; }
  __device__ __forceinline__ const float* ln_b() const { return in[12]; }
  __device__ __forceinline__ const float* pw2_w() const { return in[13]; }
  __device__ __forceinline__ const float* pw2_b() const { return in[14]; }
  __device__ __forceinline__ const float* wqkv() const { return in[15]; }
  __device__ __forceinline__ const float* lam() const { return in[16]; }
  __device__ __forceinline__ const float* subln() const { return in[17]; }
  __device__ __forceinline__ const float* wo() const { return in[18]; }
  __device__ __forceinline__ const float* ffn_in() const { return in[19]; }
  __device__ __forceinline__ const float* ffn_out() const { return in[20]; }
  __device__ __forceinline__ const float* final_g() const { return in[21]; }
  __device__ __forceinline__ float* out() const { return outp; }
  __device__ __forceinline__ u16* w_pw1() const { return (u16*)(ws + OFF_WPW1); }
  __device__ __forceinline__ u16* w_pw2() const { return (u16*)(ws + OFF_WPW2); }
  __device__ __forceinline__ u16* w_qkv() const { return (u16*)(ws + OFF_WQKV); }
  __device__ __forceinline__ u16* w_o() const { return (u16*)(ws + OFF_WO); }
  __device__ __forceinline__ u16* w_fin() const { return (u16*)(ws + OFF_WFIN); }
  __device__ __forceinline__ u16* w_fout() const { return (u16*)(ws + OFF_WFOUT); }
  __device__ __forceinline__ float* h() const { return (float*)(ws + OFF_H); }
  __device__ __forceinline__ u16* nbuf() const { return (u16*)(ws + OFF_NBUF); }
  __device__ __forceinline__ u16* big() const { return (u16*)(ws + OFF_BIG); }
  __device__ __forceinline__ u16* vbuf() const { return (u16*)(ws + OFF_VBUF); }
  __device__ __forceinline__ float* modv() const { return (float*)(ws + OFF_MODV); }
  __device__ __forceinline__ float2* rope() const { return (float2*)(ws + OFF_ROPE); }
  __device__ __forceinline__ float* rowss() const { return (float*)(ws + OFF_ROWSS); }
  __device__ __forceinline__ float* cvec() const { return (float*)(ws + OFF_CVEC); }
};

typedef __bf16 bf2v __attribute__((ext_vector_type(2)));
typedef float f2v __attribute__((ext_vector_type(2)));
__device__ __forceinline__ unsigned pack2(float a, float b) {
  f2v v = {a, b};
  bf2v r = __builtin_convertvector(v, bf2v);
  return *(unsigned*)&r;
}
__device__ __forceinline__ u16 f2bf(float f) { return (u16)(pack2(f, 0.f) & 0xffffu); }
__device__ __forceinline__ float bf2f(unsigned v) { return __uint_as_float(v << 16); }
__device__ __forceinline__ int tile_off(int row, int chunk) { return row * 128 + (((chunk ^ row) & 7) << 4); }
__device__ __forceinline__ float fexp2(float x) { return __builtin_amdgcn_exp2f(x); }
__device__ __forceinline__ float sigmoidf_(float x) { return __builtin_amdgcn_rcpf(1.f + __expf(-x)); }

__device__ __forceinline__ int otid() { int t = threadIdx.x; asm volatile("" : "+v"(t)); return t; }

struct WDesc { const float* sp; u16* dp; int N, K; };
__device__ __forceinline__ WDesc wconv_decode(const Params& p, int item, int tid) {
  int K, N, half = 0, tpl, ntN, base;
  const float* src; u16* dst;
  if (item < 1024)      { base = 0;    K = 1024; N = 2048; half = 1024; tpl = 512;  ntN = 32; src = p.pw1_w();  dst = p.w_pw1(); }
  else if (item < 1536) { base = 1024; K = 1024; N = 1024;              tpl = 256;  ntN = 16; src = p.pw2_w();  dst = p.w_pw2(); }
  else if (item < 3072) { base = 1536; K = 1024; N = 3072;              tpl = 768;  ntN = 48; src = p.wqkv();   dst = p.w_qkv(); }
  else if (item < 3584) { base = 3072; K = 1024; N = 1024;              tpl = 256;  ntN = 16; src = p.wo();     dst = p.w_o(); }
  else if (item < 9216) { base = 3584; K = 1024; N = 5632; half = 2816; tpl = 1408; ntN = 88; src = p.ffn_in(); dst = p.w_fin(); }
  else                  { base = 9216; K = 2816; N = 1024;              tpl = 704;  ntN = 16; src = p.ffn_out(); dst = p.w_fout(); }
  const int it = item - base;
  const int l = it / tpl, rem = it % tpl, kt = rem / ntN, nt = rem % ntN;
  src += (size_t)l * K * N; dst += (size_t)l * K * N;
  const int nl = tid & 63, kk0 = tid >> 6;
  const int np = nt * 64 + nl;
  int sc = np;
  if (half) { int blk = np >> 5, w = np & 31; sc = blk * 16 + (w & 15) + ((w >> 4) ? half : 0); }
  WDesc d;
  d.sp = src + (size_t)(kt * 64 + kk0) * N + sc;
  d.dp = dst + (size_t)(nt * 64 + (tid >> 2)) * K + kt * 64 + (tid & 3) * 16;
  d.N = N; d.K = K;
  return d;
}

__device__ void wconv_loop(const Params& p, char* smem) {
  float* tl = (float*)smem;
  const int tid = otid();
  const int nl = tid & 63, kk0 = tid >> 6, nl2 = tid >> 2, kq = tid & 3;
  int item = blockIdx.x;
  if (item >= 12032) return;
  float v[16];
  WDesc d = wconv_decode(p, item, tid);
#pragma unroll
  for (int i = 0; i < 16; ++i) v[i] = d.sp[(size_t)(4 * i) * d.N];
  for (; item < 12032; item += gridDim.x) {
#pragma unroll
    for (int i = 0; i < 16; ++i) tl[(kk0 + 4 * i) * 65 + nl] = v[i];
    u16* dp = d.dp;
    const int nxt = item + gridDim.x;
    if (nxt < 12032) {
      d = wconv_decode(p, nxt, tid);
#pragma unroll
      for (int i = 0; i < 16; ++i) v[i] = d.sp[(size_t)(4 * i) * d.N];
    }
    __syncthreads();
    unsigned pk[8];
#pragma unroll
    for (int e = 0; e < 8; ++e) pk[e] = pack2(tl[(kq * 16 + 2 * e) * 65 + nl2], tl[(kq * 16 + 2 * e + 1) * 65 + nl2]);
    ((uint4*)dp)[0] = make_uint4(pk[0], pk[1], pk[2], pk[3]);
    ((uint4*)dp)[1] = make_uint4(pk[4], pk[5], pk[6], pk[7]);
    __syncthreads();
  }
}

__device__ void prologue_phase(const Params& p, char* smem) {
  const int tid = otid(), wid = tid >> 6, lane = tid & 63;
  if (blockIdx.x < 384) {
    float* s = (float*)smem;
    float* red = (float*)(smem + 36864);
    for (int idx = tid; idx < 9 * 1024; idx += 256) {
      int r = idx >> 10, k = idx & 1023;
      float cv = r < 8 ? p.c()[r * 1024 + k] : p.c_ctx()[k];
      s[idx] = cv * sigmoidf_(cv);
    }
    __syncthreads();
    for (int item = blockIdx.x; item < 384; item += gridDim.x) {
      int i = item / 96, cgp = item % 96;
      float a[9];
#pragma unroll
      for (int r = 0; r < 9; ++r) a[r] = 0.f;
      const float* wp = p.mod_w() + ((size_t)i * 1024 + wid * 256) * 6144 + cgp * 64 + lane;
#pragma unroll 4
      for (int k4 = 0; k4 < 256; k4 += 4) {
        float w0 = wp[(size_t)(k4 + 0) * 6144], w1 = wp[(size_t)(k4 + 1) * 6144];
        float w2 = wp[(size_t)(k4 + 2) * 6144], w3 = wp[(size_t)(k4 + 3) * 6144];
#pragma unroll
        for (int r = 0; r < 9; ++r) {
          float4 sv = *(const float4*)&s[r * 1024 + wid * 256 + k4];
          a[r] += sv.x * w0 + sv.y * w1 + sv.z * w2 + sv.w * w3;
        }
      }
#pragma unroll
      for (int r = 0; r < 9; ++r) red[(wid * 9 + r) * 64 + lane] = a[r];
      __syncthreads();
      for (int idx = tid; idx < 9 * 64; idx += 256) {
        int r = idx >> 6, l = idx & 63;
        float v = red[(0 * 9 + r) * 64 + l] + red[(1 * 9 + r) * 64 + l] + red[(2 * 9 + r) * 64 + l] + red[(3 * 9 + r) * 64 + l];
        v += p.mod_b()[i * 6144 + cgp * 64 + l];
        p.modv()[((size_t)i * 9 + r) * 6144 + cgp * 64 + l] = v;
      }
      __syncthreads();
    }
  }
  if (blockIdx.x == gridDim.x - 1) {
    for (int idx = tid; idx < 1024; idx += 256) {
      int pos = idx >> 4, f = idx & 15;
      float inv = powf(10000.f, -(float)f / 16.f);
      float ang = (float)pos * inv;
      p.rope()[idx] = make_float2(cosf(ang), sinf(ang));
    }
  }
  wconv_loop(p, smem);
  for (int idx = blockIdx.x * 256 + tid; idx < 8 * T; idx += gridDim.x * 256) p.rowss()[idx] = 0.f;
  {
    const float4* x4 = (const float4*)p.x(); const float4* c4 = (const float4*)p.ctx(); float4* h4 = (float4*)p.h();
    for (int idx = blockIdx.x * 256 + tid; idx < T * 256; idx += gridDim.x * 256)
      h4[idx] = idx < TL * 256 ? x4[idx] : c4[idx - TL * 256];
  }
}

__device__ void norm_phase(const Params& p, int layer, int which, int M) {
  const int tid = otid(), wid = tid >> 6, lane = tid & 63;
  const int inst = layer * 2 + which;
  const float* g = p.norm_g() + inst * 1024;
  const int stride = gridDim.x * 4;
  const int co = (which ? 4 : 1) * 1024;
  float* rs = p.rowss() + (size_t)inst * T;
  for (int row = blockIdx.x * 4 + wid; row < M; row += 2 * stride) {
    const int rowB = row + stride;
    const bool hasB = rowB < M;
    const int rB = hasB ? rowB : row;
    const float4* hpA = (const float4*)(p.h() + (size_t)row * 1024);
    const float4* hpB = (const float4*)(p.h() + (size_t)rB * 1024);
    float4 va[4], vb[4];
#pragma unroll
    for (int i = 0; i < 4; ++i) { va[i] = hpA[lane + 64 * i]; vb[i] = hpB[lane + 64 * i]; }
    float sa = 0.f, sb = 0.f;
#pragma unroll
    for (int i = 0; i < 4; ++i) {
      sa += va[i].x * va[i].x + va[i].y * va[i].y + va[i].z * va[i].z + va[i].w * va[i].w;
      sb += vb[i].x * vb[i].x + vb[i].y * vb[i].y + vb[i].z * vb[i].z + vb[i].w * vb[i].w;
    }
#pragma unroll
    for (int o = 32; o >= 1; o >>= 1) { sa += __shfl_xor(sa, o); sb += __shfl_xor(sb, o); }
    if (lane == 0) { rs[row] = sa; if (hasB) rs[rB] = sb; }
    const int ra = row < TL ? row / SEQ : 8, rb = rB < TL ? rB / SEQ : 8;
    const float* mva = p.modv() + ((size_t)layer * 9 + ra) * 6144 + co;
    const float* mvb = p.modv() + ((size_t)layer * 9 + rb) * 6144 + co;
    uint2* opA = (uint2*)(p.nbuf() + (size_t)row * 1024);
    uint2* opB = (uint2*)(p.nbuf() + (size_t)rB * 1024);
#pragma unroll
    for (int i = 0; i < 4; ++i) {
      const int c4 = lane + 64 * i;
      const float4 gg = ((const float4*)g)[c4];
      {
        const float4 s4 = ((const float4*)mva)[c4];
        opA[c4] = make_uint2(pack2(va[i].x * gg.x * (1.f + s4.x), va[i].y * gg.y * (1.f + s4.y)),
                             pack2(va[i].z * gg.z * (1.f + s4.z), va[i].w * gg.w * (1.f + s4.w)));
      }
      if (hasB) {
        const float4 s4 = ((const float4*)mvb)[c4];
        opB[c4] = make_uint2(pack2(vb[i].x * gg.x * (1.f + s4.x), vb[i].y * gg.y * (1.f + s4.y)),
                             pack2(vb[i].z * gg.z * (1.f + s4.z), vb[i].w * gg.w * (1.f + s4.w)));
      }
    }
  }
}

__device__ void cvec_phase(const Params& p, char* smem) {
  const int tid = otid(), wid = tid >> 6, lane = tid & 63;
  float* sh = (float*)smem;
  for (int vb = blockIdx.x; vb < 512; vb += gridDim.x) {
    int inst = 0, rem = vb;
#pragma unroll 1
    for (; inst < 8; ++inst) {
      const int nb = (inst & 1) ? 88 : (((inst >> 1) & 1) ? 48 : 32);
      if (rem < nb) break;
      rem -= nb;
    }
    const int l = inst >> 1, which = inst & 1;
    const u16* Bt;
    if (which) Bt = p.w_fin() + (size_t)l * 5632 * 1024;
    else if ((l & 1) == 0) Bt = p.w_pw1() + (size_t)(l >> 1) * 2048 * 1024;
    else Bt = p.w_qkv() + (size_t)(l >> 1) * 3072 * 1024;
    const int so = (which ? 3 : 0) * 1024;
    for (int idx = tid; idx < 9 * 1024; idx += 256) sh[idx] = p.modv()[((size_t)l * 9 + (idx >> 10)) * 6144 + so + (idx & 1023)];
    __syncthreads();
    float* cv = p.cvec() + (size_t)inst * 9 * 5632;
    const int n0 = rem * 64 + wid * 16;
#pragma unroll 1
    for (int g4i = 0; g4i < 4; ++g4i) {
      u32x4 w0[4], w1[4];
#pragma unroll
      for (int q = 0; q < 4; ++q) {
        const u16* rp = Bt + (size_t)(n0 + g4i * 4 + q) * 1024 + lane * 16;
        w0[q] = *(const u32x4*)rp; w1[q] = *(const u32x4*)(rp + 8);
      }
#pragma unroll
      for (int q = 0; q < 4; ++q) {
        float wf[16];
#pragma unroll
        for (int e = 0; e < 4; ++e) {
          wf[2 * e] = bf2f(w0[q][e] & 0xffffu); wf[2 * e + 1] = bf2f(w0[q][e] >> 16);
          wf[8 + 2 * e] = bf2f(w1[q][e] & 0xffffu); wf[8 + 2 * e + 1] = bf2f(w1[q][e] >> 16);
        }
        float acc9[9];
#pragma unroll
        for (int r = 0; r < 9; ++r) {
          const float4* sp = (const float4*)(sh + r * 1024 + lane * 16);
          float a = 0.f;
#pragma unroll
          for (int k4 = 0; k4 < 4; ++k4) {
            const float4 sv = sp[k4];
            a += sv.x * wf[4 * k4] + sv.y * wf[4 * k4 + 1] + sv.z * wf[4 * k4 + 2] + sv.w * wf[4 * k4 + 3];
          }
          acc9[r] = a;
        }
#pragma unroll
        for (int o = 32; o >= 1; o >>= 1)
#pragma unroll
          for (int r = 0; r < 9; ++r) acc9[r] += __shfl_xor(acc9[r], o);
        if (lane == 0) {
#pragma unroll
          for (int r = 0; r < 9; ++r) cv[(size_t)r * 5632 + n0 + g4i * 4 + q] = acc9[r];
        }
      }
    }
    __syncthreads();
  }
}

__device__ void final_phase(const Params& p) {
  const int tid = otid(), wid = tid >> 6, lane = tid & 63;
  for (int row = blockIdx.x * 4 + wid; row < TL; row += gridDim.x * 4) {
    const float4* hp = (const float4*)(p.h() + (size_t)row * 1024);
    float4 v[4];
    float ss = 0.f;
#pragma unroll
    for (int i = 0; i < 4; ++i) { v[i] = hp[lane + 64 * i]; ss += v[i].x * v[i].x + v[i].y * v[i].y + v[i].z * v[i].z + v[i].w * v[i].w; }
#pragma unroll
    for (int o = 32; o >= 1; o >>= 1) ss += __shfl_xor(ss, o);
    float rstd = rsqrtf(ss * (1.f / 1024.f) + EPS);
    float4* op = (float4*)(p.out() + (size_t)row * 1024);
#pragma unroll
    for (int i = 0; i < 4; ++i) {
      int c4 = lane + 64 * i;
      float4 gg = ((const float4*)p.final_g())[c4];
      float4 ov = make_float4(v[i].x * rstd * gg.x, v[i].y * rstd * gg.y, v[i].z * rstd * gg.z, v[i].w * rstd * gg.w);
      op[c4] = ov;
    }
  }
}

template <int K, int EPI>
__device__ __forceinline__ void gemm_run(const Params& p, const u16* __restrict__ A, const u16* __restrict__ Bt,
                          int Mt, int Nt, int layer, int gidx, int ninst, const float* __restrict__ bias, char* smem) {
  const int tid = otid(), wid = tid >> 6, lane = tid & 63, wr = wid >> 1, wc = wid & 1, fr = lane & 15, fq = lane >> 4;
  const int xcd = blockIdx.x & 7, rank = blockIdx.x >> 3, rpx = gridDim.x >> 3;
  const int SN = (Nt & 7) == 0 ? 8 : 4, SM = 64 / SN;
  const int nsn = Nt / SN, total_s = (Mt / SM) * nsn;
  const int cq = rank < 64 ? (64 - rank + rpx - 1) / rpx : 0;
  const int nsx = xcd < total_s ? (total_s - xcd + 7) / 8 : 0;
  const int ntile = cq * nsx;
  if (ntile == 0) return;
#define TILE_MN(i_, mt_, nt_)                                              \
  {                                                                        \
    const int si_ = (i_) / cq, qi_ = (i_) - si_ * cq;                      \
    const int sidx_ = xcd + 8 * si_, q_ = rank + rpx * qi_;                \
    const int ms_ = sidx_ / nsn, ns_ = sidx_ - ms_ * nsn;                  \
    mt_ = ms_ * SM + q_ / SN;                                              \
    nt_ = ns_ * SN + q_ % SN;                                              \
  }
  constexpr int nk = K / 64;
  const int lrow = tid >> 3, lc = tid & 7;
  const int toff = lrow * K + lc * 8;
  const int loff = tile_off(lrow, lc);
  const int aoff = tile_off(wr * 64 + fr, fq);
  const int boff = tile_off(wc * 64 + fr, fq);
  u32x4 ra0_0, ra1_0, ra2_0, ra3_0, rb0_0, rb1_0, rb2_0, rb3_0;
#define GLD(dst, ptr) dst = *(const u32x4*)(ptr)
#define G_LOAD(S, ko)                          \
  GLD(ra0_##S, pa + 0 * 32 * K + (ko));        \
  GLD(ra1_##S, pa + 1 * 32 * K + (ko));        \
  GLD(ra2_##S, pa + 2 * 32 * K + (ko));        \
  GLD(ra3_##S, pa + 3 * 32 * K + (ko));        \
  GLD(rb0_##S, pb + 0 * 32 * K + (ko));        \
  GLD(rb1_##S, pb + 1 * 32 * K + (ko));        \
  GLD(rb2_##S, pb + 2 * 32 * K + (ko));        \
  GLD(rb3_##S, pb + 3 * 32 * K + (ko));
#define VMWAIT(N, S)
#define L_STORE(S, base)                                                \
  *(u32x4*)((base) + loff + 0 * 4096) = ra0_##S;                          \
  *(u32x4*)((base) + loff + 1 * 4096) = ra1_##S;                          \
  *(u32x4*)((base) + loff + 2 * 4096) = ra2_##S;                          \
  *(u32x4*)((base) + loff + 3 * 4096) = ra3_##S;                          \
  *(u32x4*)((base) + 16384 + loff + 0 * 4096) = rb0_##S;                  \
  *(u32x4*)((base) + 16384 + loff + 1 * 4096) = rb1_##S;                  \
  *(u32x4*)((base) + 16384 + loff + 2 * 4096) = rb2_##S;                  \
  *(u32x4*)((base) + 16384 + loff + 3 * 4096) = rb3_##S;
#define DMA1(sbase, m0v) asm volatile("s_mov_b32 m0, %2\n\ts_nop 0\n\tglobal_load_lds_dwordx4 %0, %1" ::"v"(dvoff), "s"(sbase), "s"(m0v) : "memory", "m0")
#define DMA_LOAD(sb, ko)                                   \
  DMA1(Au + 0 * 32 * K + (ko), (sb) + 0 * 4096);           \
  DMA1(Au + 1 * 32 * K + (ko), (sb) + 1 * 4096);           \
  DMA1(Au + 2 * 32 * K + (ko), (sb) + 2 * 4096);           \
  DMA1(Au + 3 * 32 * K + (ko), (sb) + 3 * 4096);           \
  DMA1(Bu + 0 * 32 * K + (ko), (sb) + 16384 + 0 * 4096);   \
  DMA1(Bu + 1 * 32 * K + (ko), (sb) + 16384 + 1 * 4096);   \
  DMA1(Bu + 2 * 32 * K + (ko), (sb) + 16384 + 2 * 4096);   \
  DMA1(Bu + 3 * 32 * K + (ko), (sb) + 16384 + 3 * 4096);
#define MMA_TILE_DB(As_, Bs_)                                                                        \
  {                                                                                               \
    bf16x8 a0[4], b0[4], a1[4], b1[4];                                                            \
    __builtin_amdgcn_s_setprio(1);                                                                \
    _Pragma("unroll") for (int mi = 0; mi < 4; ++mi) a0[mi] = *(const bf16x8*)((As_) + aoff + mi * 2048);        \
    _Pragma("unroll") for (int ni = 0; ni < 4; ++ni) b0[ni] = *(const bf16x8*)((Bs_) + boff + ni * 2048);        \
    _Pragma("unroll") for (int mi = 0; mi < 4; ++mi) a1[mi] = *(const bf16x8*)((As_) + (aoff ^ 64) + mi * 2048); \
    _Pragma("unroll") for (int ni = 0; ni < 4; ++ni) b1[ni] = *(const bf16x8*)((Bs_) + (boff ^ 64) + ni * 2048); \
    __builtin_amdgcn_sched_barrier(0);                                                            \
    _Pragma("unroll") for (int mi = 0; mi < 4; ++mi)                                              \
      _Pragma("unroll") for (int ni = 0; ni < 4; ++ni)                                            \
        acc[mi][ni] = __builtin_amdgcn_mfma_f32_16x16x32_bf16(a0[mi], b0[ni], acc[mi][ni], 0, 0, 0); \
    _Pragma("unroll") for (int mi = 0; mi < 4; ++mi)                                              \
      _Pragma("unroll") for (int ni = 0; ni < 4; ++ni)                                            \
        acc[mi][ni] = __builtin_amdgcn_mfma_f32_16x16x32_bf16(a1[mi], b1[ni], acc[mi][ni], 0, 0, 0); \
    __builtin_amdgcn_s_setprio(0);                                                                \
  }
#define MMA_TILE_N(As_, Bs_)                                                                      \
  __builtin_amdgcn_s_setprio(1);                                                                  \
  _Pragma("unroll") for (int ks = 0; ks < 2; ++ks) {                                              \
    bf16x8 af[4], bfr[4];                                                                         \
    _Pragma("unroll") for (int mi = 0; mi < 4; ++mi) af[mi] = *(const bf16x8*)((As_) + (aoff ^ (ks << 6)) + mi * 2048);  \
    _Pragma("unroll") for (int ni = 0; ni < 4; ++ni) bfr[ni] = *(const bf16x8*)((Bs_) + (boff ^ (ks << 6)) + ni * 2048); \
    _Pragma("unroll") for (int mi = 0; mi < 4; ++mi)                                              \
      _Pragma("unroll") for (int ni = 0; ni < 4; ++ni)                                            \
        acc[mi][ni] = __builtin_amdgcn_mfma_f32_16x16x32_bf16(af[mi], bfr[ni], acc[mi][ni], 0, 0, 0); \
  }                                                                                               \
  __builtin_amdgcn_s_setprio(0);
#define MMA_TILE(As_, Bs_)                         \
  if constexpr (EPI == 1) { MMA_TILE_N(As_, Bs_) } \
  else { MMA_TILE_DB(As_, Bs_) }
  int mt, nt;
  TILE_MN(0, mt, nt)
  const u16* pa = A + (size_t)mt * 128 * K + toff;
  const u16* pb = Bt + (size_t)nt * 128 * K + toff;
  G_LOAD(0, 0)
#pragma unroll 1
  for (int ti = 0; ti < ntile; ++ti) {
  const int brow = mt * 128, bcol = nt * 128;
  f32x4 acc[4][4];
#pragma unroll
  for (int i = 0; i < 4; ++i)
#pragma unroll
    for (int j = 0; j < 4; ++j) acc[i][j] = f32x4{0.f, 0.f, 0.f, 0.f};
  L_STORE(0, smem)
  __syncthreads();
  {
    const unsigned dvoff = (unsigned)(lrow * K + ((lc ^ lrow) & 7) * 8) * 2u;
    const u16* Au = A + (size_t)mt * 128 * K;
    const u16* Bu = Bt + (size_t)nt * 128 * K;
    const unsigned sm0 = __builtin_amdgcn_readfirstlane((unsigned)(size_t)smem) + __builtin_amdgcn_readfirstlane(wid) * 1024u;
#pragma unroll 2
    for (int kt = 0; kt < nk; ++kt) {
      const int cur = kt & 1;
      if (kt + 1 < nk) {
        const unsigned sb = sm0 + (unsigned)(cur ^ 1) * 32768u;
        DMA_LOAD(sb, (kt + 1) * 64)
      }
      __builtin_amdgcn_sched_barrier(0);
      MMA_TILE(smem + cur * 32768, smem + cur * 32768 + 16384)
      __builtin_amdgcn_sched_barrier(0);
      asm volatile("s_waitcnt vmcnt(0)" ::: "memory");
      __syncthreads();
    }
  }
  int mt2 = mt, nt2 = nt;
  if (ti + 1 < ntile) {
    TILE_MN(ti + 1, mt2, nt2)
    pa = A + (size_t)mt2 * 128 * K + toff;
    pb = Bt + (size_t)nt2 * 128 * K + toff;
    if constexpr (EPI != 1) { G_LOAD(0, 0) }
  }
  __builtin_amdgcn_sched_barrier(0);
  const int r0 = brow + wr * 64;
  char* stg = smem + wid * 16384;
  if constexpr (EPI == 0 || EPI == 3) {
    const int OW = (EPI == 0) ? 1024 : FH;
    u16* outp = p.big();
    const int jch0 = (bcol + wc * 64) >> 1;
    const float* rsp = p.rowss() + (size_t)ninst * T + r0 + fq * 4;
    const float* cvp = p.cvec() + ((size_t)ninst * 9 + (brow < TL ? brow / SEQ : 8)) * 5632 + bcol + wc * 64 + fr;
    float rstd[4][4];
#pragma unroll
    for (int mi = 0; mi < 4; ++mi)
#pragma unroll
      for (int j = 0; j < 4; ++j) rstd[mi][j] = rsqrtf(rsp[mi * 16 + j] * (1.f / 1024.f) + EPS);
#pragma unroll
    for (int pp = 0; pp < 2; ++pp) {
      float b0 = cvp[pp * 32], b1 = cvp[pp * 32 + 16];
      if (bias) { b0 += bias[jch0 + pp * 16 + fr]; b1 += bias[1024 + jch0 + pp * 16 + fr]; }
#pragma unroll
      for (int mi = 0; mi < 4; ++mi)
#pragma unroll
        for (int j = 0; j < 4; ++j) {
          float a = rstd[mi][j] * acc[mi][2 * pp][j] + b0, g = rstd[mi][j] * acc[mi][2 * pp + 1][j] + b1;
          float sg = sigmoidf_(EPI == 0 ? g : a);
          float v = (EPI == 0) ? a * sg : a * sg * g;
          *(u16*)(stg + (mi * 16 + fq * 4 + j) * 80 + (pp * 16 + fr) * 2) = f2bf(v);
        }
    }
    __syncthreads();
#pragma unroll
    for (int it = 0; it < 4; ++it) {
      const int row = it * 16 + (lane >> 2), ch = lane & 3;
      u32x4 val = *(const u32x4*)(stg + row * 80 + ch * 16);
      *(u32x4*)(outp + (size_t)(r0 + row) * OW + jch0 + ch * 8) = val;
    }
    __syncthreads();
  } else if constexpr (EPI == 2) {
    float* sf = (float*)stg;
#pragma unroll
    for (int mi = 0; mi < 4; ++mi)
#pragma unroll
      for (int ni = 0; ni < 4; ++ni)
#pragma unroll
        for (int j = 0; j < 4; ++j) sf[(mi * 16 + fq * 4 + j) * 64 + ((ni ^ fq) << 4) + fr] = acc[mi][ni][j];
    __syncthreads();
    {
      const int r = brow < TL ? brow / SEQ : 8;
      const int c = lane & 15, rsub = lane >> 4;
      const int col0 = bcol + wc * 64 + c * 4;
      const float4 g4 = *(const float4*)(p.modv() + ((size_t)layer * 9 + r) * 6144 + gidx * 1024 + col0);
      float4 b4 = make_float4(0.f, 0.f, 0.f, 0.f);
      if (bias) b4 = *(const float4*)(bias + col0);
      float* hrow = p.h() + (size_t)(r0 + rsub) * 1024 + col0;
      const float* srow = sf + rsub * 64 + (c & 3) * 4;
      u16* urow = p.nbuf() + (size_t)(r0 + rsub) * 1024 + col0;
      float* rsrow = p.rowss() + (size_t)(ninst < 0 ? 0 : ninst) * T + r0 + rsub;
      float4 gm4 = make_float4(0.f, 0.f, 0.f, 0.f);
      if (ninst >= 0) {
        const float4 ng4 = *(const float4*)(p.norm_g() + ninst * 1024 + col0);
        const float4 sc4 = *(const float4*)(p.modv() + ((size_t)(ninst >> 1) * 9 + r) * 6144 + ((ninst & 1) ? 4 : 1) * 1024 + col0);
        gm4 = make_float4(ng4.x * (1.f + sc4.x), ng4.y * (1.f + sc4.y), ng4.z * (1.f + sc4.z), ng4.w * (1.f + sc4.w));
      }
      float4 hv[16];
#pragma unroll
      for (int it = 0; it < 16; ++it) hv[it] = *(const float4*)(hrow + (size_t)it * 4096);
#pragma unroll
      for (int it = 0; it < 16; ++it) {
        const int u = it & 3;
        const int grp = (c >> 2) ^ u;
        const float4 a4 = *(const float4*)(srow + it * 256 + grp * 16);
        float4 v = hv[it];
        v.x += g4.x * (a4.x + b4.x); v.y += g4.y * (a4.y + b4.y); v.z += g4.z * (a4.z + b4.z); v.w += g4.w * (a4.w + b4.w);
        *(float4*)(hrow + (size_t)it * 4096) = v;
        if (ninst >= 0) {
          *(uint2*)(urow + (size_t)it * 4096) = make_uint2(pack2(v.x * gm4.x, v.y * gm4.y), pack2(v.z * gm4.z, v.w * gm4.w));
          float sq = v.x * v.x + v.y * v.y + v.z * v.z + v.w * v.w;
          sq += __shfl_xor(sq, 1); sq += __shfl_xor(sq, 2); sq += __shfl_xor(sq, 4); sq += __shfl_xor(sq, 8);
          if (c == 0) unsafeAtomicAdd(rsrow + it * 4, sq);
        }
      }
    }
    __syncthreads();
  } else {
    const int region = nt >> 3, hd = nt & 7;
    const bool lat = brow < TL;
    const int b = lat ? brow / SEQ : (brow - TL) / CTX;
    const int kb = lat ? 256 + (r0 - b * SEQ) : (r0 - TL - b * CTX);
    const size_t bh = (size_t)(b * 8 + hd);
    u16* qb = p.big(); u16* kbuf = p.big() + (size_t)T * 1024; u16* vt = p.big() + (size_t)T * 2048;
    {
      const float* rsp = p.rowss() + (size_t)ninst * T + r0 + fq * 4;
      const float* cvp = p.cvec() + ((size_t)ninst * 9 + (lat ? b : 8)) * 5632 + bcol + wc * 64 + fr;
      const float c0 = cvp[0], c1 = cvp[16], c2 = cvp[32], c3 = cvp[48];
#pragma unroll
      for (int mi = 0; mi < 4; ++mi)
#pragma unroll
        for (int j = 0; j < 4; ++j) {
          const float rsd = rsqrtf(rsp[mi * 16 + j] * (1.f / 1024.f) + EPS);
          acc[mi][0][j] = rsd * acc[mi][0][j] + c0; acc[mi][1][j] = rsd * acc[mi][1][j] + c1;
          acc[mi][2][j] = rsd * acc[mi][2][j] + c2; acc[mi][3][j] = rsd * acc[mi][3][j] + c3;
        }
    }
    if (region < 2) {
      u16* dst = (region == 0 ? qb : kbuf) + ((bh * 2 + wc) * KEYS + kb) * 64;
      const float qs = region == 0 ? 0.125f * 1.44269504088896f : 1.f;
#pragma unroll
      for (int mi = 0; mi < 4; ++mi)
#pragma unroll
        for (int j = 0; j < 4; ++j) {
          int rl = mi * 16 + fq * 4 + j;
          float x0 = acc[mi][0][j], x1 = acc[mi][1][j], x2 = acc[mi][2][j], x3 = acc[mi][3][j];
          if (lat) {
            int t = kb - 256 + rl;
            float2 cr = p.rope()[(t >> 6) * 16 + fr], cc = p.rope()[(t & 63) * 16 + fr];
            float y0 = x0 * cr.x - x1 * cr.y, y1 = x1 * cr.x + x0 * cr.y;
            float y2 = x2 * cc.x - x3 * cc.y, y3 = x3 * cc.x + x2 * cc.y;
            x0 = y0; x1 = y1; x2 = y2; x3 = y3;
          }
          char* sp = stg + rl * 144 + fr * 2;
          *(u16*)(sp) = f2bf(x0 * qs); *(u16*)(sp + 32) = f2bf(x1 * qs); *(u16*)(sp + 64) = f2bf(x2 * qs); *(u16*)(sp + 96) = f2bf(x3 * qs);
          if (j == 3) asm volatile("" ::: "memory");
        }
      __syncthreads();
#pragma unroll
      for (int it = 0; it < 8; ++it) {
        const int row = it * 8 + (lane >> 3), ch = lane & 7;
        u32x4 val = *(const u32x4*)(stg + row * 144 + ch * 16);
        *(u32x4*)(dst + (size_t)row * 64 + ch * 8) = val;
      }
      __syncthreads();
    } else {
#pragma unroll
      for (int ni = 0; ni < 4; ++ni) {
        const int e = ni * 16 + fr;
#pragma unroll
        for (int mi = 0; mi < 4; ++mi) {
          int slot = (mi >> 1) * 32 + fq * 8 + (mi & 1) * 4;
          *(uint2*)(stg + e * 144 + slot * 2) = make_uint2(pack2(acc[mi][ni][0], acc[mi][ni][1]), pack2(acc[mi][ni][2], acc[mi][ni][3]));
        }
      }
      __syncthreads();
      u16* dp = vt + (bh * 128 + wc * 64) * KEYS + kb;
#pragma unroll
      for (int it = 0; it < 8; ++it) {
        const int row = it * 8 + (lane >> 3), ch = lane & 7;
        u32x4 val = *(const u32x4*)(stg + row * 144 + ch * 16);
        *(u32x4*)(dp + (size_t)row * KEYS + ch * 8) = val;
      }
      __syncthreads();
    }
  }
  if constexpr (EPI == 1) { if (ti + 1 < ntile) { G_LOAD(0, 0) } }
  mt = mt2; nt = nt2;
  }
#undef GLD
#undef VMWAIT
#undef G_LOAD
#undef L_STORE
#undef MMA_TILE
#undef MMA_TILE_N
#undef MMA_TILE_DB
#undef DMA1
#undef DMA_LOAD
#undef TILE_MN
}

__device__ void gemm_phase(const Params& p, const u16* A, const u16* Bt, int K, int Mt, int Nt, int epi, int layer, int gidx,
                           int ninst, const float* bias, char* smem) {
  if (K != 1024) gemm_run<FH, 2>(p, A, Bt, Mt, Nt, layer, gidx, ninst, bias, smem);
  else if (epi == 0) gemm_run<1024, 0>(p, A, Bt, Mt, Nt, layer, gidx, ninst, bias, smem);
  else if (epi == 1) gemm_run<1024, 1>(p, A, Bt, Mt, Nt, layer, gidx, ninst, bias, smem);
  else if (epi == 2) gemm_run<1024, 2>(p, A, Bt, Mt, Nt, layer, gidx, ninst, bias, smem);
  else gemm_run<1024, 3>(p, A, Bt, Mt, Nt, layer, gidx, ninst, bias, smem);
}

__device__ void conv_phase(const Params& p, int j, int M, char* smem) {
  const int tid = otid(), wid = tid >> 6, lane = tid & 63;
  float* cbuf = (float*)smem;
  const u16* U = p.big();
  for (int item = blockIdx.x; item < M / 8; item += gridDim.x) {
    const int t0 = item * 8;
    int s0, s1;
    if (t0 < TL) { s0 = (t0 / SEQ) * SEQ; s1 = s0 + SEQ; } else { s0 = TL + ((t0 - TL) / CTX) * CTX; s1 = s0 + CTX; }
#pragma unroll 1
    for (int g = 0; g < 2; ++g) {
      const int c = g * 512 + tid * 2;
      float acc[8][2];
      float w[31][2];
#pragma unroll
      for (int k = 0; k < 31; ++k) { float2 wv = *(const float2*)(p.dw_w() + ((size_t)j * 31 + k) * 1024 + c); w[k][0] = wv.x; w[k][1] = wv.y; }
      float2 bv = *(const float2*)(p.dw_b() + j * 1024 + c);
#pragma unroll
      for (int o = 0; o < 8; ++o) { acc[o][0] = bv.x; acc[o][1] = bv.y; }
#pragma unroll
      for (int ti = 0; ti < 38; ++ti) {
        int tin = t0 - 15 + ti;
        bool valid = tin >= s0 && tin < s1;
        int tc = min(max(tin, s0), s1 - 1);
        unsigned raw = *(const unsigned*)(U + (size_t)tc * 1024 + c);
        if (!valid) raw = 0u;
        float x0 = bf2f(raw & 0xffffu), x1 = bf2f(raw >> 16);
#pragma unroll
        for (int o = 0; o < 8; ++o) {
          const int k = ti - o;
          if (k >= 0 && k < 31) { acc[o][0] += x0 * w[k][0]; acc[o][1] += x1 * w[k][1]; }
        }
      }
#pragma unroll
      for (int o = 0; o < 8; ++o) *(float2*)(cbuf + o * 1024 + c) = make_float2(acc[o][0], acc[o][1]);
    }
    __syncthreads();
#pragma unroll
    for (int tt = 0; tt < 2; ++tt) {
      const int o = wid * 2 + tt;
      float4 v[4];
      float sm = 0.f;
#pragma unroll
      for (int i = 0; i < 4; ++i) { v[i] = *(const float4*)(cbuf + o * 1024 + (lane + 64 * i) * 4); sm += v[i].x + v[i].y + v[i].z + v[i].w; }
#pragma unroll
      for (int sh = 32; sh >= 1; sh >>= 1) sm += __shfl_xor(sm, sh);
      const float mean = sm * (1.f / 1024.f);
      float sq = 0.f;
#pragma unroll
      for (int i = 0; i < 4; ++i) {
        v[i].x -= mean; v[i].y -= mean; v[i].z -= mean; v[i].w -= mean;
        sq += v[i].x * v[i].x + v[i].y * v[i].y + v[i].z * v[i].z + v[i].w * v[i].w;
      }
#pragma unroll
      for (int sh = 32; sh >= 1; sh >>= 1) sq += __shfl_xor(sq, sh);
      const float rstd = rsqrtf(sq * (1.f / 1024.f) + EPS);
      uint2* op = (uint2*)(p.vbuf() + (size_t)(t0 + o) * 1024);
#pragma unroll
      for (int i = 0; i < 4; ++i) {
        int c4 = lane + 64 * i;
        float4 lg = ((const float4*)(p.ln_g() + j * 1024))[c4], lb = ((const float4*)(p.ln_b() + j * 1024))[c4];
        float y0 = v[i].x * rstd * lg.x + lb.x, y1 = v[i].y * rstd * lg.y + lb.y;
        float y2 = v[i].z * rstd * lg.z + lb.z, y3 = v[i].w * rstd * lg.w + lb.w;
        y0 *= sigmoidf_(y0); y1 *= sigmoidf_(y1); y2 *= sigmoidf_(y2); y3 *= sigmoidf_(y3);
        op[c4] = make_uint2(pack2(y0, y1), pack2(y2, y3));
      }
    }
    __syncthreads();
  }
}

__device__ void attn_item(const Params& p, int b, int hd, int q0, int nkeys, int out_row0, float lam, float oscale,
                          const float* __restrict__ subg, char* smem) {
  const int tid = otid(), wid = tid >> 6, lane = tid & 63, fr = lane & 15, fq = lane >> 4;
  const int comp = wid & 1, qg = wid >> 1;
  const size_t bh = (size_t)(b * 8 + hd);
  const u16* qb = p.big(); const u16* kbuf = p.big() + (size_t)T * 1024; const u16* vtb = p.big() + (size_t)T * 2048;
  const u16* Qp = qb + ((bh * 2 + comp) * KEYS + q0 + qg * 32) * 64;
  bf16x8 qf[2][2];
#pragma unroll
  for (int qs = 0; qs < 2; ++qs)
#pragma unroll
    for (int ks = 0; ks < 2; ++ks) qf[qs][ks] = *(const bf16x8*)(Qp + (qs * 16 + fr) * 64 + ks * 32 + fq * 8);
  const u16* K1p = kbuf + (bh * 2 + 0) * KEYS * 64;
  const u16* K2p = kbuf + (bh * 2 + 1) * KEYS * 64;
  const u16* Vp = vtb + bh * 128 * KEYS;
  const int lrow = tid >> 3, lc = tid & 7;
  const unsigned swz8 = (unsigned)(((lc ^ lrow) & 7) * 8);
  const unsigned dvk = (unsigned)(lrow * 64) * 2u + swz8 * 2u;
  const unsigned dvv = (unsigned)(lrow * KEYS) * 2u + swz8 * 2u;
  const unsigned sm0 = __builtin_amdgcn_readfirstlane((unsigned)(size_t)smem) + __builtin_amdgcn_readfirstlane(wid) * 1024u;
#define ADMA(voff, sbase, m0v) asm volatile("s_mov_b32 m0, %2\n\ts_nop 0\n\tglobal_load_lds_dwordx4 %0, %1" ::"v"(voff), "s"(sbase), "s"(m0v) : "memory", "m0")
#define ATT_DMA(kt_, buf_)                                                                     \
  {                                                                                            \
    const int key0 = (kt_) * 64;                                                               \
    const unsigned sb_ = sm0 + (unsigned)(buf_) * 32768u;                                      \
    ADMA(dvk, K1p + (size_t)(key0) * 64, sb_);                                                 \
    ADMA(dvk, K1p + (size_t)(key0 + 32) * 64, sb_ + 4096u);                                    \
    ADMA(dvk, K2p + (size_t)(key0) * 64, sb_ + 8192u);                                         \
    ADMA(dvk, K2p + (size_t)(key0 + 32) * 64, sb_ + 12288u);                                   \
    ADMA(dvv, Vp + key0, sb_ + 16384u);                                                        \
    ADMA(dvv, Vp + (size_t)32 * KEYS + key0, sb_ + 20480u);                                    \
    ADMA(dvv, Vp + (size_t)64 * KEYS + key0, sb_ + 24576u);                                    \
    ADMA(dvv, Vp + (size_t)96 * KEYS + key0, sb_ + 28672u);                                    \
  }
  f32x4 O[8][2];
#pragma unroll
  for (int e = 0; e < 8; ++e) { O[e][0] = f32x4{0.f, 0.f, 0.f, 0.f}; O[e][1] = f32x4{0.f, 0.f, 0.f, 0.f}; }
  float m[2] = {-1e30f, -1e30f}, l[2] = {0.f, 0.f};
  const int ntile = nkeys >> 6;
  ATT_DMA(0, 0)
  asm volatile("s_waitcnt vmcnt(0)" ::: "memory");
  __syncthreads();
  for (int kt = 0; kt < ntile; ++kt) {
    const int cur = kt & 1;
    if (kt + 1 < ntile) ATT_DMA(kt + 1, cur ^ 1)
    const char* base = smem + cur * 32768;
    const char* Kc = base + comp * 8192;
    const char* Vt = base + 16384;
    f32x4 S[4][2];
#pragma unroll
    for (int i = 0; i < 4; ++i) { S[i][0] = f32x4{0.f, 0.f, 0.f, 0.f}; S[i][1] = f32x4{0.f, 0.f, 0.f, 0.f}; }
    __builtin_amdgcn_s_setprio(1);
    {
      bf16x8 kf[2][4];
#pragma unroll
      for (int ks = 0; ks < 2; ++ks)
#pragma unroll
        for (int ksub = 0; ksub < 4; ++ksub) kf[ks][ksub] = *(const bf16x8*)(Kc + tile_off(ksub * 16 + fr, ks * 4 + fq));
      __builtin_amdgcn_sched_barrier(0);
#pragma unroll
      for (int ks = 0; ks < 2; ++ks)
#pragma unroll
        for (int ksub = 0; ksub < 4; ++ksub)
#pragma unroll
          for (int qs = 0; qs < 2; ++qs) S[ksub][qs] = __builtin_amdgcn_mfma_f32_16x16x32_bf16(kf[ks][ksub], qf[qs][ks], S[ksub][qs], 0, 0, 0);
    }
    __builtin_amdgcn_s_setprio(0);
#pragma unroll
    for (int qs = 0; qs < 2; ++qs) {
      float mx = -1e30f;
#pragma unroll
      for (int ksub = 0; ksub < 4; ++ksub)
#pragma unroll
        for (int j = 0; j < 4; ++j) mx = fmaxf(mx, S[ksub][qs][j]);
      mx = fmaxf(mx, __shfl_xor(mx, 16));
      mx = fmaxf(mx, __shfl_xor(mx, 32));
      float mn = fmaxf(m[qs], mx);
      float alpha = fexp2(m[qs] - mn);
      m[qs] = mn;
      float rs = 0.f;
#pragma unroll
      for (int ksub = 0; ksub < 4; ++ksub)
#pragma unroll
        for (int j = 0; j < 4; ++j) { float pv = fexp2(S[ksub][qs][j] - mn); S[ksub][qs][j] = pv; rs += pv; }
      l[qs] = l[qs] * alpha + rs;
      if (__builtin_amdgcn_ballot_w64(alpha != 1.f) != 0) {
#pragma unroll
        for (int e = 0; e < 8; ++e) O[e][qs] *= alpha;
      }
    }
    bf16x8 pf[2][2];
#pragma unroll
    for (int qs = 0; qs < 2; ++qs)
#pragma unroll
      for (int s = 0; s < 2; ++s) {
        unsigned u0 = pack2(S[2 * s][qs][0], S[2 * s][qs][1]), u1 = pack2(S[2 * s][qs][2], S[2 * s][qs][3]);
        unsigned u2 = pack2(S[2 * s + 1][qs][0], S[2 * s + 1][qs][1]), u3 = pack2(S[2 * s + 1][qs][2], S[2 * s + 1][qs][3]);
        uint4 uu = make_uint4(u0, u1, u2, u3);
        pf[qs][s] = *(bf16x8*)&uu;
      }
    __builtin_amdgcn_s_setprio(1);
#pragma unroll
    for (int s = 0; s < 2; ++s) {
      bf16x8 vf[8];
#pragma unroll
      for (int e = 0; e < 8; ++e) vf[e] = *(const bf16x8*)(Vt + tile_off(e * 16 + fr, s * 4 + fq));
      __builtin_amdgcn_sched_barrier(0);
#pragma unroll
      for (int e = 0; e < 8; ++e)
#pragma unroll
        for (int qs = 0; qs < 2; ++qs) O[e][qs] = __builtin_amdgcn_mfma_f32_16x16x32_bf16(vf[e], pf[qs][s], O[e][qs], 0, 0, 0);
    }
    __builtin_amdgcn_s_setprio(0);
    asm volatile("s_waitcnt vmcnt(0)" ::: "memory");
    __syncthreads();
  }
#undef ATT_DMA
#undef ADMA
#pragma unroll
  for (int qs = 0; qs < 2; ++qs) {
    float ls = l[qs];
    ls += __shfl_xor(ls, 16);
    ls += __shfl_xor(ls, 32);
    float inv = (comp ? lam : 1.f) / ls;
#pragma unroll
    for (int e = 0; e < 8; ++e) O[e][qs] *= inv;
  }
  float* ex = (float*)smem;
  if (comp == 1) {
#pragma unroll
    for (int e = 0; e < 8; ++e)
#pragma unroll
      for (int qs = 0; qs < 2; ++qs) *(f32x4*)(ex + ((((qg * 8 + e) * 2 + qs) * 64 + lane) << 2)) = O[e][qs];
  }
  __syncthreads();
  if (comp == 0) {
#pragma unroll
    for (int qs = 0; qs < 2; ++qs) {
      float ssq = 0.f;
#pragma unroll
      for (int e = 0; e < 8; ++e) {
        f32x4 o2 = *(const f32x4*)(ex + ((((qg * 8 + e) * 2 + qs) * 64 + lane) << 2));
        O[e][qs] -= o2;
#pragma unroll
        for (int j = 0; j < 4; ++j) ssq += O[e][qs][j] * O[e][qs][j];
      }
      ssq += __shfl_xor(ssq, 16);
      ssq += __shfl_xor(ssq, 32);
      float rstd = rsqrtf(ssq * (1.f / 128.f) + EPS) * oscale;
      u16* op = p.vbuf() + (size_t)(out_row0 + qg * 32 + qs * 16 + fr) * 1024 + hd * 128 + fq * 4;
#pragma unroll
      for (int e = 0; e < 8; ++e) {
        float4 sg = *(const float4*)(subg + e * 16 + fq * 4);
        *(uint2*)(op + e * 16) = make_uint2(pack2(O[e][qs][0] * rstd * sg.x, O[e][qs][1] * rstd * sg.y),
                                            pack2(O[e][qs][2] * rstd * sg.z, O[e][qs][3] * rstd * sg.w));
      }
    }
  }
  __syncthreads();
}

__device__ void attn_phase(const Params& p, int layer, bool with_ctx, char* smem) {
  const int ja = layer >> 1;
  const float* lv = p.lam() + ja * 256;
  float d01 = 0.f, d23 = 0.f;
  for (int i = 0; i < 64; ++i) { d01 += lv[i] * lv[64 + i]; d23 += lv[128 + i] * lv[192 + i]; }
  const float lam_init = 0.8f - 0.6f * expf(-0.3f * (float)layer);
  const float lam = expf(d01) - expf(d23) + lam_init;
  const float* subg = p.subln() + ja * 128;
  {
    const int xcd = blockIdx.x & 7, rank = blockIdx.x >> 3, rpx = gridDim.x >> 3;
    for (int r = 0; r < 4; ++r)
      for (int q = rank; q < 64; q += rpx) {
        const int bh = r * 16 + xcd * 2 + (q >> 5), qt = q & 31;
        const int b = bh >> 3, hd = bh & 7;
        attn_item(p, b, hd, 256 + qt * 64, KEYS, b * SEQ + qt * 64, lam, 1.f - lam_init, subg, smem);
      }
  }
  if (with_ctx) {
    for (int it = blockIdx.x; it < 256; it += gridDim.x) {
      const int qt = it & 3, hd = (it >> 2) & 7, b = it >> 5;
      attn_item(p, b, hd, qt * 64, CTX, TL + b * CTX + qt * 64, lam, 1.f - lam_init, subg, smem);
    }
  }
}

__device__ void run_phase(const Params& p, int ph_in, char* smem) {
  const int ph = ph_in & 0xffff;
  if (ph == 0) { prologue_phase(p, smem); return; }
  if (ph == NPH - 1) { final_phase(p); return; }
  int layer, sub;
  if (ph <= 6) { layer = 0; const int t = ph - 1; sub = t < 4 ? t : t + 1; }
  else { const int t = ph - 7; layer = 1 + t / 5; const int jj = t % 5; sub = jj < 3 ? jj + 1 : jj + 2; }
  const bool last = layer == DEPTH - 1;
  const int M = last ? TL : T;
  const bool is_conv = (layer & 1) == 0;
  const int j = layer >> 1;
  if (sub == 0) { norm_phase(p, 0, 0, T); cvec_phase(p, smem); return; }
  if (sub == 2) {
    if (is_conv) conv_phase(p, j, T, smem);
    else attn_phase(p, layer, !last, smem);
    return;
  }
  const u16 *A, *Bt; int K = 1024, Nt, epi, gidx = 0, ninst = -1, mtiles = M / 128; const float* bias = nullptr;
  if (sub == 1) {
    A = p.nbuf(); mtiles = T / 128; ninst = layer * 2;
    if (is_conv) { Bt = p.w_pw1() + (size_t)j * 2048 * 1024; Nt = 16; epi = 0; bias = p.pw1_b() + j * 2048; }
    else { Bt = p.w_qkv() + (size_t)j * 3072 * 1024; Nt = 24; epi = 1; }
  } else if (sub == 3) {
    A = p.vbuf(); Nt = 8; epi = 2; gidx = 2; ninst = layer * 2 + 1;
    if (is_conv) { Bt = p.w_pw2() + (size_t)j * 1024 * 1024; bias = p.pw2_b() + j * 1024; }
    else Bt = p.w_o() + (size_t)j * 1024 * 1024;
  } else if (sub == 5) {
    A = p.nbuf(); Bt = p.w_fin() + (size_t)layer * 5632 * 1024; Nt = 44; epi = 3; ninst = layer * 2 + 1;
  } else {
    A = p.big(); Bt = p.w_fout() + (size_t)layer * 1024 * FH; K = FH; Nt = 8; epi = 2; gidx = 5;
    ninst = last ? -1 : (layer + 1) * 2;
  }
  gemm_phase(p, A, Bt, K, mtiles, Nt, epi, layer, gidx, ninst, bias, smem);
}

__device__ __forceinline__ unsigned xcc_id() { return (unsigned)__builtin_amdgcn_s_getreg((3 << 11) | 20) & 0xFu; }
__device__ __forceinline__ void grid_barrier(unsigned* bar, unsigned xcc, unsigned k, unsigned nloc, unsigned nx) {
  __syncthreads();
  if (threadIdx.x == 0) {
    unsigned a = __hip_atomic_fetch_add(&bar[1024 + xcc * 64], 1u, __ATOMIC_RELAXED, __HIP_MEMORY_SCOPE_AGENT) + 1u;
    if (a == k * nloc) {
      __builtin_amdgcn_fence(__ATOMIC_RELEASE, "agent");
      asm volatile("s_waitcnt vmcnt(0)" ::: "memory");
      __hip_atomic_fetch_add(&bar[2048], 1u, __ATOMIC_RELAXED, __HIP_MEMORY_SCOPE_AGENT);
    }
    while (__hip_atomic_load(&bar[2048], __ATOMIC_RELAXED, __HIP_MEMORY_SCOPE_AGENT) < k * nx) __builtin_amdgcn_s_sleep(2);
    __builtin_amdgcn_fence(__ATOMIC_ACQUIRE, "agent");
    asm volatile("s_waitcnt vmcnt(0)" ::: "memory");
  }
  __syncthreads();
}

__global__ void __launch_bounds__(256, 2) mega(Params p, int ph_begin, int ph_end, int use_sync) {
  __shared__ __attribute__((aligned(16))) char smem[65536];
  __shared__ unsigned s_cnt[2];
  cg::grid_group grid = cg::this_grid();
  unsigned* bar = (unsigned*)(p.ws + WS_NEED);
  const unsigned xcc = xcc_id();
  if (use_sync && threadIdx.x == 0) __hip_atomic_fetch_add(&bar[xcc * 64], 1u, __ATOMIC_RELAXED, __HIP_MEMORY_SCOPE_AGENT);
  unsigned k = 0, nloc = 1, nx = 1;
  for (int ph = ph_begin; ph < ph_end; ++ph) {
    run_phase(p, ph, smem);
#ifdef DUP_MASK
    if (ph > ph_begin) {
      const int sub = (ph >= 1 && ph < NPH - 1) ? (ph - 1) % 7 : -1, layer = (ph - 1) / 7;
      bool dup = false;
      if ((DUP_MASK & 1) && sub == 2 && (layer & 1)) dup = true;
      if ((DUP_MASK & 2) && (sub == 1 || sub == 5)) dup = true;
      if ((DUP_MASK & 4) && sub == 2 && !(layer & 1)) dup = true;
      if ((DUP_MASK & 8) && (sub == 0 || sub == 4)) dup = true;
      if (dup) { ++k; grid_barrier(bar, xcc, k, nloc, nx); run_phase(p, ph | DUP_FLAG, smem); }
    }
#endif
    if (use_sync && ph + 1 < ph_end) {
      if (ph == ph_begin) {
        grid.sync();
        if (threadIdx.x == 0) {
          unsigned cnt = 0;
          for (int j = 0; j < 16; ++j) cnt += __hip_atomic_load(&bar[j * 64], __ATOMIC_RELAXED, __HIP_MEMORY_SCOPE_AGENT) ? 1u : 0u;
          s_cnt[0] = __hip_atomic_load(&bar[xcc * 64], __ATOMIC_RELAXED, __HIP_MEMORY_SCOPE_AGENT);
          s_cnt[1] = cnt;
        }
        __syncthreads();
        nloc = __builtin_amdgcn_readfirstlane(s_cnt[0]); nx = __builtin_amdgcn_readfirstlane(s_cnt[1]);
      } else {
        ++k;
        grid_barrier(bar, xcc, k, nloc, nx);
      }
    }
  }
}

extern "C" void kernel_launch(void* const* d_in, const int* in_sizes, int n_in, void* d_out, int out_size, void* d_ws,
                              size_t ws_size, hipStream_t stream) {
  Params p{};
  for (int i = 0; i < 22; ++i) p.in[i] = (const float*)d_in[i];
  p.outp = (float*)d_out;
  p.ws = (char*)d_ws;
  if (WS_NEED + 16384 > ws_size || n_in < 22) return;
  static int grid_blocks = 0;
  if (!grid_blocks) {
    int dev = 0, cus = 0, per_cu = 0;
    hipGetDevice(&dev);
    hipDeviceGetAttribute(&cus, hipDeviceAttributeMultiprocessorCount, dev);
    hipOccupancyMaxActiveBlocksPerMultiprocessor(&per_cu, mega, 256, 0);
    if (per_cu > 2) per_cu = 2;
    if (per_cu < 1) per_cu = 1;
    grid_blocks = cus * per_cu;
  }
#if MULTI_LAUNCH
  for (int ph = 0; ph < NPH; ++ph) mega<<<grid_blocks, 256, 0, stream>>>(p, ph, ph + 1, 0);
#else
  hipMemsetAsync((char*)d_ws + WS_NEED, 0, 16384, stream);
  int b = 0, e = NPH, s = 1;
  void* args[] = {&p, &b, &e, &s};
  hipError_t err = hipLaunchCooperativeKernel((void*)mega, dim3(grid_blocks), dim3(256), args, 0, stream);
  if (err != hipSuccess) fprintf(stderr, "cooperative launch failed: %s (grid %d)\n", hipGetErrorString(err), grid_blocks);
#endif
}
```
